# Optimizing an MI355X kernel written in HIP

```python
import jax, jax.numpy as jnp
from jax import lax
import numpy as np

D_MODEL = 1024
BATCH = 8
SEQ = 2048
DEPTH = 2

HEAD_DIM = 64
H_SB = 8
H_NSA = 8
NSA_KV_HEADS = 2
H_FOX = 8
H_MEM = 4
N_MEM = 256
N_BRANCH = 3
ROPE_THETA = 500000.0
ROPE_DIM = HEAD_DIM // 4
Q_BLOCK = 128
CMP_STRIDE = 16
CMP_LEN = 2 * CMP_STRIDE
CMP_HIDDEN = 256
SEL_BLOCK = 64
SEL_TOPK = 8
WINDOW = 512
D_FF = -(-(8 * D_MODEL) // (3 * 256)) * 256
W_SB = H_SB * HEAD_DIM
W_NSA = H_NSA * HEAD_DIM
W_NSA_KV = NSA_KV_HEADS * HEAD_DIM
W_FOX = H_FOX * HEAD_DIM
W_MEM = H_MEM * HEAD_DIM
IN_SIZES = (W_SB, W_SB, W_SB,
            W_NSA, W_NSA_KV, W_NSA_KV, W_NSA_KV, W_NSA_KV, W_NSA_KV, W_NSA_KV, 3 * H_NSA,
            W_FOX, W_FOX, W_FOX, H_FOX,
            N_BRANCH * D_MODEL)
D_IN = sum(IN_SIZES)

kernel_name = "hybrid_sb_nsa_fox_block"

F32 = jnp.float32


def rmsnorm(x, g, eps=1e-6):
    xf = x.astype(F32)
    y = xf * lax.rsqrt(jnp.mean(xf * xf, axis=-1, keepdims=True) + eps)
    return (y * g.astype(F32)).astype(x.dtype)


def masked_softmax(logits, mask):
    logits = jnp.where(mask, logits.astype(F32), -jnp.inf)
    m = jnp.max(logits, axis=-1, keepdims=True)
    m = jnp.where(jnp.isfinite(m), m, 0.0)
    e = jnp.where(mask, jnp.exp(logits - m), 0.0)
    den = jnp.sum(e, axis=-1, keepdims=True)
    return e / jnp.where(den > 0, den, 1.0)


def partial_rope(x, pos):
    half = ROPE_DIM // 2
    inv_freq = ROPE_THETA ** (-jnp.arange(half, dtype=F32) / half)
    ang = pos.astype(F32)[:, :, None] * inv_freq
    cos = jnp.cos(ang)[:, :, None, :].astype(x.dtype)
    sin = jnp.sin(ang)[:, :, None, :].astype(x.dtype)
    x1, x2, rest = x[..., :half], x[..., half:ROPE_DIM], x[..., ROPE_DIM:]
    return jnp.concatenate([x1 * cos - x2 * sin, x2 * cos + x1 * sin, rest], axis=-1)


def stick_breaking_attention(q, k, v):
    B, S, H, d = q.shape
    scale = d ** -0.5
    outs = []
    for i in range(S // Q_BLOCK):
        q0, q1 = i * Q_BLOCK, (i + 1) * Q_BLOCK
        z = jnp.einsum('bqhd,bkhd->bhqk', q[:, q0:q1], k[:, :q1]).astype(F32) * scale
        strict = jnp.arange(q1)[None, :] < jnp.arange(q0, q1)[:, None]
        log_keep = jnp.where(strict, jax.nn.log_sigmoid(-z), 0.0)
        later = lax.cumsum(log_keep, axis=3, reverse=True) - log_keep
        w = jnp.where(strict, jnp.exp(jax.nn.log_sigmoid(z) + later), 0.0)
        outs.append(jnp.einsum('bhqk,bkhd->bqhd', w.astype(v.dtype), v[:, :q1]))
    return jnp.concatenate(outs, axis=1)


def forgetting_attention(q, k, v, f_logit):
    B, S, H, d = q.shape
    scale = d ** -0.5
    c = jnp.cumsum(jax.nn.log_sigmoid(f_logit.astype(F32)), axis=1).transpose(0, 2, 1)
    outs = []
    for i in range(S // Q_BLOCK):
        q0, q1 = i * Q_BLOCK, (i + 1) * Q_BLOCK
        logits = (jnp.einsum('bqhd,bkhd->bhqk', q[:, q0:q1], k[:, :q1]).astype(F32) * scale
                  + c[:, :, q0:q1, None] - c[:, :, None, :q1])
        causal = jnp.arange(q1)[None, :] <= jnp.arange(q0, q1)[:, None]
        p = masked_softmax(logits, causal)
        outs.append(jnp.einsum('bhqk,bkhd->bqhd', p.astype(v.dtype), v[:, :q1]))
    return jnp.concatenate(outs, axis=1)


def compress_blocks(x, pe, w1, b1, w2):
    B, S, G, d = x.shape
    ch = x.reshape(B, S // CMP_STRIDE, CMP_STRIDE, G, d)
    blk = jnp.concatenate([ch[:, :-1], ch[:, 1:]], axis=2) + pe[None, None, :, None, :]
    n_cmp = blk.shape[1]
    flat = blk.transpose(0, 1, 3, 2, 4).reshape(B, n_cmp, G, CMP_LEN * d)
    return jax.nn.silu(flat @ w1 + b1) @ w2


def native_sparse_attention(q, kc, vc, ks, vs, kw, vw, gates, pos,
                            pe_k, w1_k, b1_k, w2_k, pe_v, w1_v, b1_v, w2_v):
    B, S, H, d = q.shape
    G = kc.shape[2]
    R = H // G
    scale = d ** -0.5
    t_all = jnp.arange(S)
    qg = q.reshape(B, S, G, R, d)
    qg_rope = partial_rope(q, pos).reshape(B, S, G, R, d)
    ks_r = partial_rope(ks, pos)
    kw_r = partial_rope(kw, pos)

    k_cmp = compress_blocks(kc, pe_k, w1_k, b1_k, w2_k)
    v_cmp = compress_blocks(vc, pe_v, w1_v, b1_v, w2_v)
    n_cmp = k_cmp.shape[1]
    cmp_start = jnp.arange(n_cmp) * CMP_STRIDE
    cmp_valid = (cmp_start + CMP_LEN - 1)[None, :] <= t_all[:, None]
    s_cmp = jnp.einsum('bsgrd,bcgd->bgrsc', qg, k_cmp).astype(F32) * scale
    p_cmp = masked_softmax(s_cmp, cmp_valid)
    o_cmp = jnp.einsum('bgrsc,bcgd->bsgrd', p_cmp.astype(v_cmp.dtype), v_cmp)

    n_sel = S // SEL_BLOCK
    sel_start = jnp.arange(n_sel) * SEL_BLOCK
    overlap = ((cmp_start[:, None] < sel_start[None, :] + SEL_BLOCK)
               & (cmp_start[:, None] + CMP_LEN > sel_start[None, :])).astype(F32)
    p_slc = jnp.einsum('bgrsc,cn->bgsn', p_cmp, overlap)
    blk_id = jnp.arange(n_sel)[None, :]
    sel_valid = sel_start[None, :] <= t_all[:, None]
    forced = (blk_id == 0) | (blk_id == (t_all // SEL_BLOCK)[:, None])
    sel_score = jnp.where(forced, 1e4, jnp.where(sel_valid, p_slc, -1.0))
    k_top = min(SEL_TOPK, n_sel)
    sel_idx = lax.top_k(sel_score, k_top)[1]
    ks_blk = ks_r.reshape(B, n_sel, SEL_BLOCK, G, d).transpose(0, 3, 1, 2, 4)
    vs_blk = vs.reshape(B, n_sel, SEL_BLOCK, G, d).transpose(0, 3, 1, 2, 4)
    b_ix = jnp.arange(B)[:, None, None, None]
    g_ix = jnp.arange(G)[None, :, None, None]
    o_sel, o_win = [], []
    for i in range(S // Q_BLOCK):
        q0, q1 = i * Q_BLOCK, (i + 1) * Q_BLOCK
        t_blk = jnp.arange(q0, q1)
        ib = sel_idx[:, :, q0:q1]
        kg = ks_blk[b_ix, g_ix, ib].reshape(B, G, Q_BLOCK, k_top * SEL_BLOCK, d)
        vg = vs_blk[b_ix, g_ix, ib].reshape(B, G, Q_BLOCK, k_top * SEL_BLOCK, d)
        kpos = (ib[..., None] * SEL_BLOCK + jnp.arange(SEL_BLOCK)).reshape(B, G, Q_BLOCK, k_top * SEL_BLOCK)
        logits = jnp.einsum('bqgrd,bgqnd->bgrqn', qg_rope[:, q0:q1], kg) * scale
        mask = kpos[:, :, None] <= t_blk[None, None, None, :, None]
        p = masked_softmax(logits, mask)
        o_sel.append(jnp.einsum('bgrqn,bgqnd->bqgrd', p.astype(vg.dtype), vg))
        k0 = max(0, q0 - WINDOW + 1)
        logits_w = jnp.einsum('bqgrd,bkgd->bgrqk', qg_rope[:, q0:q1], kw_r[:, k0:q1]) * scale
        s_pos = jnp.arange(k0, q1)[None, :]
        band = (s_pos <= t_blk[:, None]) & (t_blk[:, None] - s_pos < WINDOW)
        p_w = masked_softmax(logits_w, band)
        o_win.append(jnp.einsum('bgrqk,bkgd->bqgrd', p_w.astype(vw.dtype), vw[:, k0:q1]))
    o_sel = jnp.concatenate(o_sel, axis=1)
    o_win = jnp.concatenate(o_win, axis=1)
    g = gates.reshape(B, S, G, R, 3).astype(q.dtype)
    o = g[..., 0:1] * o_cmp + g[..., 1:2] * o_sel + g[..., 2:3] * o_win
    return o.reshape(B, S, H * d)


def hybrid_mixer(h, pos, w_in, b_fox_f, pe_k, w1_k, b1_k, w2_k, pe_v, w1_v, b1_v, w2_v,
                 w_up_sb, w_up_nsa, w_up_fox, w_out):
    B, S, _ = h.shape
    offsets = np.cumsum(IN_SIZES)[:-1].tolist()
    (sb_q, sb_k, sb_v, nsa_q, nsa_kc, nsa_vc, nsa_ks, nsa_vs, nsa_kw, nsa_vw, nsa_g,
     fox_q, fox_k, fox_v, fox_f, merge) = jnp.split(h @ w_in, offsets, axis=-1)

    def heads(t, n):
        return t.reshape(B, S, n, HEAD_DIM)

    o_sb = stick_breaking_attention(heads(sb_q, H_SB), heads(sb_k, H_SB), heads(sb_v, H_SB))
    nsa_gates = jax.nn.sigmoid(nsa_g.astype(F32)).reshape(B, S, H_NSA, 3)
    o_nsa = native_sparse_attention(
        heads(nsa_q, H_NSA), heads(nsa_kc, NSA_KV_HEADS), heads(nsa_vc, NSA_KV_HEADS),
        heads(nsa_ks, NSA_KV_HEADS), heads(nsa_vs, NSA_KV_HEADS),
        heads(nsa_kw, NSA_KV_HEADS), heads(nsa_vw, NSA_KV_HEADS), nsa_gates, pos,
        pe_k, w1_k, b1_k, w2_k, pe_v, w1_v, b1_v, w2_v)
    o_fox = forgetting_attention(heads(fox_q, H_FOX), heads(fox_k, H_FOX), heads(fox_v, H_FOX),
                                 fox_f + b_fox_f)
    gate = jax.nn.sigmoid(merge.astype(F32)).astype(h.dtype).reshape(B, S, N_BRANCH, D_MODEL)
    y = (gate[:, :, 0] * (o_sb.reshape(B, S, W_SB) @ w_up_sb)
         + gate[:, :, 1] * (o_nsa @ w_up_nsa)
         + gate[:, :, 2] * (o_fox.reshape(B, S, W_FOX) @ w_up_fox))
    return y @ w_out


def memory_attention(h, mem_n, wq, wk, wv, wo):
    B, S, _ = h.shape
    M = mem_n.shape[1]
    q = (h @ wq).reshape(B, S, H_MEM, HEAD_DIM)
    k = (mem_n @ wk).reshape(B, M, H_MEM, HEAD_DIM)
    v = (mem_n @ wv).reshape(B, M, H_MEM, HEAD_DIM)
    logits = jnp.einsum('bshd,bmhd->bhsm', q, k).astype(F32) * HEAD_DIM ** -0.5
    p = jax.nn.softmax(logits, axis=-1).astype(v.dtype)
    o = jnp.einsum('bhsm,bmhd->bshd', p, v).reshape(B, S, W_MEM)
    return o @ wo


def swiglu(h, w_gate, w_up, w_down):
    return (jax.nn.silu(h @ w_gate) * (h @ w_up)) @ w_down


def setup_inputs(seed: int = 0) -> dict:
    key = jax.random.key(seed)
    ks = jax.random.split(key, 40)
    nrm = jax.random.normal

    def w(k, shape, fan_in):
        return nrm(k, shape, F32) * fan_in ** -0.5

    def gain(k):
        return 1.0 + 0.05 * nrm(k, (DEPTH, D_MODEL), F32)

    start = jax.random.randint(ks[2], (BATCH, 1), 0, 4096, dtype=jnp.int32)
    positions = (start + jnp.arange(SEQ, dtype=jnp.int32)[None, :]).astype(jnp.int32)
    return {
        "x": nrm(ks[0], (BATCH, SEQ, D_MODEL), F32),
        "mem": nrm(ks[1], (BATCH, N_MEM, D_MODEL), F32),
        "positions": positions,
        "g_pre_mix": gain(ks[3]),
        "g_post_mix": gain(ks[4]),
        "g_pre_mem": gain(ks[5]),
        "g_mem": gain(ks[6]),
        "g_post_mem": gain(ks[7]),
        "g_pre_ffn": gain(ks[8]),
        "g_post_ffn": gain(ks[9]),
        "w_in": w(ks[10], (DEPTH, D_MODEL, D_IN), D_MODEL),
        "b_fox_f": 3.0 + 0.5 * nrm(ks[11], (DEPTH, H_FOX), F32),
        "cmp_pe_k": 0.02 * nrm(ks[12], (DEPTH, CMP_LEN, HEAD_DIM), F32),
        "cmp_w1_k": w(ks[13], (DEPTH, CMP_LEN * HEAD_DIM, CMP_HIDDEN), CMP_LEN * HEAD_DIM),
        "cmp_b1_k": 0.02 * nrm(ks[14], (DEPTH, CMP_HIDDEN), F32),
        "cmp_w2_k": w(ks[15], (DEPTH, CMP_HIDDEN, HEAD_DIM), CMP_HIDDEN),
        "cmp_pe_v": 0.02 * nrm(ks[16], (DEPTH, CMP_LEN, HEAD_DIM), F32),
        "cmp_w1_v": w(ks[17], (DEPTH, CMP_LEN * HEAD_DIM, CMP_HIDDEN), CMP_LEN * HEAD_DIM),
        "cmp_b1_v": 0.02 * nrm(ks[18], (DEPTH, CMP_HIDDEN), F32),
        "cmp_w2_v": w(ks[19], (DEPTH, CMP_HIDDEN, HEAD_DIM), CMP_HIDDEN),
        "w_up_sb": w(ks[20], (DEPTH, W_SB, D_MODEL), W_SB),
        "w_up_nsa": w(ks[21], (DEPTH, W_NSA, D_MODEL), W_NSA),
        "w_up_fox": w(ks[22], (DEPTH, W_FOX, D_MODEL), W_FOX),
        "w_out": w(ks[23], (DEPTH, D_MODEL, D_MODEL), D_MODEL),
        "w_mem_q": w(ks[24], (DEPTH, D_MODEL, W_MEM), D_MODEL),
        "w_mem_k": w(ks[25], (DEPTH, D_MODEL, W_MEM), D_MODEL),
        "w_mem_v": w(ks[26], (DEPTH, D_MODEL, W_MEM), D_MODEL),
        "w_mem_o": w(ks[27], (DEPTH, W_MEM, D_MODEL), W_MEM),
        "w_ffn_gate": w(ks[28], (DEPTH, D_MODEL, D_FF), D_MODEL),
        "w_ffn_up": w(ks[29], (DEPTH, D_MODEL, D_FF), D_MODEL),
        "w_ffn_down": w(ks[30], (DEPTH, D_FF, D_MODEL), D_FF),
    }


def reference(x, mem, positions, g_pre_mix, g_post_mix, g_pre_mem, g_mem, g_post_mem,
              g_pre_ffn, g_post_ffn, w_in, b_fox_f, cmp_pe_k, cmp_w1_k, cmp_b1_k, cmp_w2_k,
              cmp_pe_v, cmp_w1_v, cmp_b1_v, cmp_w2_v, w_up_sb, w_up_nsa, w_up_fox, w_out,
              w_mem_q, w_mem_k, w_mem_v, w_mem_o, w_ffn_gate, w_ffn_up, w_ffn_down):
    for l in range(DEPTH):
        h = rmsnorm(x, g_pre_mix[l])
        y = hybrid_mixer(h, positions, w_in[l], b_fox_f[l],
                         cmp_pe_k[l], cmp_w1_k[l], cmp_b1_k[l], cmp_w2_k[l],
                         cmp_pe_v[l], cmp_w1_v[l], cmp_b1_v[l], cmp_w2_v[l],
                         w_up_sb[l], w_up_nsa[l], w_up_fox[l], w_out[l])
        x = x + rmsnorm(y, g_post_mix[l])
        h = rmsnorm(x, g_pre_mem[l])
        y = memory_attention(h, rmsnorm(mem, g_mem[l]), w_mem_q[l], w_mem_k[l], w_mem_v[l], w_mem_o[l])
        x = x + rmsnorm(y, g_post_mem[l])
        h = rmsnorm(x, g_pre_ffn[l])
        y = swiglu(h, w_ffn_gate[l], w_ffn_up[l], w_ffn_down[l])
        x = x + rmsnorm(y, g_post_ffn[l])
    return x
```

```cpp
#include <hip/hip_runtime.h>
#include <cstdio>
#include <cstdint>
#include <cmath>
#include <utility>
#include <initializer_list>
#define MK_ONE_LAUNCH 1
#define PROBE_MASK 0u
#define PROBE_REPS 0
#define PROBE_XBAR 0
#define PROBE_XP 0
#define FA_FULL 1
#define FA_RESC 1
#define FA_VAR 0
#define FA_CORE_MEM fa::flash_core_v4
#define FA_CORE_FOX fa::flash_core_v4
#define FA_CORE_SEL fa::flash_core_v4
#define GAS __attribute__((address_space(1)))
#define LAS __attribute__((address_space(3)))
namespace pg8 {
#define PG8_LAS __attribute__((address_space(3)))
typedef unsigned short bf16_t;
typedef short bf16x8 __attribute__((ext_vector_type(8)));
typedef float f32x4 __attribute__((ext_vector_type(4)));
typedef unsigned u32x4 __attribute__((ext_vector_type(4)));
constexpr int BM = 256, BK = 64, HALF = 128, HTB = HALF * BK * 2  , STAGE_BYTES = 8 * HTB, NXCD = 8, WGM = 8;

__host__ __device__ __forceinline__ int lds_byte(int r, int c) { const int st = (r >> 4) * 2 + (c >> 5), rr = r & 15, cc = c & 31, ob = rr * 64 + cc * 2; return st * 1024 + (ob ^ (((ob >> 9) & 1) << 5)); }
__host__ __device__ __forceinline__ void stage_rc(int b, int& R, int& C) { const int st = b / 1024, sb = b % 1024, swz = sb ^ (((sb >> 9) & 1) << 5); R = (st >> 1) * 16 + swz / 64; C = (st & 1) * 32 + (swz % 64) / 2; }
__host__ __device__ __forceinline__ int perm32(int rho) { const int n = rho >> 4, i = rho & 15; return 8 * (i >> 2) + 4 * n + (i & 3); }

struct Unit { int pm, pn; };
struct Gemm { const bf16_t* A; const bf16_t* Bt; int M, N, K; int lda, ldb; };

struct StaticOrder {
    int nM, nN, nwg, G, c;
    __host__ __device__ void init(int M, int N, int G_, int c_) { nM = M / BM; nN = N / BM; nwg = nM * nN; G = G_; c = c_; }
    __host__ __device__ bool next(int i, Unit& u) const {
        const long L = (long)i * G + c; if (L >= nwg) return false;
        int wgid = (int)L; { const int q = nwg / NXCD, r = nwg % NXCD, xcd = wgid % NXCD, off = wgid / NXCD; wgid = (xcd < r ? xcd * (q + 1) : r * (q + 1) + (xcd - r) * q) + off; }
        const int nig = WGM * nN, gid = wgid / nig, fm = gid * WGM, gsz = (nM - fm) < WGM ? (nM - fm) : WGM;
        u.pm = fm + ((wgid % nig) % gsz); u.pn = (wgid % nig) / gsz; return true;
    }
    __device__ __forceinline__ void a_ready(const Unit&) const {}
    __device__ __forceinline__ void done(const Unit&) const {}
};

typedef float cvt_f32x2_t __attribute__((ext_vector_type(2))); typedef __bf16 cvt_bf16x2_t __attribute__((ext_vector_type(2)));
__device__ __forceinline__ unsigned cvt_pk_bf16(float lo, float hi) { const cvt_f32x2_t v = {lo, hi}; const cvt_bf16x2_t b = __builtin_convertvector(v, cvt_bf16x2_t); return __builtin_bit_cast(unsigned, b); }
typedef float f32x2 __attribute__((ext_vector_type(2)));
template <class Epi, class Sched, bool ALIGN_EPI = false, bool SP2 = false>
__device__ __forceinline__ void gemm_phase(PG8_LAS unsigned char* lds, const Gemm g, const Sched& S, const Epi& E) {
    int tid_ = threadIdx.x; asm volatile("" : "+v"(tid_));
    const int tid = tid_, wid = __builtin_amdgcn_readfirstlane(tid >> 6), lane = tid & 63, wr = wid >> 2, wc = wid & 3, fr = lane & 15, fq = lane >> 4;
    const int K = g.K, nt = K / BK, lda = g.lda ? g.lda : K, ldb = g.ldb ? g.ldb : K;
    unsigned voffA[2], voffB[2];
#pragma unroll
    for (int i = 0; i < 2; ++i) { int R, C; stage_rc(tid * 16 + i * 8192, R, C); const int Rb = Epi::PERM ? ((R & ~31) + perm32(R & 31)) : R;
        voffA[i] = (unsigned)(R * lda + C) * 2u; voffB[i] = (unsigned)(Rb * ldb + C) * 2u; }
    const size_t kstep = (size_t)(BK * 2);
    const size_t hstepA = (size_t)HALF * lda * 2, hstepB = (size_t)HALF * ldb * 2;
    const size_t tstepA = 2 * hstepA, tstepB = 2 * hstepB;
    const unsigned ldsw = (unsigned)wid * 1024u;
    const int aoff = lds_byte(wr * 64 + fr, fq * 8), boff = lds_byte(wc * 32 + fr, fq * 8);
#define PG8_SA(b, h) (((b) * 2 + (h)) * HTB)
#define PG8_SB(b, h) ((4 + (b) * 2 + (h)) * HTB)
#define PG8_STAGE(bufoff, gbase, voff) do { _Pragma("unroll") for (int _i = 0; _i < 2; ++_i) \
        __builtin_amdgcn_global_load_lds((const unsigned*)((const char*)(gbase) + (voff)[_i]), (PG8_LAS unsigned*)(lds + (bufoff) + ldsw + _i * 8192), 16, 0, 0); } while (0)
#define PG8_LDA(dst, b, h) do { _Pragma("unroll") for (int m = 0; m < 4; ++m) _Pragma("unroll") for (int k = 0; k < 2; ++k) dst[m][k] = *(const PG8_LAS bf16x8*)(lds + PG8_SA(b, h) + aoff + m * 2048 + k * 1024); } while (0)
#define PG8_LDB(dst, b, h) do { _Pragma("unroll") for (int n = 0; n < 2; ++n) _Pragma("unroll") for (int k = 0; k < 2; ++k) dst[n][k] = *(const PG8_LAS bf16x8*)(lds + PG8_SB(b, h) + boff + n * 2048 + k * 1024); } while (0)
#define PG8_MMA(ai, bj, At, Bt) do { __builtin_amdgcn_s_setprio(1); _Pragma("unroll") for (int m = 0; m < 4; ++m) _Pragma("unroll") for (int n = 0; n < 2; ++n) _Pragma("unroll") for (int k = 0; k < 2; ++k) \
        acc[ai][bj][m][n] = __builtin_amdgcn_mfma_f32_16x16x32_bf16(Bt[n][k], At[m][k], acc[ai][bj][m][n], 0, 0, 0); __builtin_amdgcn_s_setprio(0); } while (0)
#define PG8_WAIT_V(n) asm volatile("s_waitcnt vmcnt(" #n ")" ::: "memory")
#define PG8_WAIT_L(n) asm volatile("s_waitcnt lgkmcnt(" #n ")" ::: "memory")
#define PG8_BAR __builtin_amdgcn_s_barrier()
#define PG8_SCHED __builtin_amdgcn_sched_barrier(0)
    Unit cur, nxt; int ui = 0;
    if (!S.next(0, cur)) return;
    float zz_ = 0.f; asm volatile("" : "+v"(zz_));
    f32x4 acc[2][2][4][2];
#pragma unroll
    for (int a = 0; a < 2; ++a)
#pragma unroll
        for (int b = 0; b < 2; ++b)
#pragma unroll
            for (int m = 0; m < 4; ++m)
#pragma unroll
                for (int n = 0; n < 2; ++n) acc[a][b][m][n] = (f32x4){zz_, zz_, zz_, zz_};
    bf16x8 At[4][2], B0[2][2], B1[2][2];
    const char* cA = (const char*)g.A + (size_t)cur.pm * tstepA; const char* cB = (const char*)g.Bt + (size_t)cur.pn * tstepB;
    S.a_ready(cur);
    if constexpr (SP2) {
        PG8_STAGE(PG8_SB(0, 0), cB, voffB); PG8_STAGE(PG8_SB(0, 1), cB + hstepB, voffB); PG8_STAGE(PG8_SA(0, 0), cA, voffA); PG8_STAGE(PG8_SA(0, 1), cA + hstepA, voffA);
        if (wr == 1) PG8_BAR;
        PG8_WAIT_V(2); PG8_BAR;
        PG8_STAGE(PG8_SB(1, 0), cB + kstep, voffB); PG8_STAGE(PG8_SA(1, 0), cA + kstep, voffA); PG8_STAGE(PG8_SB(1, 1), cB + hstepB + kstep, voffB);
        PG8_WAIT_V(6); PG8_BAR;
    } else {
        PG8_STAGE(PG8_SB(0, 0), cB, voffB); PG8_STAGE(PG8_SA(0, 0), cA, voffA); PG8_STAGE(PG8_SB(0, 1), cB + hstepB, voffB); PG8_STAGE(PG8_SA(0, 1), cA + hstepA, voffA);
        if (wr == 1) PG8_BAR;
        PG8_WAIT_V(4); PG8_BAR;
        PG8_STAGE(PG8_SB(1, 0), cB + kstep, voffB); PG8_STAGE(PG8_SA(1, 0), cA + kstep, voffA); PG8_STAGE(PG8_SB(1, 1), cB + hstepB + kstep, voffB);
        PG8_WAIT_V(6); PG8_BAR;
    }
    for (;;) {
        const bool has_next = S.next(ui + 1, nxt);
        const char* nA = has_next ? (const char*)g.A + (size_t)nxt.pm * tstepA : cA; const char* nB = has_next ? (const char*)g.Bt + (size_t)nxt.pn * tstepB : cB;
        for (int t = 0; t < nt; t += 2) {
            const bool last = (t == nt - 2);
            const char* a1 = cA + (size_t)(t + 1) * kstep;
            const char* a2 = last ? nA : cA + (size_t)(t + 2) * kstep; const char* b2 = last ? nB : cB + (size_t)(t + 2) * kstep;
            const char* a3 = a2 + kstep; const char* b3 = b2 + kstep;
            if (last && has_next) S.a_ready(nxt);
            if constexpr (SP2) {
            PG8_LDB(B0, 0, 0); PG8_LDB(B1, 0, 1); PG8_SCHED; PG8_LDA(At, 0, 0); PG8_STAGE(PG8_SA(1, 1), a1 + hstepA, voffA);
            PG8_WAIT_V(8); PG8_WAIT_L(0); PG8_BAR; PG8_MMA(0, 0, At, B0); PG8_MMA(0, 1, At, B1); PG8_BAR; PG8_SCHED;
            PG8_LDA(At, 0, 1); PG8_STAGE(PG8_SB(0, 0), b2, voffB); PG8_STAGE(PG8_SB(0, 1), b2 + hstepB, voffB); PG8_STAGE(PG8_SA(0, 0), a2, voffA);
            PG8_WAIT_V(8); PG8_WAIT_L(0); PG8_BAR; PG8_MMA(1, 0, At, B0); PG8_MMA(1, 1, At, B1); PG8_BAR; PG8_SCHED;
            PG8_LDB(B0, 1, 0); PG8_LDB(B1, 1, 1); PG8_SCHED; PG8_LDA(At, 1, 0); PG8_STAGE(PG8_SA(0, 1), a2 + hstepA, voffA);
            PG8_WAIT_V(8); PG8_WAIT_L(0); PG8_BAR; PG8_MMA(0, 0, At, B0); PG8_MMA(0, 1, At, B1); PG8_BAR; PG8_SCHED;
            PG8_LDA(At, 1, 1); PG8_STAGE(PG8_SB(1, 0), b3, voffB); PG8_STAGE(PG8_SB(1, 1), b3 + hstepB, voffB); PG8_STAGE(PG8_SA(1, 0), a3, voffA);
            PG8_WAIT_V(8); PG8_WAIT_L(0); PG8_BAR; PG8_MMA(1, 0, At, B0); PG8_MMA(1, 1, At, B1); PG8_BAR; PG8_SCHED;
            } else {
            PG8_LDB(B0, 0, 0); PG8_SCHED; PG8_LDA(At, 0, 0); PG8_STAGE(PG8_SA(1, 1), a1 + hstepA, voffA);
            PG8_WAIT_L(8); PG8_BAR; PG8_WAIT_L(0); PG8_MMA(0, 0, At, B0); PG8_BAR; PG8_SCHED;
            PG8_LDB(B1, 0, 1); PG8_STAGE(PG8_SB(0, 0), b2, voffB);
            PG8_BAR; PG8_WAIT_L(0); PG8_MMA(0, 1, At, B1); PG8_BAR;
            PG8_LDA(At, 0, 1); PG8_STAGE(PG8_SA(0, 0), a2, voffA);
            PG8_BAR; PG8_WAIT_L(0); PG8_MMA(1, 0, At, B0); PG8_BAR; PG8_SCHED;
            PG8_STAGE(PG8_SB(0, 1), b2 + hstepB, voffB);
            PG8_WAIT_V(6); PG8_BAR; PG8_MMA(1, 1, At, B1); PG8_BAR;
            PG8_LDB(B0, 1, 0); PG8_SCHED; PG8_LDA(At, 1, 0); PG8_STAGE(PG8_SA(0, 1), a2 + hstepA, voffA);
            PG8_WAIT_L(8); PG8_BAR; PG8_WAIT_L(0); PG8_MMA(0, 0, At, B0); PG8_BAR; PG8_SCHED;
            PG8_LDB(B1, 1, 1); PG8_STAGE(PG8_SB(1, 0), b3, voffB);
            PG8_BAR; PG8_WAIT_L(0); PG8_MMA(0, 1, At, B1); PG8_BAR;
            PG8_LDA(At, 1, 1); PG8_STAGE(PG8_SA(1, 0), a3, voffA);
            PG8_BAR; PG8_WAIT_L(0); PG8_MMA(1, 0, At, B0); PG8_BAR; PG8_SCHED;
            PG8_STAGE(PG8_SB(1, 1), b3 + hstepB, voffB);
            PG8_WAIT_V(6); PG8_BAR; PG8_MMA(1, 1, At, B1); PG8_BAR;
            }
        }
        if constexpr (ALIGN_EPI) { if (wr == 0) PG8_BAR; }
        if constexpr (!Epi::AFTER_DRAIN) { E(acc, cur, wr, wc, fr, fq); S.done(cur); }
        if (!has_next) break;
#pragma unroll
        for (int a = 0; a < 2; ++a)
#pragma unroll
            for (int b = 0; b < 2; ++b)
#pragma unroll
                for (int m = 0; m < 4; ++m)
#pragma unroll
                    for (int n = 0; n < 2; ++n) acc[a][b][m][n] = (f32x4){zz_, zz_, zz_, zz_};
        cur = nxt; cA = nA; cB = nB; ++ui;
        if constexpr (ALIGN_EPI) { if (wr == 1) PG8_BAR; }
    }
    PG8_WAIT_V(0);
    if constexpr (!ALIGN_EPI) { if (wr == 0) PG8_BAR; }
    PG8_BAR;
    if constexpr (Epi::AFTER_DRAIN) { E.fused(acc, cur, wr, wc, fr, fq, lds, wid, lane); S.done(cur); }
#undef PG8_SA
#undef PG8_SB
#undef PG8_STAGE
#undef PG8_LDA
#undef PG8_LDB
#undef PG8_MMA
#undef PG8_WAIT_V
#undef PG8_WAIT_L
#undef PG8_BAR
#undef PG8_SCHED
}
}
#define XB_TMO      128
#define XB_XCNT(j)  (256  + 64 * (j))
#define XB_XSUB(j)  (1280 + 64 * (j))
#define XB_XGEN(j)  (2304 + 64 * (j))
#define XB_TOP      3328
#define XB_TOPGEN   3392
#define XCD_BAR_WORDS 3456
#define XB_SPIN_CAP (1u << 18)

__device__ __forceinline__ unsigned xb_ld(unsigned* p)              { return __hip_atomic_load(p, __ATOMIC_RELAXED, __HIP_MEMORY_SCOPE_AGENT); }
__device__ __forceinline__ unsigned xb_add(unsigned* p, unsigned v) { return __hip_atomic_fetch_add(p, v, __ATOMIC_RELAXED, __HIP_MEMORY_SCOPE_AGENT); }
__device__ __forceinline__ unsigned xb_xcc_id() { return (unsigned)__builtin_amdgcn_s_getreg((3 << 11) | 20) & 0xFu; }
#define XB_SPIN(cond, bar) do { unsigned _sp = 0; while (cond) { __builtin_amdgcn_s_sleep(1); \
    if ((++_sp & 255u) == 0u) { if (xb_ld(&(bar)[XB_TMO])) break; if (_sp > XB_SPIN_CAP) { atomicAdd(&(bar)[XB_TMO], 1u); break; } } } } while (0)

struct XcdBarrier {
    unsigned* bar; unsigned x;
    volatile LAS unsigned* st;
};

__device__ __forceinline__ XcdBarrier xcd_barrier_post(unsigned* bar, volatile LAS unsigned* st) {
    XcdBarrier b; b.bar = bar; b.x = xb_xcc_id(); b.st = st;
    if (threadIdx.x == 0) (void)xb_add(&bar[XB_XCNT(b.x)], 1u);
    return b;
}
__device__ __forceinline__ void xcd_barrier_complete(unsigned* bar, unsigned x, unsigned& nloc, unsigned& nx) {
    const unsigned G = gridDim.x * gridDim.y * gridDim.z;
    unsigned sum, cnt, mine, sp = 0u;
    for (;;) {
        sum = 0u; cnt = 0u; mine = 0u;
#pragma unroll
        for (unsigned j = 0; j < 16; ++j) { const unsigned c = xb_ld(&bar[XB_XCNT(j)]); sum += c; cnt += (c > 0u) ? 1u : 0u; mine = (j == x) ? c : mine; }
        if (sum == G) break;
        __builtin_amdgcn_s_sleep(1);
        if ((++sp & 255u) == 0u) { if (xb_ld(&bar[XB_TMO])) break; if (sp > XB_SPIN_CAP) { atomicAdd(&bar[XB_TMO], 1u); break; } }
    }
    nloc = mine > 0u ? mine : 1u; nx = cnt > 0u ? cnt : 1u;
}

__device__ __forceinline__ void xcd_barrier(const XcdBarrier& b) {
    asm volatile("s_waitcnt vmcnt(0)" ::: "memory");
    __syncthreads();
    if (threadIdx.x == 0) {
        unsigned* bar = b.bar;
        __builtin_amdgcn_s_waitcnt(0);
        unsigned nloc = b.st[0], nx = b.st[1];
        if (nloc == 0u) { xcd_barrier_complete(bar, b.x, nloc, nx); b.st[0] = nloc; b.st[1] = nx; }
        const unsigned old = xb_add(&bar[XB_XSUB(b.x)], 1u);
        const unsigned gen = old / nloc;
        if (old + 1u == (gen + 1u) * nloc) {
            __builtin_amdgcn_fence(__ATOMIC_RELEASE, "agent");
            asm volatile("s_waitcnt vmcnt(0)" ::: "memory");
            const unsigned og = xb_add(&bar[XB_TOP], 1u);
            const unsigned tg = og / nx;
            if (og + 1u == (tg + 1u) * nx) xb_add(&bar[XB_TOPGEN], 1u);
            else XB_SPIN(xb_ld(&bar[XB_TOPGEN]) == tg, bar);
            __builtin_amdgcn_fence(__ATOMIC_ACQUIRE, "agent");
            xb_add(&bar[XB_XGEN(b.x)], 1u);
            asm volatile("s_waitcnt vmcnt(0)" ::: "memory");
        } else {
            XB_SPIN(xb_ld(&bar[XB_XGEN(b.x)]) == gen, bar);
            __builtin_amdgcn_fence(__ATOMIC_ACQUIRE, "agent");
            asm volatile("s_waitcnt vmcnt(0)" ::: "memory");
        }
    }
    __syncthreads();
}

namespace pg8 {
typedef unsigned u32x4e __attribute__((ext_vector_type(4)));
typedef int i32x4e __attribute__((ext_vector_type(4)));
__device__ __forceinline__ __amdgpu_buffer_rsrc_t wt_rsrc(const void* base) {
    const unsigned long long b = (unsigned long long)base;
    void* ub = (void*)(((unsigned long long)(unsigned)__builtin_amdgcn_readfirstlane((int)(b >> 32)) << 32) | (unsigned)__builtin_amdgcn_readfirstlane((int)b));
    return __builtin_amdgcn_make_buffer_rsrc(ub, (short)0, (int)0x7ffffff0, 0x00020000); }
__device__ __forceinline__ void st16_wt(__amdgpu_buffer_rsrc_t r, unsigned off, u32x4e w) { __builtin_amdgcn_raw_buffer_store_b128(w, r, (int)off, 0, 16); }
struct EpiPlain {
    static constexpr bool PERM = true, AFTER_DRAIN = false;
    bf16_t* O; int ld;
    __device__ __forceinline__ void operator()(const f32x4 (&acc)[2][2][4][2], const Unit& u, int wr, int wc, int fr, int fq) const {
        bf16_t* base = O + (size_t)(u.pm * BM + wr * 64 + fr) * ld + u.pn * BM + wc * 32 + 8 * fq;
        const bf16_t* wt_base_ = O; const __amdgpu_buffer_rsrc_t wt_r_ = wt_rsrc(wt_base_);
#pragma unroll
        for (int ai = 0; ai < 2; ++ai)
#pragma unroll
            for (int m = 0; m < 4; ++m) { bf16_t* rowp = base + (size_t)(ai * HALF + m * 16) * ld;
#pragma unroll
                for (int bj = 0; bj < 2; ++bj) { const f32x4 v0 = acc[ai][bj][m][0], v1 = acc[ai][bj][m][1];
                    u32x4e w; w.x = cvt_pk_bf16(v0[0], v0[1]); w.y = cvt_pk_bf16(v0[2], v0[3]); w.z = cvt_pk_bf16(v1[0], v1[1]); w.w = cvt_pk_bf16(v1[2], v1[3]);
                    st16_wt(wt_r_, (unsigned)((const char*)(rowp + bj * HALF) - (const char*)wt_base_), w); } }
    }
};
struct EpiProj {
    static constexpr bool PERM = true, AFTER_DRAIN = false;
    bf16_t* ck;
    bf16_t* oq; bf16_t* kv;
    int Mrows;
    __device__ __forceinline__ void operator()(const f32x4 (&acc)[2][2][4][2], const Unit& u, int wr, int wc, int fr, int fq) const {
        const int pn = u.pn; const size_t MS = (size_t)Mrows * 512;
        bf16_t* dst; int ld, c0;
        if (pn < 2)       { dst = oq;            ld = 512; c0 = pn * 256; }
        else if (pn < 4)  { dst = kv;            ld = 512; c0 = (pn - 2) * 256; }
        else if (pn < 6)  { dst = kv + MS;       ld = 512; c0 = (pn - 4) * 256; }
        else if (pn < 8)  { dst = oq + MS;       ld = 512; c0 = (pn - 6) * 256; }
        else if (pn < 11) { dst = kv + 4 * MS;   ld = 768; c0 = (pn - 8) * 256; }
        else if (pn < 13) { dst = oq + 2 * MS;   ld = 512; c0 = (pn - 11) * 256; }
        else if (pn < 15) { dst = kv + 2 * MS;   ld = 512; c0 = (pn - 13) * 256; }
        else if (pn < 17) { dst = kv + 3 * MS;   ld = 512; c0 = (pn - 15) * 256; }
        else              { dst = kv + 4 * MS + (size_t)Mrows * 768; ld = 256; c0 = 0; }
        bf16_t* base = dst + (size_t)(u.pm * BM + wr * 64 + fr) * ld + c0 + wc * 32 + 8 * fq;
        size_t bjs = HALF;
        if (pn == 8) {
            base = ck + ((size_t)(wc >> 1) * Mrows + (size_t)(u.pm * BM + wr * 64 + fr)) * 64 + (wc & 1) * 32 + 8 * fq; ld = 64; bjs = (size_t)2 * Mrows * 64; }
        const bf16_t* wt_base_ = (pn == 8 ? ck : dst); const __amdgpu_buffer_rsrc_t wt_r_ = wt_rsrc(wt_base_);
#pragma unroll
        for (int ai = 0; ai < 2; ++ai)
#pragma unroll
            for (int m = 0; m < 4; ++m) { bf16_t* rowp = base + (size_t)(ai * HALF + m * 16) * ld;
#pragma unroll
                for (int bj = 0; bj < 2; ++bj) { const f32x4 v0 = acc[ai][bj][m][0], v1 = acc[ai][bj][m][1];
                    u32x4e w; w.x = cvt_pk_bf16(v0[0], v0[1]); w.y = cvt_pk_bf16(v0[2], v0[3]); w.z = cvt_pk_bf16(v1[0], v1[1]); w.w = cvt_pk_bf16(v1[2], v1[3]);
                    st16_wt(wt_r_, (unsigned)((const char*)(rowp + bj * bjs) - (const char*)wt_base_), w); } }
    }
};
__device__ __forceinline__ float sigmoidf_(float x) { return __builtin_amdgcn_rcpf(1.0f + __expf(-x)); }
struct EpiSigmoid {
    static constexpr bool PERM = true, AFTER_DRAIN = false;
    bf16_t* O; int ld;
    __device__ __forceinline__ void operator()(const f32x4 (&acc)[2][2][4][2], const Unit& u, int wr, int wc, int fr, int fq) const {
        bf16_t* base = O + (size_t)(u.pm * BM + wr * 64 + fr) * ld + u.pn * BM + wc * 32 + 8 * fq;
#pragma unroll
        for (int ai = 0; ai < 2; ++ai)
#pragma unroll
            for (int m = 0; m < 4; ++m) { bf16_t* rowp = base + (size_t)(ai * HALF + m * 16) * ld;
#pragma unroll
                for (int bj = 0; bj < 2; ++bj) { f32x4 v0 = acc[ai][bj][m][0], v1 = acc[ai][bj][m][1];
#pragma unroll
                    for (int e = 0; e < 4; ++e) { v0[e] = sigmoidf_(v0[e]); v1[e] = sigmoidf_(v1[e]); }
                    u32x4e w; w.x = cvt_pk_bf16(v0[0], v0[1]); w.y = cvt_pk_bf16(v0[2], v0[3]); w.z = cvt_pk_bf16(v1[0], v1[1]); w.w = cvt_pk_bf16(v1[2], v1[3]);
                    *(u32x4e*)(rowp + bj * HALF) = w; } }
    }
};
struct EpiGateY {
    static constexpr bool PERM = true, AFTER_DRAIN = false;
    const bf16_t* MG; bf16_t* Y; bool dry;
    __device__ __forceinline__ void operator()(const f32x4 (&acc)[2][2][4][2], const Unit& u, int wr, int wc, int fr, int fq) const {
        const int branch = u.pm >> 6, pmr = u.pm & 63, pnr = u.pn & 3;
        const size_t r0 = (size_t)(pmr * BM + wr * 64 + fr); const int c0 = pnr * BM + wc * 32 + 8 * fq;
#pragma unroll
        for (int ai = 0; ai < 2; ++ai)
#pragma unroll
            for (int m = 0; m < 4; ++m) { const size_t row = r0 + ai * HALF + m * 16;
#pragma unroll
                for (int bj = 0; bj < 2; ++bj) { const f32x4 v0 = acc[ai][bj][m][0], v1 = acc[ai][bj][m][1];
                    const u32x4e g = *(const u32x4e*)(MG + row * 3072 + branch * 1024 + c0 + bj * HALF);
                    bf16_t* yp = Y + row * 1024 + c0 + bj * HALF;
                    float y[8];
                    y[0] = v0[0] * __uint_as_float(g.x << 16); y[1] = v0[1] * __uint_as_float(g.x & 0xffff0000u); y[2] = v0[2] * __uint_as_float(g.y << 16); y[3] = v0[3] * __uint_as_float(g.y & 0xffff0000u);
                    y[4] = v1[0] * __uint_as_float(g.z << 16); y[5] = v1[1] * __uint_as_float(g.z & 0xffff0000u); y[6] = v1[2] * __uint_as_float(g.w << 16); y[7] = v1[3] * __uint_as_float(g.w & 0xffff0000u);
                    if (branch != 0) { const u32x4e p = *(const u32x4e*)yp;
                        y[0] += __uint_as_float(p.x << 16); y[1] += __uint_as_float(p.x & 0xffff0000u); y[2] += __uint_as_float(p.y << 16); y[3] += __uint_as_float(p.y & 0xffff0000u);
                        y[4] += __uint_as_float(p.z << 16); y[5] += __uint_as_float(p.z & 0xffff0000u); y[6] += __uint_as_float(p.w << 16); y[7] += __uint_as_float(p.w & 0xffff0000u); }
                    u32x4e w; w.x = cvt_pk_bf16(y[0], y[1]); w.y = cvt_pk_bf16(y[2], y[3]); w.z = cvt_pk_bf16(y[4], y[5]); w.w = cvt_pk_bf16(y[6], y[7]);
                    if (!dry) *(u32x4e*)yp = w; } }
    }
};
struct EpiUpU {
    static constexpr bool PERM = true, AFTER_DRAIN = false;
    bf16_t* U;
    __device__ __forceinline__ void operator()(const f32x4 (&acc)[2][2][4][2], const Unit& u, int wr, int wc, int fr, int fq) const {
        const int pmr = u.pm & 63;
        bf16_t* base = U + (size_t)(pmr * BM + wr * 64 + fr) * 3072 + u.pn * BM + wc * 32 + 8 * fq;
        const bf16_t* wt_base_ = U; const __amdgpu_buffer_rsrc_t wt_r_ = wt_rsrc(wt_base_);
#pragma unroll
        for (int ai = 0; ai < 2; ++ai)
#pragma unroll
            for (int m = 0; m < 4; ++m) { bf16_t* rowp = base + (size_t)(ai * HALF + m * 16) * 3072;
#pragma unroll
                for (int bj = 0; bj < 2; ++bj) { const f32x4 v0 = acc[ai][bj][m][0], v1 = acc[ai][bj][m][1];
                    u32x4e w; w.x = cvt_pk_bf16(v0[0], v0[1]); w.y = cvt_pk_bf16(v0[2], v0[3]); w.z = cvt_pk_bf16(v1[0], v1[1]); w.w = cvt_pk_bf16(v1[2], v1[3]);
                    st16_wt(wt_r_, (unsigned)((const char*)(rowp + bj * HALF) - (const char*)wt_base_), w); } }
    }
};
struct EpiGateY2 {
    static constexpr bool PERM = true, AFTER_DRAIN = false;
    const bf16_t* U; bf16_t* Y; bool dry;
    __device__ __forceinline__ void operator()(const f32x4 (&acc)[2][2][4][2], const Unit& u, int wr, int wc, int fr, int fq) const {
        const int branch = u.pn >> 2, pnr = u.pn & 3;
        const size_t r0 = (size_t)(u.pm * BM + wr * 64 + fr); const int c0 = pnr * BM + wc * 32 + 8 * fq;
        const __amdgpu_buffer_rsrc_t yr_ = wt_rsrc(Y);
#pragma unroll
        for (int ai = 0; ai < 2; ++ai)
#pragma unroll
            for (int m = 0; m < 4; ++m) { const size_t row = r0 + ai * HALF + m * 16;
#pragma unroll
                for (int bj = 0; bj < 2; ++bj) { const f32x4 v0 = acc[ai][bj][m][0], v1 = acc[ai][bj][m][1];
                    const u32x4e g = __builtin_nontemporal_load((const u32x4e*)(U + row * 3072 + branch * 1024 + c0 + bj * HALF));
                    bf16_t* yp = Y + row * 1024 + c0 + bj * HALF;
                    float y[8];
                    y[0] = sigmoidf_(v0[0]) * __uint_as_float(g.x << 16); y[1] = sigmoidf_(v0[1]) * __uint_as_float(g.x & 0xffff0000u); y[2] = sigmoidf_(v0[2]) * __uint_as_float(g.y << 16); y[3] = sigmoidf_(v0[3]) * __uint_as_float(g.y & 0xffff0000u);
                    y[4] = sigmoidf_(v1[0]) * __uint_as_float(g.z << 16); y[5] = sigmoidf_(v1[1]) * __uint_as_float(g.z & 0xffff0000u); y[6] = sigmoidf_(v1[2]) * __uint_as_float(g.w << 16); y[7] = sigmoidf_(v1[3]) * __uint_as_float(g.w & 0xffff0000u);
                    if (branch != 0) { const u32x4e p = *(const u32x4e*)yp;
                        y[0] += __uint_as_float(p.x << 16); y[1] += __uint_as_float(p.x & 0xffff0000u); y[2] += __uint_as_float(p.y << 16); y[3] += __uint_as_float(p.y & 0xffff0000u);
                        y[4] += __uint_as_float(p.z << 16); y[5] += __uint_as_float(p.z & 0xffff0000u); y[6] += __uint_as_float(p.w << 16); y[7] += __uint_as_float(p.w & 0xffff0000u); }
                    u32x4e w; w.x = cvt_pk_bf16(y[0], y[1]); w.y = cvt_pk_bf16(y[2], y[3]); w.z = cvt_pk_bf16(y[4], y[5]); w.w = cvt_pk_bf16(y[6], y[7]);
                    if (!dry) st16_wt(yr_, (unsigned)((const char*)yp - (const char*)Y), w); } }
    }
};
struct MergeOrder {
    StaticOrder so; int G, c;
    __host__ __device__ void init(int M_, int G_, int c_) { so.init(M_, 1024, 256, 0); G = G_; c = c_; }
    __host__ __device__ bool next(int i, Unit& u) const {
        const int tile = c + (i / 3) * G, branch = i % 3; if (tile >= 256) return false;
        StaticOrder t = so; t.c = tile; Unit v; t.next(0, v);
        u.pm = v.pm; u.pn = branch * 4 + v.pn; return true;
    }
    __device__ __forceinline__ void a_ready(const Unit&) const {}
    __device__ __forceinline__ void done(const Unit&) const {}
};
struct EpiSwiglu {
    static constexpr bool PERM = true, AFTER_DRAIN = false;
    bf16_t* O; int ld;
    __device__ __forceinline__ void operator()(const f32x4 (&acc)[2][2][4][2], const Unit& u, int wr, int wc, int fr, int fq) const {
        bf16_t* base = O + (size_t)(u.pm * BM + wr * 64 + fr) * ld + u.pn * HALF + wc * 32 + 8 * fq;
        const bf16_t* wt_base_ = O; const __amdgpu_buffer_rsrc_t wt_r_ = wt_rsrc(wt_base_);
#pragma unroll
        for (int ai = 0; ai < 2; ++ai)
#pragma unroll
            for (int m = 0; m < 4; ++m) { bf16_t* rowp = base + (size_t)(ai * HALF + m * 16) * ld;
                f32x4 v0 = acc[ai][0][m][0], v1 = acc[ai][0][m][1]; const f32x4 u0 = acc[ai][1][m][0], u1 = acc[ai][1][m][1];
#pragma unroll
                for (int e = 0; e < 4; ++e) { v0[e] = v0[e] * sigmoidf_(v0[e]) * u0[e]; v1[e] = v1[e] * sigmoidf_(v1[e]) * u1[e]; }
                u32x4e w; w.x = cvt_pk_bf16(v0[0], v0[1]); w.y = cvt_pk_bf16(v0[2], v0[3]); w.z = cvt_pk_bf16(v1[0], v1[1]); w.w = cvt_pk_bf16(v1[2], v1[3]);
                st16_wt(wt_r_, (unsigned)((const char*)rowp - (const char*)wt_base_), w); }
    }
};
struct UpOrder {
    StaticOrder so; int G, c;
    __host__ __device__ void init(int M_, int G_, int c_) { so.init(M_, 1024, 256, 0); G = G_; c = c_; }
    __host__ __device__ bool next(int i, Unit& u) const {
        const int tile = c + (i / 3) * G, branch = i % 3; if (tile >= 256) return false;
        StaticOrder t = so; t.c = tile; Unit v; t.next(0, v);
        u.pm = branch * 64 + v.pm; u.pn = branch * 4 + v.pn; return true;
    }
    __device__ __forceinline__ void a_ready(const Unit&) const {}
    __device__ __forceinline__ void done(const Unit&) const {}
};
}

constexpr int NB = 8, SEQ = 2048, DM = 1024, M = NB * SEQ;
constexpr int NMEM = 256, MMEM = NB * NMEM;
constexpr int DFF = 2816, DIN = 7456, NA = 4608;
constexpr float RMS_EPS = 1e-6f;
constexpr int NWAVES = 8, NTHREADS = 512;

constexpr size_t MiB = 1u << 20;
constexpr size_t WS_CTL = 0, CTL_ZERO_BYTES = 64 * 1024;
constexpr size_t WS_W = 1 * MiB;
constexpr size_t W_A = WS_W, W_M = W_A + (size_t)NA * 1024 * 2, W_C1K = W_M + 3072ull * 1024 * 2, W_C1V = W_C1K + 512ull * 1024 * 2,
                 W_UP = W_C1V + 512ull * 1024 * 2, W_OUT3 = W_UP + 3072ull * 512 * 2, W_MQ = W_OUT3 + 1024ull * 3072 * 2, W_MKV = W_MQ + 256ull * 1024 * 2,
                 W_MO = W_MKV + 512ull * 1024 * 2, W_GU = W_MO + 1024ull * 256 * 2, W_DN = W_GU + 5632ull * 1024 * 2, W_B1PART = W_DN + 1024ull * 2816 * 2,
                 W_END = W_B1PART + 2ull * 32 * 256 * 4;
constexpr size_t WS_H = 47 * MiB;
constexpr size_t WS_OQ = 79 * MiB;
constexpr size_t WS_KV = 127 * MiB;
constexpr size_t WS_MG = WS_KV;
constexpr size_t WS_ACT = WS_OQ;
constexpr size_t WS_MQ = WS_OQ, WS_MO = WS_OQ + 32 * MiB;
constexpr size_t WS_MISC = 223 * MiB;
constexpr size_t WS_CF = WS_MISC;
constexpr size_t WS_KCMP = WS_CF + 512 * 1024, WS_VCMP = WS_KCMP + 256 * 1024, WS_SELM = WS_VCMP + 256 * 1024;
constexpr size_t WS_MEMN = WS_MISC + 3 * MiB / 2;
constexpr size_t WS_MEMKV = WS_MEMN + 4 * MiB;
constexpr size_t WS_PSLC = WS_MEMKV + 2 * MiB;
constexpr size_t WS_OCMP = WS_PSLC + 4 * MiB;
constexpr size_t WS_CK = WS_OCMP, WS_CV = WS_CK + 4 * MiB, WS_PK = WS_CV + 4 * MiB, WS_PV = WS_PK + 2 * MiB;
constexpr size_t WS_END = WS_OCMP + 16 * MiB;
static_assert(W_END <= WS_H && WS_H + 32 * MiB == WS_OQ && WS_OQ + 48 * MiB == WS_KV && WS_KV + 96 * MiB == WS_MISC && WS_END <= 256 * MiB && WS_PV + 2 * MiB <= WS_END, "ws map");
constexpr int CW_BAR = 4096, CW_SB = 8192, CW_CVB = 8192 + 32 * 64;

typedef unsigned short bf16;
typedef float f32x4 __attribute__((ext_vector_type(4)));
typedef unsigned u32x4 __attribute__((ext_vector_type(4)));
typedef unsigned u32x2 __attribute__((ext_vector_type(2)));

__device__ __forceinline__ float bf2f(unsigned short b) { return __uint_as_float((unsigned)b << 16); }
__device__ __forceinline__ unsigned pk2(float lo, float hi) { return pg8::cvt_pk_bf16(lo, hi); }
__device__ __forceinline__ unsigned short f2bf(float f) { return (unsigned short)(pk2(f, 0.f) & 0xffffu); }
__device__ __forceinline__ float wave_sum(float v) {
#pragma unroll
    for (int o = 1; o < 64; o <<= 1) v += __shfl_xor(v, o);
    return v;
}
__device__ __forceinline__ float sigm(float x) { return __builtin_amdgcn_rcpf(1.0f + __expf(-x)); }
__device__ __forceinline__ float logsig(float x) { return fminf(x, 0.f) - log1pf(__expf(-fabsf(x))); }

struct Args { const void* in[31]; float* out; unsigned char* ws; int ph_lo, ph_hi; };

struct MapOff { int off; float s; __device__ __forceinline__ int row(int n) const { return n + off; } __device__ __forceinline__ float sc(int) const { return s; } };
struct MapA {
    __device__ __forceinline__ int row(int n) const { return n < 2816 ? n : (n < 2840 ? n + 1536 : (n < 4376 ? n - 24 : n)); }
    __device__ __forceinline__ float sc(int n) const { return (n < 512 || (n >= 1536 && n < 2048) || (n >= 2840 && n < 3352)) ? 0.125f : 1.0f; }
};
struct MapGU { int half; __device__ __forceinline__ int row(int n) const { return (n >> 7) * 256 + half * 128 + (n & 127); } __device__ __forceinline__ float sc(int) const { return 1.0f; } };

template <class Map>
__device__ __forceinline__ void conv_item(const float* W, int N, int ldw, bf16* WT, int ldt, int dk0, const Map map, LAS float* scr, int it, int lane) {
    const int nblk = N / 32, kb = it / nblk, nb = it % nblk, k0 = 64 * kb, n0 = 32 * nb;
    const float* src = W + (size_t)(k0 + (lane >> 3)) * ldw + n0 + 4 * (lane & 7);
    f32x4 v[8];
#pragma unroll
    for (int i = 0; i < 8; ++i) v[i] = *(const f32x4*)(src + (size_t)(8 * i) * ldw);
#pragma unroll
    for (int i = 0; i < 8; ++i) { LAS float* d = scr + (8 * i + (lane >> 3)) * 33 + 4 * (lane & 7); d[0] = v[i].x; d[1] = v[i].y; d[2] = v[i].z; d[3] = v[i].w; }
    asm volatile("s_waitcnt lgkmcnt(0)" ::: "memory");
    const int c = lane & 7;
#pragma unroll
    for (int j = 0; j < 4; ++j) { const int n = (lane >> 3) + 8 * j; const LAS float* s = scr + (8 * c) * 33 + n; const float sc = map.sc(n0 + n);
        u32x4 o; o.x = pk2(s[0 * 33] * sc, s[1 * 33] * sc); o.y = pk2(s[2 * 33] * sc, s[3 * 33] * sc); o.z = pk2(s[4 * 33] * sc, s[5 * 33] * sc); o.w = pk2(s[6 * 33] * sc, s[7 * 33] * sc);
        *(u32x4*)(WT + (size_t)map.row(n0 + n) * ldt + dk0 + k0 + 8 * c) = o; }
    asm volatile("s_waitcnt lgkmcnt(0)" ::: "memory");
}

__device__ __forceinline__ void norm_row_to_bf16(const float* xrow, const float* g, bf16* hrow, int lane) {
    const f32x4* xr = (const f32x4*)xrow + lane; const f32x4* gr = (const f32x4*)g + lane;
    f32x4 v[4]; float s = 0.f;
#pragma unroll
    for (int j = 0; j < 4; ++j) { v[j] = xr[64 * j]; s += (v[j].x * v[j].x + v[j].y * v[j].y) + (v[j].z * v[j].z + v[j].w * v[j].w); }
    const float rstd = __builtin_amdgcn_rsqf(wave_sum(s) * (1.f / DM) + RMS_EPS);
    u32x2* o8 = (u32x2*)hrow + lane;
#pragma unroll
    for (int j = 0; j < 4; ++j) { const f32x4 gg = gr[64 * j]; u32x2 w; w.x = pk2(v[j].x * rstd * gg.x, v[j].y * rstd * gg.y); w.y = pk2(v[j].z * rstd * gg.z, v[j].w * rstd * gg.w); o8[64 * j] = w; }
}
__device__ __forceinline__ void post_norm_row(const bf16* yrow, const float* xs, float* xd, const float* gpost, const float* gpre, bf16* hrow, bool write_h, bool dry, int lane) {
    const u32x2* yr = (const u32x2*)yrow + lane; const f32x4* xr = (const f32x4*)xs + lane;
    f32x4 y[4], x[4]; float s = 0.f;
#pragma unroll
    for (int j = 0; j < 4; ++j) { const u32x2 w = yr[64 * j]; y[j].x = __uint_as_float(w.x << 16); y[j].y = __uint_as_float(w.x & 0xffff0000u); y[j].z = __uint_as_float(w.y << 16); y[j].w = __uint_as_float(w.y & 0xffff0000u);
        x[j] = xr[64 * j]; s += (y[j].x * y[j].x + y[j].y * y[j].y) + (y[j].z * y[j].z + y[j].w * y[j].w); }
    const float rstd = __builtin_amdgcn_rsqf(wave_sum(s) * (1.f / DM) + RMS_EPS);
    float s2 = 0.f;
#pragma unroll
    for (int j = 0; j < 4; ++j) { const f32x4 gg = ((const f32x4*)gpost + lane)[64 * j];
        x[j].x += y[j].x * rstd * gg.x; x[j].y += y[j].y * rstd * gg.y; x[j].z += y[j].z * rstd * gg.z; x[j].w += y[j].w * rstd * gg.w;
        if (!dry) ((f32x4*)xd + lane)[64 * j] = x[j]; s2 += (x[j].x * x[j].x + x[j].y * x[j].y) + (x[j].z * x[j].z + x[j].w * x[j].w); }
    if (write_h && !dry) {
        const float r2 = __builtin_amdgcn_rsqf(wave_sum(s2) * (1.f / DM) + RMS_EPS);
        u32x2* o8 = (u32x2*)hrow + lane;
#pragma unroll
        for (int j = 0; j < 4; ++j) { const f32x4 gg = ((const f32x4*)gpre + lane)[64 * j]; u32x2 w; w.x = pk2(x[j].x * r2 * gg.x, x[j].y * r2 * gg.y); w.y = pk2(x[j].z * r2 * gg.z, x[j].w * r2 * gg.w); o8[64 * j] = w; }
    }
}

__device__ __forceinline__ void post_norm_rows2(const bf16* y0, const bf16* y1, const float* xs0, const float* xs1, float* xd0, float* xd1, const float* gpost, const float* gpre, bf16* h0, bf16* h1, bool write_h, bool dry, int lane) {
    f32x4 y[2][4], x[2][4], gp[4]; u32x2 w[2][4];
#pragma unroll
    for (int j = 0; j < 4; ++j) { w[0][j] = __builtin_nontemporal_load((const u32x2*)y0 + lane + 64 * j); w[1][j] = __builtin_nontemporal_load((const u32x2*)y1 + lane + 64 * j); }
#pragma unroll
    for (int j = 0; j < 4; ++j) { x[0][j] = __builtin_nontemporal_load((const f32x4*)xs0 + lane + 64 * j); x[1][j] = __builtin_nontemporal_load((const f32x4*)xs1 + lane + 64 * j); gp[j] = ((const f32x4*)gpost + lane)[64 * j]; }
    float s[2] = {0.f, 0.f};
#pragma unroll
    for (int q = 0; q < 2; ++q)
#pragma unroll
        for (int j = 0; j < 4; ++j) { y[q][j].x = __uint_as_float(w[q][j].x << 16); y[q][j].y = __uint_as_float(w[q][j].x & 0xffff0000u); y[q][j].z = __uint_as_float(w[q][j].y << 16); y[q][j].w = __uint_as_float(w[q][j].y & 0xffff0000u);
            s[q] += (y[q][j].x * y[q][j].x + y[q][j].y * y[q][j].y) + (y[q][j].z * y[q][j].z + y[q][j].w * y[q][j].w); }
#pragma unroll
    for (int o = 1; o < 64; o <<= 1) { s[0] += __shfl_xor(s[0], o); s[1] += __shfl_xor(s[1], o); }
    float s2[2] = {0.f, 0.f};
#pragma unroll
    for (int q = 0; q < 2; ++q) { const float rstd = __builtin_amdgcn_rsqf(s[q] * (1.f / DM) + RMS_EPS); float* xd = q ? xd1 : xd0;
#pragma unroll
        for (int j = 0; j < 4; ++j) {
            x[q][j].x += y[q][j].x * rstd * gp[j].x; x[q][j].y += y[q][j].y * rstd * gp[j].y; x[q][j].z += y[q][j].z * rstd * gp[j].z; x[q][j].w += y[q][j].w * rstd * gp[j].w;
            if (!dry) __builtin_nontemporal_store(x[q][j], (f32x4*)xd + lane + 64 * j); s2[q] += (x[q][j].x * x[q][j].x + x[q][j].y * x[q][j].y) + (x[q][j].z * x[q][j].z + x[q][j].w * x[q][j].w); } }
    if (write_h && !dry) {
#pragma unroll
        for (int o = 1; o < 64; o <<= 1) { s2[0] += __shfl_xor(s2[0], o); s2[1] += __shfl_xor(s2[1], o); }
#pragma unroll
        for (int j = 0; j < 4; ++j) gp[j] = ((const f32x4*)gpre + lane)[64 * j];
#pragma unroll
        for (int q = 0; q < 2; ++q) { const float r2 = __builtin_amdgcn_rsqf(s2[q] * (1.f / DM) + RMS_EPS); const __amdgpu_buffer_rsrc_t hr_ = pg8::wt_rsrc(q ? h1 : h0);
#pragma unroll
            for (int j = 0; j < 4; ++j) { u32x2 ww; ww.x = pk2(x[q][j].x * r2 * gp[j].x, x[q][j].y * r2 * gp[j].y); ww.y = pk2(x[q][j].z * r2 * gp[j].z, x[q][j].w * r2 * gp[j].w); __builtin_amdgcn_raw_buffer_store_b64(ww, hr_, (lane + 64 * j) * 8, 0, 16); } }
    }
}

__device__ __forceinline__ void rope_cs(int pos, int i, float& c, float& s) {
    float hi, lo;
    switch (i) { case 0: hi = 0.1591796875f; lo = -2.474440771038644e-05f; break; case 1: hi = 0.0308685302734375f; lo = -4.76686864203657e-06f; break;
                 case 2: hi = 0.005985260009765625f; lo = -7.429704851347196e-08f; break; case 3: hi = 0.0011606216430664062f; lo = 4.1998173827551e-08f; break;
                 case 4: hi = 0.000225067138671875f; lo = 1.1940367805607366e-08f; break; case 5: hi = 4.366040229797363e-05f; lo = -1.2449505426559426e-08f; break;
                 case 6: hi = 8.463859558105469e-06f; lo = 4.712501500137023e-10f; break; default: hi = 1.6409903764724731e-06f; lo = 4.3588632703261965e-10f; break; }
    const float fp = (float)pos, p = fp * hi, fr = (p - rintf(p)) + fp * lo;
    c = __builtin_amdgcn_cosf(fr); s = __builtin_amdgcn_sinf(fr);
}

typedef __attribute__((address_space(4))) const unsigned char* kptr_t;
struct KA {
    kptr_t kp;
    __device__ __forceinline__ void refresh() { kp = (kptr_t)__builtin_amdgcn_kernarg_segment_ptr(); asm volatile("" : "+s"(kp)); }
    __device__ __forceinline__ const void* in(int i) const { return (const void*)(const GAS void*)(*(const __attribute__((address_space(4))) unsigned long long*)(kp + 8 * i)); }
    __device__ __forceinline__ float* out() const { return (float*)(GAS float*)(*(const __attribute__((address_space(4))) unsigned long long*)(kp + 8 * 31)); }
    __device__ __forceinline__ unsigned char* ws() const { return (unsigned char*)(GAS unsigned char*)(*(const __attribute__((address_space(4))) unsigned long long*)(kp + 8 * 32)); }
    __device__ __forceinline__ int ph_lo() const { return *(const __attribute__((address_space(4))) int*)(kp + 8 * 33); }
    __device__ __forceinline__ int ph_hi() const { return *(const __attribute__((address_space(4))) int*)(kp + 8 * 33 + 4); }
};
struct Frame {
    LAS unsigned char* lds;
    int tid, lane, wave, G, bid;
    int gw, ngw;
    int gt, ngt;
};

struct ConvDesc { const float* src; int ldw; bf16* dst; int ldt; int kd; int n0; int kind; int par; float sc; };
#define CVD(Wp, K_, N_, LDW_, DST_, LDT_, DK0_, KIND_, PAR_, SC_) { constexpr int n_ = ((N_) / 32) * ((K_) / 64); if (it < n_) { const int nblk = (N_) / 32, kb = it / nblk, nb = it % nblk; \
    d.src = (Wp) + (size_t)(64 * kb + (lane >> 3)) * (LDW_) + 32 * nb + 4 * (lane & 7); d.ldw = (LDW_); d.dst = (DST_); d.ldt = (LDT_); d.kd = (DK0_) + 64 * kb; d.n0 = 32 * nb; d.kind = (KIND_); d.par = (PAR_); d.sc = (SC_); return; } it -= n_; }
constexpr int N_CONV = 2192 + 1536 + 4 * 128 + 3 * 256 + 512 + 128 + 2 * 128 + 128 + 2 * 1408 + 1408;
__device__ __forceinline__ void conv_decode(ConvDesc& d, const KA& a, unsigned char* ws, int l, int it, int lane) {
    CVD((const float*)a.in(10) + (size_t)l * DM * DIN, DM, 4384, DIN, (bf16*)(ws + W_A), DM, 0, 1, 0, 1.0f)
    CVD((const float*)a.in(10) + (size_t)l * DM * DIN + 4384, DM, 3072, DIN, (bf16*)(ws + W_M), DM, 0, 0, 0, 1.0f)
    CVD((const float*)a.in(13) + (size_t)l * 2048 * 256, 1024, 256, 256, (bf16*)(ws + W_C1K), 1024, 0, 0, 0, 1.0f)
    CVD((const float*)a.in(13) + (size_t)l * 2048 * 256 + 1024 * 256, 1024, 256, 256, (bf16*)(ws + W_C1K), 1024, 0, 0, 256, 1.0f)
    CVD((const float*)a.in(17) + (size_t)l * 2048 * 256, 1024, 256, 256, (bf16*)(ws + W_C1V), 1024, 0, 0, 0, 1.0f)
    CVD((const float*)a.in(17) + (size_t)l * 2048 * 256 + 1024 * 256, 1024, 256, 256, (bf16*)(ws + W_C1V), 1024, 0, 0, 256, 1.0f)
    CVD((const float*)a.in(20) + (size_t)l * 512 * DM, 512, DM, DM, (bf16*)(ws + W_UP), 512, 0, 0, 0, 1.0f)
    CVD((const float*)a.in(21) + (size_t)l * 512 * DM, 512, DM, DM, (bf16*)(ws + W_UP), 512, 0, 0, 1024, 1.0f)
    CVD((const float*)a.in(22) + (size_t)l * 512 * DM, 512, DM, DM, (bf16*)(ws + W_UP), 512, 0, 0, 2048, 1.0f)
    CVD((const float*)a.in(23) + (size_t)l * DM * DM, DM, DM, DM, (bf16*)(ws + W_OUT3), DM, 0, 0, 0, 1.0f)
    CVD((const float*)a.in(24) + (size_t)l * DM * 256, DM, 256, 256, (bf16*)(ws + W_MQ), DM, 0, 0, 0, 0.125f)
    CVD((const float*)a.in(25) + (size_t)l * DM * 256, DM, 256, 256, (bf16*)(ws + W_MKV), DM, 0, 0, 0, 1.0f)
    CVD((const float*)a.in(26) + (size_t)l * DM * 256, DM, 256, 256, (bf16*)(ws + W_MKV), DM, 0, 0, 256, 1.0f)
    CVD((const float*)a.in(27) + (size_t)l * 256 * DM, 256, DM, DM, (bf16*)(ws + W_MO), 256, 0, 0, 0, 1.0f)
    CVD((const float*)a.in(28) + (size_t)l * DM * DFF, DM, DFF, DFF, (bf16*)(ws + W_GU), DM, 0, 2, 0, 1.0f)
    CVD((const float*)a.in(29) + (size_t)l * DM * DFF, DM, DFF, DFF, (bf16*)(ws + W_GU), DM, 0, 2, 1, 1.0f)
    CVD((const float*)a.in(30) + (size_t)l * DFF * DM, DFF, DM, DM, (bf16*)(ws + W_DN), DFF, 0, 0, 0, 1.0f)
}
#undef CVD
__device__ __forceinline__ void conv_load(const ConvDesc& d, f32x4 (&v)[8]) {
#pragma unroll
    for (int i = 0; i < 8; ++i) v[i] = __builtin_nontemporal_load((const f32x4*)(d.src + (size_t)(8 * i) * d.ldw));
}
__device__ __forceinline__ void conv_finish(const ConvDesc& d, const f32x4 (&v)[8], LAS float* scr, int lane) {
#pragma unroll
    for (int i = 0; i < 8; ++i) { LAS float* p = scr + (8 * i + (lane >> 3)) * 33 + 4 * (lane & 7); p[0] = v[i].x; p[1] = v[i].y; p[2] = v[i].z; p[3] = v[i].w; }
    asm volatile("s_waitcnt lgkmcnt(0)" ::: "memory");
    const int c = lane & 7;
#pragma unroll
    for (int j = 0; j < 4; ++j) { const int n = (lane >> 3) + 8 * j, gn = d.n0 + n; const LAS float* s = scr + (8 * c) * 33 + n;
        const int row = d.kind == 0 ? gn + d.par : (d.kind == 1 ? MapA{}.row(gn) : MapGU{d.par}.row(gn));
        const float sc = d.kind == 1 ? MapA{}.sc(gn) : d.sc;
        u32x4 o; o.x = pk2(s[0 * 33] * sc, s[1 * 33] * sc); o.y = pk2(s[2 * 33] * sc, s[3 * 33] * sc); o.z = pk2(s[4 * 33] * sc, s[5 * 33] * sc); o.w = pk2(s[6 * 33] * sc, s[7 * 33] * sc);
        *(u32x4*)(d.dst + (size_t)row * d.ldt + d.kd + 8 * c) = o; }
    asm volatile("s_waitcnt lgkmcnt(0)" ::: "memory");
}
__device__ __forceinline__ void norm_rows4_to_bf16(const float* x0, const float* g, bf16* h0, int lane) {
    f32x4 v[4][4], gg[4]; float s[4] = {0.f, 0.f, 0.f, 0.f};
#pragma unroll
    for (int q = 0; q < 4; ++q)
#pragma unroll
        for (int j = 0; j < 4; ++j) v[q][j] = __builtin_nontemporal_load((const f32x4*)(x0 + (size_t)q * DM) + lane + 64 * j);
#pragma unroll
    for (int j = 0; j < 4; ++j) gg[j] = ((const f32x4*)g + lane)[64 * j];
#pragma unroll
    for (int q = 0; q < 4; ++q)
#pragma unroll
        for (int j = 0; j < 4; ++j) s[q] += (v[q][j].x * v[q][j].x + v[q][j].y * v[q][j].y) + (v[q][j].z * v[q][j].z + v[q][j].w * v[q][j].w);
#pragma unroll
    for (int o = 1; o < 64; o <<= 1) { s[0] += __shfl_xor(s[0], o); s[1] += __shfl_xor(s[1], o); s[2] += __shfl_xor(s[2], o); s[3] += __shfl_xor(s[3], o); }
#pragma unroll
    for (int q = 0; q < 4; ++q) { const float rstd = __builtin_amdgcn_rsqf(s[q] * (1.f / DM) + RMS_EPS); u32x2* o8 = (u32x2*)(h0 + (size_t)q * DM) + lane;
#pragma unroll
        for (int j = 0; j < 4; ++j) { u32x2 w; w.x = pk2(v[q][j].x * rstd * gg[j].x, v[q][j].y * rstd * gg[j].y); w.y = pk2(v[q][j].z * rstd * gg[j].z, v[q][j].w * rstd * gg[j].w); o8[64 * j] = w; } }
}
struct ConvB { const float* src; int ldw; bf16* dst; int ldt; int kd; int n0; int kind; int par; float sc; };
#define CVB(Wp, K_, N_, LDW_, DST_, LDT_, DK0_, KIND_, PAR_, SC_) { constexpr int nb_ = (N_) / 256, n_ = nb_ * ((K_) / 64); if (it < n_) { const int kb = it / nb_, nb = it % nb_; \
    d.src = (Wp) + (size_t)(64 * kb) * (LDW_) + 256 * nb; d.ldw = (LDW_); d.dst = (DST_); d.ldt = (LDT_); d.kd = (DK0_) + 64 * kb; d.n0 = 256 * nb; d.kind = (KIND_); d.par = (PAR_); d.sc = (SC_); return; } it -= n_; }
constexpr int N_CONVB = 16 * 17 + 16 * 12 + 4 * 16 + 3 * 32 + 64 + 16 + 2 * 16 + 16 + 2 * 176 + 176;
constexpr int N_CONVA = N_CONVB - (2 * 176 + 176);
__device__ __forceinline__ void convb_decode(ConvB& d, const KA& a, unsigned char* ws, int l, int it) {
    CVB((const float*)a.in(10) + (size_t)l * DM * DIN, DM, 4352, DIN, (bf16*)(ws + W_A), DM, 0, 1, 0, 1.0f)
    CVB((const float*)a.in(10) + (size_t)l * DM * DIN + 4384, DM, 3072, DIN, (bf16*)(ws + W_M), DM, 0, 0, 0, 1.0f)
    CVB((const float*)a.in(13) + (size_t)l * 2048 * 256, 1024, 256, 256, (bf16*)(ws + W_C1K), 1024, 0, 0, 0, 1.0f)
    CVB((const float*)a.in(13) + (size_t)l * 2048 * 256 + 1024 * 256, 1024, 256, 256, (bf16*)(ws + W_C1K), 1024, 0, 0, 256, 1.0f)
    CVB((const float*)a.in(17) + (size_t)l * 2048 * 256, 1024, 256, 256, (bf16*)(ws + W_C1V), 1024, 0, 0, 0, 1.0f)
    CVB((const float*)a.in(17) + (size_t)l * 2048 * 256 + 1024 * 256, 1024, 256, 256, (bf16*)(ws + W_C1V), 1024, 0, 0, 256, 1.0f)
    CVB((const float*)a.in(20) + (size_t)l * 512 * DM, 512, DM, DM, (bf16*)(ws + W_UP), 512, 0, 0, 0, 1.0f)
    CVB((const float*)a.in(21) + (size_t)l * 512 * DM, 512, DM, DM, (bf16*)(ws + W_UP), 512, 0, 0, 1024, 1.0f)
    CVB((const float*)a.in(22) + (size_t)l * 512 * DM, 512, DM, DM, (bf16*)(ws + W_UP), 512, 0, 0, 2048, 1.0f)
    CVB((const float*)a.in(23) + (size_t)l * DM * DM, DM, DM, DM, (bf16*)(ws + W_OUT3), DM, 0, 0, 0, 1.0f)
    CVB((const float*)a.in(24) + (size_t)l * DM * 256, DM, 256, 256, (bf16*)(ws + W_MQ), DM, 0, 0, 0, 0.125f)
    CVB((const float*)a.in(25) + (size_t)l * DM * 256, DM, 256, 256, (bf16*)(ws + W_MKV), DM, 0, 0, 0, 1.0f)
    CVB((const float*)a.in(26) + (size_t)l * DM * 256, DM, 256, 256, (bf16*)(ws + W_MKV), DM, 0, 0, 256, 1.0f)
    CVB((const float*)a.in(27) + (size_t)l * 256 * DM, 256, DM, DM, (bf16*)(ws + W_MO), 256, 0, 0, 0, 1.0f)
    CVB((const float*)a.in(28) + (size_t)l * DM * DFF, DM, DFF, DFF, (bf16*)(ws + W_GU), DM, 0, 2, 0, 1.0f)
    CVB((const float*)a.in(29) + (size_t)l * DM * DFF, DM, DFF, DFF, (bf16*)(ws + W_GU), DM, 0, 2, 1, 1.0f)
    CVB((const float*)a.in(30) + (size_t)l * DFF * DM, DFF, DM, DM, (bf16*)(ws + W_DN), DFF, 0, 0, 0, 1.0f)
}
#undef CVB
__device__ __forceinline__ void convb_load(const ConvB& d, f32x4 (&v)[8], int wave, int lane) {
#pragma unroll
    for (int i = 0; i < 8; ++i) v[i] = __builtin_nontemporal_load((const f32x4*)(d.src + (size_t)(8 * wave + i) * d.ldw + 4 * lane));
}
__device__ __forceinline__ void convb_finish(const ConvB& d, const f32x4 (&v)[8], LAS float* scr, int tid, int wave, int lane) {
#pragma unroll
    for (int i = 0; i < 8; ++i) { LAS float* p = scr + (8 * wave + i) * 257 + 4 * lane; p[0] = v[i].x; p[1] = v[i].y; p[2] = v[i].z; p[3] = v[i].w; }
    __syncthreads();
#pragma unroll
    for (int j = 0; j < 4; ++j) { const int pc = tid + 512 * j, n = pc >> 3, c = pc & 7, gn = d.n0 + n; const LAS float* s = scr + (8 * c) * 257 + n;
        const int row = d.kind == 0 ? gn + d.par : (d.kind == 1 ? MapA{}.row(gn) : MapGU{d.par}.row(gn));
        const float sc = d.kind == 1 ? MapA{}.sc(gn) : d.sc;
        u32x4 o; o.x = pk2(s[0 * 257] * sc, s[1 * 257] * sc); o.y = pk2(s[2 * 257] * sc, s[3 * 257] * sc); o.z = pk2(s[4 * 257] * sc, s[5 * 257] * sc); o.w = pk2(s[6 * 257] * sc, s[7 * 257] * sc);
        *(u32x4*)(d.dst + (size_t)row * d.ldt + d.kd + 8 * c) = o; }
    __syncthreads();
}
__device__ __forceinline__ void phase_conv(const Frame& F, const KA& a, int l) {
    unsigned char* ws = a.ws();
    const int gw = F.gw, ngw = F.ngw, lane = F.lane;
    {
        LAS float* scr = (LAS float*)F.lds;
        ConvB da, db; f32x4 va[8], vb[8];
        int i0 = F.bid;
        if (i0 < N_CONVA) { convb_decode(da, a, ws, l, i0); convb_load(da, va, F.wave, lane); }
        for (; i0 < N_CONVA; i0 += 2 * F.G) {
            const int i1 = i0 + F.G, i2 = i1 + F.G; const bool h1 = i1 < N_CONVA, h2 = i2 < N_CONVA;
            if (h1) { convb_decode(db, a, ws, l, i1); convb_load(db, vb, F.wave, lane); }
            convb_finish(da, va, scr, F.tid, F.wave, lane);
            if (h2) { convb_decode(da, a, ws, l, i2); convb_load(da, va, F.wave, lane); }
            if (h1) convb_finish(db, vb, scr, F.tid, F.wave, lane);
        }
    }
    {
        LAS float* scr = (LAS float*)(F.lds + F.wave * 16384);
        for (int it = ngw - 1 - gw; it < 16; it += ngw) { ConvDesc d; f32x4 v[8];
            d.src = (const float*)a.in(10) + (size_t)l * DM * DIN + (size_t)(64 * it + (lane >> 3)) * DIN + 4352 + 4 * (lane & 7); d.ldw = DIN; d.dst = (bf16*)(ws + W_A); d.ldt = DM; d.kd = 64 * it; d.n0 = 4352; d.kind = 1; d.par = 0; d.sc = 1.0f;
            conv_load(d, v); conv_finish(d, v, scr, lane); }
    }
    __syncthreads();
    const int n_other = 14 + 64 + 512 + (l == 0 ? 4096 : 0);
    for (int it0 = ngw - 1 - gw; it0 < n_other; it0 += ngw) {
        int it = it0;
        if (it < 14) {
            u32x4* z = (u32x4*)(ws + W_A + (4384ull + 16 * it) * DM * 2) + lane; unsigned zz = 0u; asm volatile("" : "+v"(zz));
#pragma unroll 8
            for (int i = 0; i < 32; ++i) z[64 * i] = (u32x4){zz, zz, zz, zz};
            continue; }
        it -= 14;
        if (it < 64) {
            const int m = it >> 5, s = it & 31;
            const float* pe = (m ? (const float*)a.in(16) : (const float*)a.in(12)) + (size_t)l * 2048 + s * 64;
            const float* w1 = (m ? (const float*)a.in(17) : (const float*)a.in(13)) + (size_t)l * 2048 * 256 + (size_t)(s * 64) * 256;
            f32x4 acc = (f32x4){0.f, 0.f, 0.f, 0.f};
#pragma unroll 8
            for (int k = 0; k < 64; ++k) { const float p = pe[k]; const f32x4 w = ((const f32x4*)(w1 + (size_t)k * 256))[lane]; acc.x += p * w.x; acc.y += p * w.y; acc.z += p * w.z; acc.w += p * w.w; }
            ((f32x4*)((float*)(ws + W_B1PART) + (size_t)(m * 32 + s) * 256))[lane] = acc;
            continue; }
        it -= 64;
        if (it < 512) { norm_rows4_to_bf16((const float*)a.in(1) + (size_t)(4 * it) * DM, (const float*)a.in(6) + (size_t)l * DM, (bf16*)(ws + WS_MEMN) + (size_t)(4 * it) * DM, lane); continue; }
        it -= 512;
        norm_rows4_to_bf16((const float*)a.in(0) + (size_t)(4 * it) * DM, (const float*)a.in(3), (bf16*)(ws + WS_H) + (size_t)(4 * it) * DM, lane);
    }
}

__device__ __forceinline__ void phase_conv_b(const Frame& F, const KA& a, int l) {
    unsigned char* ws = a.ws();
    LAS float* scr = (LAS float*)F.lds;
    LAS unsigned* qslot = (LAS unsigned*)(F.lds + 66048);
    unsigned* ctr = (unsigned*)(ws + WS_CTL) + CW_CVB + 64 * (unsigned)l;
    for (;;) {
        if (F.tid == 0) *qslot = __hip_atomic_fetch_add(ctr, 1u, __ATOMIC_RELAXED, __HIP_MEMORY_SCOPE_AGENT);
        __syncthreads();
        const unsigned k_ = *qslot;
        __syncthreads();
        if (k_ >= (unsigned)(N_CONVB - N_CONVA)) break;
        ConvB d; f32x4 v[8];
        convb_decode(d, a, ws, l, N_CONVA + (int)k_); convb_load(d, v, F.wave, F.lane);
        convb_finish(d, v, scr, F.tid, F.wave, F.lane);
    }
}

__device__ __forceinline__ void phase_post(const Frame& F, const KA& a, int l, bool dry) {
    unsigned char* ws = a.ws();
    bf16* nsakv = (bf16*)(ws + WS_KV + 64 * MiB);
    const bf16* small = (const bf16*)(ws + WS_KV + 88 * MiB);
    const int* pos = (const int*)a.in(2);
    for (int it = F.gt; it < M * 32; it += F.ngt) {
        const int tok = it >> 5, r = it & 31, which = r >> 4, g = (r >> 3) & 1, i = r & 7;
        bf16* p = nsakv + (size_t)tok * 768 + 256 + which * 256 + g * 64 + i;
        float c, s; rope_cs(pos[tok], i, c, s);
        const float x1 = bf2f(p[0]), x2 = bf2f(p[8]);
        if (!dry) { p[0] = f2bf(x1 * c - x2 * s); p[8] = f2bf(x2 * c + x1 * s); }
    }
    if (F.bid >= 64 && F.bid < 128) {
        const int it = F.bid - 64, b = it >> 3, h = it & 7; const float bias = ((const float*)a.in(11))[l * 8 + h];
        const bf16* fp = small + ((size_t)b * SEQ + 4 * F.tid) * 256 + 24 + h;
        float v0 = logsig(bf2f(fp[0]) + bias), v1 = logsig(bf2f(fp[256]) + bias), v2 = logsig(bf2f(fp[512]) + bias), v3 = logsig(bf2f(fp[768]) + bias);
        v1 += v0; v2 += v1; v3 += v2;
        float inc = v3;
#pragma unroll
        for (int o = 1; o < 64; o <<= 1) { const float t = __shfl_up(inc, o); if (F.lane >= o) inc += t; }
        LAS float* wtot = (LAS float*)F.lds;
        if (F.lane == 63) wtot[F.wave] = inc;
        __syncthreads();
        float base = inc - v3;
        for (int w = 0; w < F.wave; ++w) base += wtot[w];
        *(f32x4*)((float*)(ws + WS_CF) + ((size_t)b * 8 + h) * SEQ + 4 * F.tid) = (f32x4){base + v0, base + v1, base + v2, base + v3};
        __syncthreads();
    }
}

__device__ __forceinline__ void phase_cmp2(const Frame& F, const KA& a, int l) {
    unsigned char* ws = a.ws();
    LAS float* b1p = (LAS float*)F.lds;
    LAS float* hid = (LAS float*)(F.lds + 4096) + F.wave * 256;
    {
        const int m = F.tid >> 8, j = F.tid & 255;
        const float* part = (const float*)(ws + W_B1PART) + (size_t)m * 32 * 256 + j;
        float s = (m ? (const float*)a.in(18) : (const float*)a.in(14))[l * 256 + j];
        for (int i = 0; i < 32; ++i) s += part[i * 256];
        b1p[m * 256 + j] = s;
    }
    __syncthreads();
    for (int it = F.gw; it < 4096; it += F.ngw) {
        const int m = it >> 11, r = it & 2047, b = r >> 8, c = (r >> 1) & 127, g = r & 1;
        bf16* out = (bf16*)(ws + (m ? WS_VCMP : WS_KCMP)) + (((size_t)b * 2 + g) * 128 + c) * 64;
        if (c == 127) { out[F.lane] = 0; continue; }
        const bf16* P = (const bf16*)(ws + (m ? WS_PV : WS_PK)) + ((size_t)g * 1024 + b * 128 + c) * 512;
        const u32x2 p1 = *(const u32x2*)(P + 4 * F.lane), p2 = *(const u32x2*)(P + 512 + 256 + 4 * F.lane);
        float hv[4];
        hv[0] = __uint_as_float(p1.x << 16) + __uint_as_float(p2.x << 16); hv[1] = __uint_as_float(p1.x & 0xffff0000u) + __uint_as_float(p2.x & 0xffff0000u);
        hv[2] = __uint_as_float(p1.y << 16) + __uint_as_float(p2.y << 16); hv[3] = __uint_as_float(p1.y & 0xffff0000u) + __uint_as_float(p2.y & 0xffff0000u);
#pragma unroll
        for (int e = 0; e < 4; ++e) { const float x = hv[e] + b1p[m * 256 + 4 * F.lane + e]; hid[4 * F.lane + e] = x * sigm(x); }
        asm volatile("s_waitcnt lgkmcnt(0)" ::: "memory");
        const float* w2 = (m ? (const float*)a.in(19) : (const float*)a.in(15)) + (size_t)l * 256 * 64 + F.lane;
        float acc = 0.f;
#pragma unroll 8
        for (int j = 0; j < 256; ++j) acc += hid[j] * w2[j * 64];
        out[F.lane] = f2bf(acc);
        asm volatile("s_waitcnt lgkmcnt(0)" ::: "memory");
    }
    __syncthreads();
}


namespace fa {
typedef short bf16x8 __attribute__((ext_vector_type(8)));
typedef short s16x4 __attribute__((ext_vector_type(4)));
typedef float f32x16 __attribute__((ext_vector_type(16)));
constexpr int KROW = 144;
constexpr int VROW = 192;
constexpr int TILE_B = 64 * KROW;
constexpr int VTILE_B = 64 * VROW;
constexpr int BIAS_OFF = TILE_B + VTILE_B;
constexpr int BUF_B = BIAS_OFF + 256;
constexpr float LOG2E = 1.4426950408889634f;
enum { MODE_NONE = 0, MODE_CAUSAL = 1, MODE_WINDOW = 2, MODE_SELECT = 3 };

__device__ __forceinline__ int crow(int r, int hi) { return (r & 3) + 8 * (r >> 2) + 4 * hi; }
__device__ __forceinline__ float xmax(float v) {
    auto rr = __builtin_amdgcn_permlane32_swap(__float_as_uint(v), __float_as_uint(v), false, false);
    return fmaxf(__uint_as_float(rr[0]), __uint_as_float(rr[1]));
}
typedef float f32x2 __attribute__((ext_vector_type(2)));
__device__ __forceinline__ float max3f(float a, float b, float c) { float r; asm("v_max3_f32 %0, %1, %2, %3" : "=v"(r) : "v"(a), "v"(b), "v"(c)); return r; }
__device__ __forceinline__ float xsum(float v) {
    auto rr = __builtin_amdgcn_permlane32_swap(__float_as_uint(v), __float_as_uint(v), false, false);
    return __uint_as_float(rr[0]) + __uint_as_float(rr[1]);
}
__device__ __forceinline__ s16x4 vtr(const LAS unsigned char* p) {
    typedef short v4i16_t __attribute__((ext_vector_type(4)));
    return __builtin_bit_cast(s16x4, __builtin_amdgcn_ds_read_tr16_b64_v4i16((LAS v4i16_t*)p));
}
__device__ __forceinline__ bf16x8 pack8(const f32x16& p, int b) {
    u32x4 w; w.x = pk2(p[b], p[b + 1]); w.y = pk2(p[b + 2], p[b + 3]); w.z = pk2(p[b + 4], p[b + 5]); w.w = pk2(p[b + 6], p[b + 7]);
    return __builtin_bit_cast(bf16x8, w);
}
__device__ __forceinline__ void load_q(bf16x8 (&qf)[4], const bf16* qrow, int hi) {
#pragma unroll
    for (int d0 = 0; d0 < 4; ++d0) qf[d0] = __builtin_bit_cast(bf16x8, *(const u32x4*)(qrow + 16 * d0 + 8 * hi));
}
__device__ __forceinline__ void rope_q(bf16x8& q0, int pos, int hi) {
    const u32x4 own = __builtin_bit_cast(u32x4, q0); u32x4 oth;
    oth.x = __shfl_xor(own.x, 32); oth.y = __shfl_xor(own.y, 32); oth.z = __shfl_xor(own.z, 32); oth.w = __shfl_xor(own.w, 32);
    float a[8], b[8];
    a[0] = __uint_as_float(own.x << 16); a[1] = __uint_as_float(own.x & 0xffff0000u); a[2] = __uint_as_float(own.y << 16); a[3] = __uint_as_float(own.y & 0xffff0000u);
    a[4] = __uint_as_float(own.z << 16); a[5] = __uint_as_float(own.z & 0xffff0000u); a[6] = __uint_as_float(own.w << 16); a[7] = __uint_as_float(own.w & 0xffff0000u);
    b[0] = __uint_as_float(oth.x << 16); b[1] = __uint_as_float(oth.x & 0xffff0000u); b[2] = __uint_as_float(oth.y << 16); b[3] = __uint_as_float(oth.y & 0xffff0000u);
    b[4] = __uint_as_float(oth.z << 16); b[5] = __uint_as_float(oth.z & 0xffff0000u); b[6] = __uint_as_float(oth.w << 16); b[7] = __uint_as_float(oth.w & 0xffff0000u);
    const float sg = hi ? 1.0f : -1.0f;
#pragma unroll
    for (int i = 0; i < 8; ++i) { float c, s; rope_cs(pos, i, c, s); a[i] = a[i] * c + sg * b[i] * s; }
    u32x4 w; w.x = pk2(a[0], a[1]); w.y = pk2(a[2], a[3]); w.z = pk2(a[4], a[5]); w.w = pk2(a[6], a[7]);
    q0 = __builtin_bit_cast(bf16x8, w);
}

struct KV { const bf16* K; const bf16* V; int ldk, ldv; const float* cb; };

struct Stage { u32x4 k, v; float b; };
template <bool BIAS> __device__ __forceinline__ void stage_load(Stage& s, const KV& P, int t, int tid) {
    const int row = 64 * t + (tid >> 3), ch = tid & 7;
    s.k = *(const u32x4*)(P.K + (size_t)row * P.ldk + ch * 8); s.v = *(const u32x4*)(P.V + (size_t)row * P.ldv + ch * 8);
    if (BIAS) { if (tid < 64) s.b = P.cb[64 * t + tid]; }
}
template <bool BIAS> __device__ __forceinline__ void stage_store(const Stage& s, LAS unsigned char* buf, int tid) {
    const int off = (tid >> 3) * KROW + (tid & 7) * 16, offv = (tid >> 3) * VROW + (tid & 7) * 16;
    *(LAS u32x4*)(buf + off) = s.k; *(LAS u32x4*)(buf + TILE_B + offv) = s.v;
    if (BIAS) { if (tid < 64) *(LAS float*)(buf + BIAS_OFF + tid * 4) = -s.b; }
}

template <int MODE> __device__ __forceinline__ bool tile_work(int t, int tq0, unsigned sel) {
    bool w = true;
    if (MODE == MODE_CAUSAL || MODE == MODE_WINDOW || MODE == MODE_SELECT) w = (64 * t <= tq0 + 31);
    if (MODE == MODE_WINDOW) w = w && (64 * t + 63 >= tq0 - 511);
    if (MODE == MODE_SELECT) w = w && (__ballot((sel >> t) & 1u) != 0ull);
    return w;
}
template <int MODE> __device__ __forceinline__ bool tile_full(int t, int tq0, unsigned sel) {
    bool f = true;
    if (MODE == MODE_CAUSAL || MODE == MODE_WINDOW || MODE == MODE_SELECT) f = (64 * t + 63 <= tq0);
    if (MODE == MODE_WINDOW) f = f && (tq0 + 31 - 64 * t < 512);
    if (MODE == MODE_SELECT) f = f && (__ballot((sel >> t) & 1u) == ~0ull);
    return f;
}

template <int MODE, bool BIAS, int XP = 0>
__device__ __forceinline__ void flash_tile(const LAS unsigned char* buf, int t, const bf16x8 (&qf)[4], int tq, int tq0, unsigned sel, int koff, int voff, int hi, f32x16 (&o)[2], float& m, float& l) {
    if (tile_work<MODE>(t, tq0, sel)) {
        bf16x8 kf[8];
#pragma unroll
        for (int d0 = 0; d0 < 4; ++d0) { kf[2 * d0] = *(const LAS bf16x8*)(buf + koff + d0 * 32); kf[2 * d0 + 1] = *(const LAS bf16x8*)(buf + koff + 32 * KROW + d0 * 32); }
        f32x16 s0, s1;
        if (BIAS) {
#pragma unroll
            for (int u = 0; u < 4; ++u) { const f32x4 b0 = *(const LAS f32x4*)(buf + BIAS_OFF + (8 * u + 4 * hi) * 4), b1 = *(const LAS f32x4*)(buf + BIAS_OFF + (32 + 8 * u + 4 * hi) * 4);
                s0[4 * u] = b0.x; s0[4 * u + 1] = b0.y; s0[4 * u + 2] = b0.z; s0[4 * u + 3] = b0.w; s1[4 * u] = b1.x; s1[4 * u + 1] = b1.y; s1[4 * u + 2] = b1.z; s1[4 * u + 3] = b1.w; }
        } else { s0 = f32x16{}; s1 = f32x16{}; }
        asm volatile("s_waitcnt lgkmcnt(0)" ::: "memory");
#pragma unroll
        for (int d0 = 0; d0 < 4; ++d0) { if (XP == 2) { asm volatile("" :: "v"(kf[2 * d0]), "v"(kf[2 * d0 + 1])); } else { s0 = __builtin_amdgcn_mfma_f32_32x32x16_bf16(kf[2 * d0], qf[d0], s0, 0, 0, 0); s1 = __builtin_amdgcn_mfma_f32_32x32x16_bf16(kf[2 * d0 + 1], qf[d0], s1, 0, 0, 0); } }
        s16x4 vlo[8], vhh[8];
#pragma unroll
        for (int j = 0; j < 2; ++j)
#pragma unroll
            for (int s = 0; s < 2; ++s)
#pragma unroll
                for (int d0 = 0; d0 < 2; ++d0) { const LAS unsigned char* vp = buf + voff + (32 * j + 16 * s) * VROW + d0 * 64; vlo[4 * j + 2 * s + d0] = vtr(vp); vhh[4 * j + 2 * s + d0] = vtr(vp + 8 * VROW); }
        asm volatile("" ::: "memory");
        asm volatile("s_nop 15\n\ts_nop 7" : "+v"(s0), "+v"(s1));
        if (MODE != MODE_NONE) {
            if (!tile_full<MODE>(t, tq0, sel)) {
                const int d = tq - (64 * t + 4 * hi);
                const bool selt = (MODE == MODE_SELECT) ? (((sel >> t) & 1u) != 0u) : true;
#pragma unroll
                for (int r = 0; r < 16; ++r) {
                    const int ca = (r & 3) + 8 * (r >> 2), cb = ca + 32;
                    bool va = selt && (ca <= d), vb = selt && (cb <= d);
                    if (MODE == MODE_WINDOW) { va = va && (ca > d - 512); vb = vb && (cb > d - 512); }
                    s0[r] = va ? s0[r] : -INFINITY; s1[r] = vb ? s1[r] : -INFINITY;
                }
            }
        }
        float mx0 = max3f(s0[0], s1[0], s0[1]), mx1 = max3f(s1[1], s0[2], s1[2]);
#pragma unroll
        for (int r = 3; r < 15; r += 2) { mx0 = max3f(mx0, s0[r], s1[r]); mx1 = max3f(mx1, s0[r + 1], s1[r + 1]); }
        const float mx = xmax(max3f(mx0, mx1, max3f(s0[15], s1[15], mx0)));
        const float mn = fmaxf(m, mx * LOG2E), ms = (mn == -INFINITY) ? 0.f : mn;
        const float alpha = __builtin_amdgcn_exp2f(m - ms);
        const bool resc = (mn != m);
        m = mn;
        f32x2 ps = (f32x2){0.f, 0.f};
#pragma unroll
        for (int r = 0; r < 16; r += 2) {
            const f32x2 ta = (f32x2){s0[r], s0[r + 1]} * LOG2E - ms, tb = (f32x2){s1[r], s1[r + 1]} * LOG2E - ms;
            if (XP == 1) { s0[r] = ta.x; s0[r + 1] = ta.y; s1[r] = tb.x; s1[r + 1] = tb.y; } else { s0[r] = __builtin_amdgcn_exp2f(ta.x); s0[r + 1] = __builtin_amdgcn_exp2f(ta.y); s1[r] = __builtin_amdgcn_exp2f(tb.x); s1[r + 1] = __builtin_amdgcn_exp2f(tb.y); }
            ps += (f32x2){s0[r], s0[r + 1]}; ps += (f32x2){s1[r], s1[r + 1]};
        }
        l = l * alpha + (ps.x + ps.y);
        if (__any(resc)) {
#pragma unroll
            for (int r = 0; r < 16; ++r) { o[0][r] *= alpha; o[1][r] *= alpha; }
        }
#pragma unroll
        for (int j = 0; j < 2; ++j)
#pragma unroll
            for (int s = 0; s < 2; ++s) {
                const bf16x8 pb = pack8(j ? s1 : s0, 8 * s);
#pragma unroll
                for (int d0 = 0; d0 < 2; ++d0) { const s16x4 lo = vlo[4 * j + 2 * s + d0], hh = vhh[4 * j + 2 * s + d0];
                    const bf16x8 vf = (bf16x8){lo[0], lo[1], lo[2], lo[3], hh[0], hh[1], hh[2], hh[3]};
                    if (XP == 2) { asm volatile("" :: "v"(vf), "v"(pb)); } else o[d0] = __builtin_amdgcn_mfma_f32_32x32x16_bf16(vf, pb, o[d0], 0, 0, 0); }
            }
    }
}
template <int MODE, bool BIAS, int XP = 0>
__device__ __forceinline__ void flash_core_v4(LAS unsigned char* lds, const KV& P, int t_lo, int t_hi, const bf16x8 (&qf)[4], int tq, int tq0, unsigned sel, f32x16 (&o)[2], float& l_out) {
    int tid_ = threadIdx.x; asm volatile("" : "+v"(tid_));
    const int tid = tid_, lane = tid & 63, r32 = lane & 31, hi = lane >> 5;
    o[0] = f32x16{}; o[1] = f32x16{};
    float m = -INFINITY, l = 0.f;
    const int koff = r32 * KROW + hi * 16;
    const int voff = TILE_B + (4 * hi + ((lane & 15) >> 2)) * VROW + (((lane >> 4) & 1) * 16 + (lane & 3) * 4) * 2;
    Stage sa, sb;
    stage_load<BIAS>(sa, P, t_lo, tid); stage_store<BIAS>(sa, lds, tid);
    if (t_lo + 1 < t_hi) stage_load<BIAS>(sa, P, t_lo + 1, tid);
    __syncthreads();
    for (int t = t_lo; t < t_hi; t += 2) {
        if (XP < 3 && t + 2 < t_hi) stage_load<BIAS>(sb, P, t + 2, tid);
        flash_tile<MODE, BIAS, XP>(lds, t, qf, tq, tq0, sel, koff, voff, hi, o, m, l);
        if (XP < 3 && t + 1 < t_hi) stage_store<BIAS>(sa, lds + BUF_B, tid);
        if (XP < 4) __syncthreads();
        if (t + 1 >= t_hi) break;
        if (XP < 3 && t + 3 < t_hi) stage_load<BIAS>(sa, P, t + 3, tid);
        flash_tile<MODE, BIAS, XP>(lds + BUF_B, t + 1, qf, tq, tq0, sel, koff, voff, hi, o, m, l);
        if (XP < 3 && t + 2 < t_hi) stage_store<BIAS>(sb, lds, tid);
        if (XP < 4) __syncthreads();
    }
    l_out = xsum(l);
}
__device__ __forceinline__ void store_o(bf16* orow, const f32x16 (&o)[2], float a, int hi) {
#pragma unroll
    for (int d0 = 0; d0 < 2; ++d0)
#pragma unroll
        for (int u = 0; u < 4; ++u) { u32x2 w; w.x = pk2(o[d0][4 * u] * a, o[d0][4 * u + 1] * a); w.y = pk2(o[d0][4 * u + 2] * a, o[d0][4 * u + 3] * a);
            *(u32x2*)(orow + 32 * d0 + 8 * u + 4 * hi) = w; }
}
}

__device__ __forceinline__ void phase_mem_mfma(const Frame& F, const KA& a) {
    unsigned char* ws = a.ws();
    const int vcu = (F.G % 8 == 0) ? (F.bid % 8) * (F.G / 8) + F.bid / 8 : F.bid;
    for (int u = vcu; u < 256; u += F.G) {
        const int b = u >> 5, h = (u >> 3) & 3, qb = u & 7;
        const int hi = F.lane >> 5, r32 = F.lane & 31, tq0 = 256 * qb + 32 * F.wave;
        const size_t tok = (size_t)b * SEQ + tq0 + r32;
        fa::bf16x8 qf[4];
#pragma unroll
        for (int d0 = 0; d0 < 4; ++d0) {
            float qa[8];
#pragma unroll
            for (int e = 0; e < 8; ++e) qa[e] = 0.f;
#pragma unroll
            for (int kq = 0; kq < 4; ++kq) { const u32x4 v = *(const u32x4*)((const bf16*)(ws + WS_MQ) + ((size_t)kq * M + tok) * 256 + h * 64 + 16 * d0 + 8 * hi);
                qa[0] += __uint_as_float(v.x << 16); qa[1] += __uint_as_float(v.x & 0xffff0000u); qa[2] += __uint_as_float(v.y << 16); qa[3] += __uint_as_float(v.y & 0xffff0000u);
                qa[4] += __uint_as_float(v.z << 16); qa[5] += __uint_as_float(v.z & 0xffff0000u); qa[6] += __uint_as_float(v.w << 16); qa[7] += __uint_as_float(v.w & 0xffff0000u); }
            u32x4 w; w.x = pk2(qa[0], qa[1]); w.y = pk2(qa[2], qa[3]); w.z = pk2(qa[4], qa[5]); w.w = pk2(qa[6], qa[7]);
            qf[d0] = __builtin_bit_cast(fa::bf16x8, w);
        }
        fa::KV P{(const bf16*)(ws + WS_MEMKV) + (size_t)b * NMEM * 512 + h * 64, (const bf16*)(ws + WS_MEMKV) + (size_t)b * NMEM * 512 + 256 + h * 64, 512, 512, nullptr};
        fa::f32x16 o[2]; float l;
        int nt_ = 4; asm volatile("" : "+s"(nt_));
        FA_CORE_MEM<fa::MODE_NONE, false>(F.lds, P, 0, nt_, qf, tq0 + r32, tq0, 0u, o, l);
        fa::store_o((bf16*)(ws + WS_MO) + tok * 256 + h * 64, o, 1.0f / l, hi);
    }
}
__device__ __forceinline__ void phase_fox_mfma(const Frame& F, const KA& a, bool dry) {
    unsigned char* ws = a.ws();
    const int vcu = (F.G % 8 == 0) ? (F.bid % 8) * (F.G / 8) + F.bid / 8 : F.bid;
    for (int u = vcu; u < 256; u += F.G) {
        const int bh = u >> 2, b = bh >> 3, h = bh & 7, s4 = u & 3;
        for (int half = 0; half < 2; ++half) {
            const int qb = half ? 7 - s4 : s4;
            const int hi = F.lane >> 5, r32 = F.lane & 31, tq0 = 256 * qb + 32 * F.wave;
            const size_t row0 = (size_t)b * SEQ, tok = row0 + tq0 + r32;
            bf16* Q = (bf16*)(ws + WS_OQ + 32 * MiB);
            fa::bf16x8 qf[4]; fa::load_q(qf, Q + tok * 512 + h * 64, hi);
            fa::KV P{(const bf16*)(ws + WS_KV + 32 * MiB) + row0 * 512 + h * 64, (const bf16*)(ws + WS_KV + 48 * MiB) + row0 * 512 + h * 64, 512, 512, (const float*)(ws + WS_CF) + (size_t)bh * SEQ};
            fa::f32x16 o[2]; float l;
            if (dry && PROBE_XP) fa::flash_core_v4<fa::MODE_CAUSAL, true, PROBE_XP>(F.lds, P, 0, 4 * (qb + 1), qf, tq0 + r32, tq0, 0u, o, l);
            else FA_CORE_FOX<fa::MODE_CAUSAL, true>(F.lds, P, 0, 4 * (qb + 1), qf, tq0 + r32, tq0, 0u, o, l);
            if (!dry) fa::store_o(Q + tok * 512 + h * 64, o, 1.0f / l, hi);
        }
    }
}

__device__ __forceinline__ void phase_nsa_fused(const Frame& F, const KA& a, bool dry) {
    using namespace fa;
    unsigned char* ws = a.ws();
    const int vcu = (F.G % 8 == 0) ? (F.bid % 8) * (F.G / 8) + F.bid / 8 : F.bid;
    const int* pos = (const int*)a.in(2);
    const int lane = F.lane, r32 = lane & 31, hi = lane >> 5, tid = F.tid, wave = F.wave;
    LAS unsigned char* lds = F.lds;
    constexpr int CT = 128 * KROW, SC_OFF = 45056, MK_OFF = SC_OFF + 8 * 32 * 32 * 4;
    for (int u = vcu; u < 256; u += F.G) {
        const int bg = u >> 4, b = bg >> 1, g = bg & 1, s16 = u & 15;
        for (int half = 0; half < 2; ++half) {
            const int qb = half ? 31 - s16 : s16;
            const int h = 4 * g + (wave >> 1), tq0 = 64 * qb + 32 * (wave & 1), tq = tq0 + r32;
            const size_t row0 = (size_t)b * SEQ, tok = row0 + tq;
            bf16* Q = (bf16*)(ws + WS_OQ + 16 * MiB);
            const bf16* kv = (const bf16*)(ws + WS_KV + 64 * MiB) + row0 * 768 + g * 64;
            const bf16* small = (const bf16*)(ws + WS_KV + 88 * MiB) + tok * 256 + h * 3;
            const float g0 = sigm(bf2f(small[0])), g1 = sigm(bf2f(small[1])), g2 = sigm(bf2f(small[2]));
            bf16x8 qf[4]; load_q(qf, Q + tok * 512 + h * 64, hi);
            {   const bf16* Kc = (const bf16*)(ws + WS_KCMP) + (size_t)bg * 128 * 64; const bf16* Vc = (const bf16*)(ws + WS_VCMP) + (size_t)bg * 128 * 64;
#pragma unroll
                for (int i = 0; i < 2; ++i) { const int pc = tid + 512 * i, row = pc >> 3, ch = pc & 7;
                    *(LAS u32x4*)(lds + row * KROW + ch * 16) = *(const u32x4*)(Kc + row * 64 + ch * 8);
                    *(LAS u32x4*)(lds + CT + row * VROW + ch * 16) = *(const u32x4*)(Vc + row * 64 + ch * 8); } }
            __syncthreads();
            {
                f32x16 acc[2];
                const int koff = r32 * KROW + hi * 16;
                const int voff = CT + (4 * hi + ((lane & 15) >> 2)) * VROW + (((lane >> 4) & 1) * 16 + (lane & 3) * 4) * 2;
                const int ncmax = tq0 >= 0 ? min(127, (tq0 + 31 - 31) / 16 + 1) : 0, nsub = (ncmax + 31) >> 5;
                f32x16 s[4];
#pragma unroll
                for (int j = 0; j < 4; ++j) s[j] = f32x16{};
#pragma unroll
                for (int j = 0; j < 4; ++j) if (j < nsub) {
#pragma unroll
                    for (int d0 = 0; d0 < 4; ++d0) { const bf16x8 kf = *(const LAS bf16x8*)(lds + koff + 32 * j * KROW + d0 * 32); s[j] = __builtin_amdgcn_mfma_f32_32x32x16_bf16(kf, qf[d0], s[j], 0, 0, 0); } }
                float mx = -INFINITY;
#pragma unroll
                for (int j = 0; j < 4; ++j)
#pragma unroll
                    for (int rr = 0; rr < 16; ++rr) { const int c = 32 * j + crow(rr, hi); const bool v = (16 * c + 31 <= tq) && (c < 127) && (j < nsub); s[j][rr] = v ? s[j][rr] : -INFINITY; mx = fmaxf(mx, s[j][rr]); }
                mx = xmax(mx);
                const float ms = (mx == -INFINITY) ? 0.f : mx * LOG2E;
                float ps = 0.f;
#pragma unroll
                for (int j = 0; j < 4; ++j)
#pragma unroll
                    for (int rr = 0; rr < 16; ++rr) { s[j][rr] = __builtin_amdgcn_exp2f(s[j][rr] * LOG2E - ms); ps += s[j][rr]; }
                ps = xsum(ps);
                const float inv = ps > 0.f ? 1.0f / ps : 0.f;
#pragma unroll
                for (int j = 0; j < 4; ++j)
#pragma unroll
                    for (int rr = 0; rr < 16; ++rr) s[j][rr] *= inv;
                LAS float* sc_out = (LAS float*)(lds + SC_OFF) + (wave * 32 + r32) * 32;
                float prev = 0.f;
#pragma unroll
                for (int idx = 0; idx < 16; ++idx) { const int j = idx >> 2, uu = idx & 3;
                    const float G = (s[j][4 * uu] + s[j][4 * uu + 1]) + (s[j][4 * uu + 2] + s[j][4 * uu + 3]), L = s[j][4 * uu + 3];
                    const float recv = __shfl_xor(L, 32);
                    sc_out[2 * idx + hi] = G + (hi ? recv : prev);
                    prev = recv; }
                acc[0] = f32x16{}; acc[1] = f32x16{};
#pragma unroll
                for (int j = 0; j < 4; ++j) if (j < nsub) {
#pragma unroll
                    for (int ss = 0; ss < 2; ++ss) {
                        const bf16x8 pb = pack8(s[j], 8 * ss);
#pragma unroll
                        for (int d0 = 0; d0 < 2; ++d0) {
                            const LAS unsigned char* vp = lds + voff + (32 * j + 16 * ss) * VROW + d0 * 64;
                            const s16x4 lo = vtr(vp), hh = vtr(vp + 8 * VROW);
                            const bf16x8 vf = (bf16x8){lo[0], lo[1], lo[2], lo[3], hh[0], hh[1], hh[2], hh[3]};
                            acc[d0] = __builtin_amdgcn_mfma_f32_32x32x16_bf16(vf, pb, acc[d0], 0, 0, 0);
                        }
                    } }
                store_o((bf16*)(ws + WS_OCMP) + tok * 512 + h * 64, acc, g0, hi);
            }
            __syncthreads();
            if (tid < 64) {
                const int t = 64 * qb + tid, sub = tid >> 5, rr = tid & 31;
                float sc[32];
#pragma unroll
                for (int n = 0; n < 32; ++n) sc[n] = 0.f;
#pragma unroll
                for (int r = 0; r < 4; ++r) { const LAS f32x4* p = (const LAS f32x4*)(lds + SC_OFF) + ((2 * r + sub) * 32 + rr) * 8;
#pragma unroll
                    for (int i = 0; i < 8; ++i) { const f32x4 v = p[i]; sc[4 * i] += v.x; sc[4 * i + 1] += v.y; sc[4 * i + 2] += v.z; sc[4 * i + 3] += v.w; } }
                const int cur = t >> 6;
#pragma unroll
                for (int n = 0; n < 32; ++n) sc[n] = (n == 0 || n == cur) ? 1e4f : ((64 * n <= t) ? sc[n] : -1.0f);
                unsigned mask = 0u;
#pragma unroll
                for (int k = 0; k < 8; ++k) {
                    float best = sc[0]; int bi = 0;
#pragma unroll
                    for (int n = 1; n < 32; ++n) { const bool take = sc[n] > best; best = take ? sc[n] : best; bi = take ? n : bi; }
                    mask |= 1u << bi;
#pragma unroll
                    for (int n = 0; n < 32; ++n) sc[n] = (n == bi) ? -INFINITY : sc[n];
                }
                ((LAS unsigned*)(lds + MK_OFF))[tid] = mask;
            }
            __syncthreads();
            const unsigned sel = ((const LAS unsigned*)(lds + MK_OFF))[32 * (wave & 1) + r32];
            rope_q(qf[0], pos[tok], hi);
            f32x16 o[2]; float l;
            { KV P{kv + 256, kv + 384, 768, 768, nullptr};
              FA_CORE_SEL<MODE_SELECT, false>(lds, P, 0, qb + 1, qf, tq, tq0, sel, o, l); }
            f32x16 acc[2];
            { const float sc = l > 0.f ? g1 / l : 0.f;
#pragma unroll
              for (int r = 0; r < 16; ++r) { acc[0][r] = o[0][r] * sc; acc[1][r] = o[1][r] * sc; } }
            { KV P{kv + 512, kv + 640, 768, 768, nullptr};
              FA_CORE_SEL<MODE_WINDOW, false>(lds, P, qb > 8 ? qb - 8 : 0, qb + 1, qf, tq, tq0, 0u, o, l); }
            { const float sc = l > 0.f ? g2 / l : 0.f;
              const bf16* oc = (const bf16*)(ws + WS_OCMP) + tok * 512 + h * 64;
#pragma unroll
              for (int d0 = 0; d0 < 2; ++d0)
#pragma unroll
                  for (int uu = 0; uu < 4; ++uu) { const u32x2 w = *(const u32x2*)(oc + 32 * d0 + 8 * uu + 4 * hi);
                      acc[d0][4 * uu] += o[d0][4 * uu] * sc + __uint_as_float(w.x << 16); acc[d0][4 * uu + 1] += o[d0][4 * uu + 1] * sc + __uint_as_float(w.x & 0xffff0000u);
                      acc[d0][4 * uu + 2] += o[d0][4 * uu + 2] * sc + __uint_as_float(w.y << 16); acc[d0][4 * uu + 3] += o[d0][4 * uu + 3] * sc + __uint_as_float(w.y & 0xffff0000u); } }
            if (!dry) store_o(Q + tok * 512 + h * 64, acc, 1.0f, hi);
        }
    }
}


__device__ __forceinline__ void phase_sb_mfma(const Frame& F, const KA& a, int l, bool dry) {
    using namespace fa;
    unsigned char* ws = a.ws();
    const int lane = F.lane, r32 = lane & 31, hi = lane >> 5;
    LAS unsigned char* lds = F.lds + F.wave * (32 * KROW + 32 * VROW);
    constexpr int SUB_B = 32 * KROW;
    const int koff = r32 * KROW + hi * 16;
    const int voff = SUB_B + (4 * hi + ((lane & 15) >> 2)) * VROW + (((lane >> 4) & 1) * 16 + (lane & 3) * 4) * 2;
    const unsigned shard = (unsigned)F.bid & 7u;
    unsigned* ctr = (unsigned*)(ws + WS_CTL) + CW_SB + 64 * (shard + 8 * (unsigned)l);
    for (;;) {
        unsigned k_ = 0u;
        if (lane == 0) k_ = __hip_atomic_fetch_add(ctr, 1u, __ATOMIC_RELAXED, __HIP_MEMORY_SCOPE_AGENT);
        k_ = (unsigned)__builtin_amdgcn_readfirstlane((int)k_);
        if (k_ >= 512u) break;
        const int u = (int)(shard * 512u + (511u - k_));
        const int bh = u >> 6, b = bh >> 3, h = bh & 7, rb = u & 63;
        const int tq0 = 32 * rb, tq = tq0 + r32;
        const size_t row0 = (size_t)b * SEQ, tok = row0 + tq;
        bf16* Q = (bf16*)(ws + WS_OQ);
        const bf16* Kg = (const bf16*)(ws + WS_KV) + row0 * 512 + h * 64; const bf16* Vg = (const bf16*)(ws + WS_KV + 16 * MiB) + row0 * 512 + h * 64;
        bf16x8 qf[4]; load_q(qf, Q + tok * 512 + h * 64, hi);
        f32x16 o[2]; o[0] = f32x16{}; o[1] = f32x16{};
        float carry = 1.0f;
        u32x4 ak[4], av[4], bk[4], bv[4];
#define SB_LOAD(K_, V_, j_) do { _Pragma("unroll") for (int i = 0; i < 4; ++i) { const int pc = lane + 64 * i, row = 32 * (j_) + (pc >> 3), ch = pc & 7; \
            K_[i] = *(const u32x4*)(Kg + (size_t)row * 512 + ch * 8); V_[i] = *(const u32x4*)(Vg + (size_t)row * 512 + ch * 8); } } while (0)
#define SB_STORE(K_, V_) do { _Pragma("unroll") for (int i = 0; i < 4; ++i) { const int pc = lane + 64 * i, off = (pc >> 3) * KROW + (pc & 7) * 16, offv = (pc >> 3) * VROW + (pc & 7) * 16; \
            *(LAS u32x4*)(lds + off) = K_[i]; *(LAS u32x4*)(lds + SUB_B + offv) = V_[i]; } } while (0)
#define SB_COMPUTE(jj_) do { const int jsub_ = (jj_); \
            f32x16 s = f32x16{}; \
_Pragma("unroll") \
            for (int d0 = 0; d0 < 4; ++d0) { const bf16x8 kf = *(const LAS bf16x8*)(lds + koff + d0 * 32); s = __builtin_amdgcn_mfma_f32_32x32x16_bf16(kf, qf[d0], s, 0, 0, 0); } \
            const int dd = tq - (32 * jsub_ + 4 * hi); \
            float keep[16]; \
_Pragma("unroll") \
            for (int r = 0; r < 16; ++r) { \
                const bool v = ((r & 3) + 8 * (r >> 2)) < dd; const float z = s[r]; \
                const float ea = __expf(-fabsf(z)), rr = __builtin_amdgcn_rcpf(1.0f + ea), sm = ea * rr; \
                const float beta = z >= 0.f ? rr : sm, kp = z >= 0.f ? sm : rr; \
                keep[r] = v ? kp : 1.0f; s[r] = v ? beta : 0.f; \
            } \
            float Go[4], Gp[4]; \
_Pragma("unroll") \
            for (int uu = 0; uu < 4; ++uu) { Go[uu] = (keep[4 * uu] * keep[4 * uu + 1]) * (keep[4 * uu + 2] * keep[4 * uu + 3]); Gp[uu] = __shfl_xor(Go[uu], 32); } \
            float above = carry; \
_Pragma("unroll") \
            for (int uu = 3; uu >= 0; --uu) { \
                const float e3 = above * (hi ? 1.0f : Gp[uu]); \
                const float e2 = e3 * keep[4 * uu + 3], e1 = e2 * keep[4 * uu + 2], e0 = e1 * keep[4 * uu + 1]; \
                s[4 * uu + 3] *= e3; s[4 * uu + 2] *= e2; s[4 * uu + 1] *= e1; s[4 * uu] *= e0; \
                above *= Go[uu] * Gp[uu]; \
            } \
            carry = above; \
_Pragma("unroll") \
            for (int ss = 0; ss < 2; ++ss) { \
                const bf16x8 pb = pack8(s, 8 * ss); \
_Pragma("unroll") \
                for (int d0 = 0; d0 < 2; ++d0) { \
                    const LAS unsigned char* vp = lds + voff + (16 * ss) * VROW + d0 * 64; \
                    const s16x4 lo = vtr(vp), hh = vtr(vp + 8 * VROW); \
                    const bf16x8 vf = (bf16x8){lo[0], lo[1], lo[2], lo[3], hh[0], hh[1], hh[2], hh[3]}; \
                    o[d0] = __builtin_amdgcn_mfma_f32_32x32x16_bf16(vf, pb, o[d0], 0, 0, 0); \
                } \
            } \
        } while (0)
        SB_LOAD(ak, av, rb);
        if (rb > 0) SB_LOAD(bk, bv, rb - 1);
        for (int j = rb; j >= 0; j -= 2) {
            SB_STORE(ak, av);
            if (j >= 2) SB_LOAD(ak, av, j - 2);
            SB_COMPUTE(j);
            if (__ballot(carry != 0.f) == 0ull) break;
            if (j == 0) break;
            SB_STORE(bk, bv);
            if (j >= 3) SB_LOAD(bk, bv, j - 3);
            SB_COMPUTE(j - 1);
            if (__ballot(carry != 0.f) == 0ull) break;
        }
#undef SB_LOAD
#undef SB_STORE
#undef SB_COMPUTE
        if (!dry) store_o(Q + tok * 512 + h * 64, o, 1.0f, hi);
    }
    __syncthreads();
}

__device__ __forceinline__ void phase_norm(const Frame& F, const KA& a, const bf16* ysrc, const float* xs, const float* gpost, const float* gpre, bool write_h, bool dry) {
    unsigned char* ws = a.ws();
    for (int r = F.gw; r < M; r += 2 * F.ngw) {
        const int r1 = (r + F.ngw < M) ? r + F.ngw : r;
        if (r1 != r) post_norm_rows2(ysrc + (size_t)r * DM, ysrc + (size_t)r1 * DM, xs + (size_t)r * DM, xs + (size_t)r1 * DM, a.out() + (size_t)r * DM, a.out() + (size_t)r1 * DM, gpost, gpre,
                                     (bf16*)(ws + WS_H) + (size_t)r * DM, (bf16*)(ws + WS_H) + (size_t)r1 * DM, write_h, dry, F.lane);
        else post_norm_row(ysrc + (size_t)r * DM, xs + (size_t)r * DM, a.out() + (size_t)r * DM, gpost, gpre, (bf16*)(ws + WS_H) + (size_t)r * DM, write_h, dry, F.lane);
    }
}

__device__ __forceinline__ void launder_frame(Frame& F) {
    int z = 0; asm volatile("" : "+s"(z));
    int t = threadIdx.x; asm volatile("" : "+v"(t));
    F.tid = t; F.lane = t & 63; F.wave = __builtin_amdgcn_readfirstlane(t >> 6);
    F.G = (int)gridDim.x + z; F.bid = (int)blockIdx.x + z;
    F.gw = F.bid * NWAVES + F.wave; F.ngw = F.G * NWAVES; F.gt = F.bid * NTHREADS + F.tid; F.ngt = F.G * NTHREADS;
}
constexpr int NPH = 19;
constexpr int LDS_BYTES = 147456;
constexpr int MISC_OFF = 131072 + 320;

template <int PSEL> __global__ void __launch_bounds__(NTHREADS, 2) hybrid_fwd(Args a_unused) {
    extern __shared__ __attribute__((aligned(16))) unsigned char lds_raw[];
    Frame F;
    F.lds = (LAS unsigned char*)lds_raw;
    F.tid = threadIdx.x; F.lane = F.tid & 63; F.wave = __builtin_amdgcn_readfirstlane(F.tid >> 6);
    F.G = gridDim.x; F.bid = blockIdx.x;
    F.gw = F.bid * NWAVES + F.wave; F.ngw = F.G * NWAVES; F.gt = F.bid * NTHREADS + F.tid; F.ngt = F.G * NTHREADS;
    volatile LAS unsigned* MISC = (volatile LAS unsigned*)(F.lds + MISC_OFF);
    if (F.tid < 32) MISC[F.tid] = 0u;
    __syncthreads();
    KA a; a.refresh();
    unsigned char* ws = a.ws();
    constexpr bool one_launch = PSEL < 0;
    XcdBarrier bar; bar.bar = (unsigned*)(ws + WS_CTL) + CW_BAR; bar.x = 0; bar.st = nullptr;
    if (one_launch) bar = xcd_barrier_post((unsigned*)(ws + WS_CTL) + CW_BAR, MISC + 8);
#define IN(k) (a.refresh(), ws = a.ws(), launder_frame(F), (PSEL < 0 || PSEL == ((k) - p0)))
#define REP(k) for (int rep_ = ((PROBE_MASK >> (k)) & 1) ? a.ph_hi() : 0; rep_ >= 0; --rep_)
#define DRY (rep_ > 0)
#define SEAM(k) do { if (PSEL < 0) { xcd_barrier(bar); if (PROBE_XBAR) xcd_barrier(bar); } } while (0)
    typedef pg8::bf16_t pb;
    const int l_lo = (PSEL < 0 ? 0 : a.ph_lo()), l_hi = (PSEL < 0 ? 2 : l_lo + 1);
    for (int l = l_lo; l < l_hi; ++l) {
        const int p0 = l * NPH;
        if (l == 0) { if (IN(p0 + 0)) REP(0) { phase_conv(F, a, 0); __syncthreads(); } SEAM(p0 + 0); }
        if (IN(p0 + 1)) REP(1) {
            pg8::Gemm g{(const pb*)(ws + WS_H), (const pb*)(ws + W_A), M, NA, DM}; pg8::StaticOrder S; S.init(M, NA, F.G, F.bid);
            pg8::EpiProj E{(pb*)(ws + WS_CK), (pb*)(ws + WS_OQ), (pb*)(ws + WS_KV), M};
            pg8::gemm_phase<pg8::EpiProj, pg8::StaticOrder, true, true>(F.lds, g, S, E);
            { pg8::Gemm g2{(const pb*)(ws + WS_MEMN), (const pb*)(ws + W_MKV), MMEM, 512, DM}; pg8::StaticOrder S2; S2.init(MMEM, 512, F.G, (F.bid + F.G - 128) % F.G);
              pg8::EpiPlain E2{(pb*)(ws + WS_MEMKV), 512}; pg8::gemm_phase<pg8::EpiPlain, pg8::StaticOrder, true, true>(F.lds, g2, S2, E2); }
            phase_conv_b(F, a, l);
        }
        SEAM(p0 + 1);
        if (IN(p0 + 3)) REP(3) {
            phase_post(F, a, l, DRY);
            { pg8::Gemm g{(const pb*)(ws + WS_CK), (const pb*)(ws + W_C1K), 2048, 512, 1024}; pg8::StaticOrder S; S.init(2048, 512, F.G, F.bid);
              pg8::EpiPlain E{(pb*)(ws + WS_PK), 512}; pg8::gemm_phase<pg8::EpiPlain, pg8::StaticOrder, true, true>(F.lds, g, S, E); }
            { pg8::Gemm g{(const pb*)(ws + WS_CV), (const pb*)(ws + W_C1V), 2048, 512, 1024}; pg8::StaticOrder S; S.init(2048, 512, F.G, (F.bid + F.G - 16) % F.G);
              pg8::EpiPlain E{(pb*)(ws + WS_PV), 512}; pg8::gemm_phase<pg8::EpiPlain, pg8::StaticOrder, true, true>(F.lds, g, S, E); }
            phase_sb_mfma(F, a, l, DRY);
        }
        SEAM(p0 + 3);
        if (IN(p0 + 4)) REP(4) { phase_cmp2(F, a, l); phase_fox_mfma(F, a, DRY); }
        SEAM(p0 + 4);
        if (IN(p0 + 5)) REP(5) phase_nsa_fused(F, a, DRY);
        SEAM(p0 + 5);
        if (IN(p0 + 8)) REP(8) {
            pg8::Gemm g{(const pb*)(ws + WS_OQ), (const pb*)(ws + W_UP), 3 * M, 3072, 512}; pg8::UpOrder S; S.init(M, F.G, F.bid);
            pg8::EpiUpU E{(pb*)(ws + WS_MG)};
            pg8::gemm_phase<pg8::EpiUpU, pg8::UpOrder, true, true>(F.lds, g, S, E);
        }
        if (PSEL < 0) { asm volatile("s_waitcnt vmcnt(0)" ::: "memory"); __builtin_amdgcn_fence(__ATOMIC_ACQUIRE, "agent"); asm volatile("s_waitcnt vmcnt(0)" ::: "memory"); __syncthreads(); }
        if (IN(p0 + 9)) REP(9) {
            pg8::Gemm g{(const pb*)(ws + WS_H), (const pb*)(ws + W_M), M, 3072, DM}; pg8::MergeOrder S; S.init(M, F.G, F.bid);
            pg8::EpiGateY2 E{(const pb*)(ws + WS_MG), (pb*)(ws + WS_OQ), DRY};
            pg8::gemm_phase<pg8::EpiGateY2, pg8::MergeOrder, true, true>(F.lds, g, S, E);
        }
        SEAM(p0 + 9);
        if (IN(p0 + 10)) REP(10) {
            pg8::Gemm g{(const pb*)(ws + WS_OQ), (const pb*)(ws + W_OUT3), M, DM, DM}; pg8::StaticOrder S; S.init(M, DM, F.G, F.bid);
            pg8::EpiPlain E{(pb*)(ws + WS_MG), DM};
            pg8::gemm_phase<pg8::EpiPlain, pg8::StaticOrder, true, true>(F.lds, g, S, E);
        }
        SEAM(p0 + 10);
        if (IN(p0 + 11)) REP(11) phase_norm(F, a, (const bf16*)(ws + WS_MG), l == 0 ? (const float*)a.in(0) : (const float*)a.out(), (const float*)a.in(4) + l * DM, (const float*)a.in(5) + l * DM, true, DRY);
        SEAM(p0 + 11);
        if (IN(p0 + 12)) REP(12) {
            for (int kq = 0; kq < 4; ++kq) {
                pg8::Gemm g{(const pb*)(ws + WS_H) + kq * 256, (const pb*)(ws + W_MQ) + kq * 256, M, 256, 256, DM, DM}; pg8::StaticOrder S; S.init(M, 256, F.G, (F.bid + F.G - 64 * kq) % F.G);
                pg8::EpiPlain E{(pb*)(ws + WS_MQ) + (size_t)kq * M * 256, 256}; pg8::gemm_phase<pg8::EpiPlain, pg8::StaticOrder, true, true>(F.lds, g, S, E);
            }
        }
        SEAM(p0 + 12);
        if (IN(p0 + 13)) REP(13) phase_mem_mfma(F, a);
        SEAM(p0 + 13);
        if (IN(p0 + 14)) REP(14) {
            pg8::Gemm g{(const pb*)(ws + WS_MO), (const pb*)(ws + W_MO), M, DM, 256}; pg8::StaticOrder S; S.init(M, DM, F.G, F.bid);
            pg8::EpiPlain E{(pb*)(ws + WS_H), DM};
            pg8::gemm_phase<pg8::EpiPlain, pg8::StaticOrder, true, true>(F.lds, g, S, E);
        }
        SEAM(p0 + 14);
        if (IN(p0 + 15)) REP(15) phase_norm(F, a, (const bf16*)(ws + WS_H), (const float*)a.out(), (const float*)a.in(7) + l * DM, (const float*)a.in(8) + l * DM, true, DRY);
        SEAM(p0 + 15);
        if (IN(p0 + 16)) REP(16) {
            pg8::Gemm g{(const pb*)(ws + WS_H), (const pb*)(ws + W_GU), M, 2 * DFF, DM}; pg8::StaticOrder S; S.init(M, 2 * DFF, F.G, F.bid);
            pg8::EpiSwiglu E{(pb*)(ws + WS_ACT), DFF};
            pg8::gemm_phase<pg8::EpiSwiglu, pg8::StaticOrder, true, true>(F.lds, g, S, E);
        }
        SEAM(p0 + 16);
        if (IN(p0 + 17)) REP(17) {
            pg8::Gemm g{(const pb*)(ws + WS_ACT), (const pb*)(ws + W_DN), M, DM, DFF}; pg8::StaticOrder S; S.init(M, DM, F.G, F.bid);
            pg8::EpiPlain E{(pb*)(ws + WS_H), DM};
            pg8::gemm_phase<pg8::EpiPlain, pg8::StaticOrder, true, true>(F.lds, g, S, E);
        }
        SEAM(p0 + 17);
        if (IN(p0 + 18)) REP(18) { phase_norm(F, a, (const bf16*)(ws + WS_H), (const float*)a.out(), (const float*)a.in(9) + l * DM, (const float*)a.in(3) + (l + 1 < 2 ? l + 1 : l) * DM, l == 0, DRY);
            if (l == 0) { phase_conv(F, a, 1); __syncthreads(); } }
        if (l == 0) SEAM(p0 + 18);
    }
#undef IN
#undef SEAM
}

template <int P> static hipError_t set_attr1() { return hipFuncSetAttribute((const void*)hybrid_fwd<P>, hipFuncAttributeMaxDynamicSharedMemorySize, LDS_BYTES); }
template <int... P> static hipError_t set_attrs_seq(std::integer_sequence<int, P...>) { hipError_t e = hipSuccess; hipError_t r[] = {set_attr1<P>()...}; for (hipError_t x : r) if (x != hipSuccess) e = x; return e; }
static hipError_t set_attrs() {
#if MK_ONE_LAUNCH
    return set_attr1<-1>();
#else
    return set_attrs_seq(std::make_integer_sequence<int, NPH>{});
#endif
}
template <int P> static int launch1(const Args& a, int grid, hipStream_t stream) { hybrid_fwd<P><<<dim3(grid), dim3(NTHREADS), LDS_BYTES, stream>>>(a); return 0; }
template <int... P> static void launch_phases(const Args& a, int grid, hipStream_t stream, std::integer_sequence<int, P...>) {
    (void)std::initializer_list<int>{launch1<P>(a, grid, stream)...};
}

extern "C" void kernel_launch(void* const* d_in, const int* in_sizes, int n_in, void* d_out, int out_size, void* d_ws, size_t ws_size, hipStream_t stream) {
    static int grid = 0;
    if (grid == 0) {
        if (n_in != 31 || out_size != M * DM || ws_size < WS_END) { fprintf(stderr, "kernel_launch: unexpected problem (n_in %d, out %d, ws %zu)\n", n_in, out_size, ws_size); grid = -1; return; }
        if (set_attrs() != hipSuccess) { fprintf(stderr, "kernel_launch: hipFuncSetAttribute failed\n"); grid = -1; return; }
        int dev = 0, cus = 0;
        if (hipGetDevice(&dev) != hipSuccess || hipDeviceGetAttribute(&cus, hipDeviceAttributeMultiprocessorCount, dev) != hipSuccess) { grid = -1; return; }
        grid = cus;
    }
    if (grid < 0) return;
    (void)hipMemsetAsync((char*)d_ws + WS_CTL, 0, CTL_ZERO_BYTES, stream);
    Args a{};
    for (int i = 0; i < 31; ++i) a.in[i] = d_in[i];
    a.out = (float*)d_out; a.ws = (unsigned char*)d_ws;
#if MK_ONE_LAUNCH
    a.ph_lo = 0; a.ph_hi = PROBE_REPS;
    launch1<-1>(a, grid, stream);
#else
    for (int l = 0; l < 2; ++l) { a.ph_lo = l; a.ph_hi = l + 1; launch_phases(a, grid, stream, std::make_integer_sequence<int, NPH>{}); }
#endif
}
```

```cpp
#include <hip/hip_runtime.h>
#include <cstdio>
#include <cstdint>
#include <cmath>
#include <utility>
#include <initializer_list>
#define MK_ONE_LAUNCH 1
#define PROBE_MASK 262144u
#define PROBE_REPS 1
#define PROBE_XBAR 0
#define PROBE_XP 0
#define FA_FULL 1
#define FA_RESC 1
#define FA_VAR 0
#define FA_CORE_MEM fa::flash_core_v4
#define FA_CORE_FOX fa::flash_core_v4
#define FA_CORE_SEL fa::flash_core_v4
#define GAS __attribute__((address_space(1)))
#define LAS __attribute__((address_space(3)))
namespace pg8 {
#define PG8_LAS __attribute__((address_space(3)))
typedef unsigned short bf16_t;
typedef short bf16x8 __attribute__((ext_vector_type(8)));
typedef float f32x4 __attribute__((ext_vector_type(4)));
typedef unsigned u32x4 __attribute__((ext_vector_type(4)));
constexpr int BM = 256, BK = 64, HALF = 128, HTB = HALF * BK * 2  , STAGE_BYTES = 8 * HTB, NXCD = 8, WGM = 8;

__host__ __device__ __forceinline__ int lds_byte(int r, int c) { const int st = (r >> 4) * 2 + (c >> 5), rr = r & 15, cc = c & 31, ob = rr * 64 + cc * 2; return st * 1024 + (ob ^ (((ob >> 9) & 1) << 5)); }
__host__ __device__ __forceinline__ void stage_rc(int b, int& R, int& C) { const int st = b / 1024, sb = b % 1024, swz = sb ^ (((sb >> 9) & 1) << 5); R = (st >> 1) * 16 + swz / 64; C = (st & 1) * 32 + (swz % 64) / 2; }
__host__ __device__ __forceinline__ int perm32(int rho) { const int n = rho >> 4, i = rho & 15; return 8 * (i >> 2) + 4 * n + (i & 3); }

struct Unit { int pm, pn; };
struct Gemm { const bf16_t* A; const bf16_t* Bt; int M, N, K; int lda, ldb; };

struct StaticOrder {
    int nM, nN, nwg, G, c;
    __host__ __device__ void init(int M, int N, int G_, int c_) { nM = M / BM; nN = N / BM; nwg = nM * nN; G = G_; c = c_; }
    __host__ __device__ bool next(int i, Unit& u) const {
        const long L = (long)i * G + c; if (L >= nwg) return false;
        int wgid = (int)L; { const int q = nwg / NXCD, r = nwg % NXCD, xcd = wgid % NXCD, off = wgid / NXCD; wgid = (xcd < r ? xcd * (q + 1) : r * (q + 1) + (xcd - r) * q) + off; }
        const int nig = WGM * nN, gid = wgid / nig, fm = gid * WGM, gsz = (nM - fm) < WGM ? (nM - fm) : WGM;
        u.pm = fm + ((wgid % nig) % gsz); u.pn = (wgid % nig) / gsz; return true;
    }
    __device__ __forceinline__ void a_ready(const Unit&) const {}
    __device__ __forceinline__ void done(const Unit&) const {}
};

typedef float cvt_f32x2_t __attribute__((ext_vector_type(2))); typedef __bf16 cvt_bf16x2_t __attribute__((ext_vector_type(2)));
__device__ __forceinline__ unsigned cvt_pk_bf16(float lo, float hi) { const cvt_f32x2_t v = {lo, hi}; const cvt_bf16x2_t b = __builtin_convertvector(v, cvt_bf16x2_t); return __builtin_bit_cast(unsigned, b); }
typedef float f32x2 __attribute__((ext_vector_type(2)));
template <class Epi, class Sched, bool ALIGN_EPI = false, bool SP2 = false>
__device__ __forceinline__ void gemm_phase(PG8_LAS unsigned char* lds, const Gemm g, const Sched& S, const Epi& E) {
    int tid_ = threadIdx.x; asm volatile("" : "+v"(tid_));
    const int tid = tid_, wid = __builtin_amdgcn_readfirstlane(tid >> 6), lane = tid & 63, wr = wid >> 2, wc = wid & 3, fr = lane & 15, fq = lane >> 4;
    const int K = g.K, nt = K / BK, lda = g.lda ? g.lda : K, ldb = g.ldb ? g.ldb : K;
    unsigned voffA[2], voffB[2];
#pragma unroll
    for (int i = 0; i < 2; ++i) { int R, C; stage_rc(tid * 16 + i * 8192, R, C); const int Rb = Epi::PERM ? ((R & ~31) + perm32(R & 31)) : R;
        voffA[i] = (unsigned)(R * lda + C) * 2u; voffB[i] = (unsigned)(Rb * ldb + C) * 2u; }
    const size_t kstep = (size_t)(BK * 2);
    const size_t hstepA = (size_t)HALF * lda * 2, hstepB = (size_t)HALF * ldb * 2;
    const size_t tstepA = 2 * hstepA, tstepB = 2 * hstepB;
    const unsigned ldsw = (unsigned)wid * 1024u;
    const int aoff = lds_byte(wr * 64 + fr, fq * 8), boff = lds_byte(wc * 32 + fr, fq * 8);
#define PG8_SA(b, h) (((b) * 2 + (h)) * HTB)
#define PG8_SB(b, h) ((4 + (b) * 2 + (h)) * HTB)
#define PG8_STAGE(bufoff, gbase, voff) do { _Pragma("unroll") for (int _i = 0; _i < 2; ++_i) \
        __builtin_amdgcn_global_load_lds((const unsigned*)((const char*)(gbase) + (voff)[_i]), (PG8_LAS unsigned*)(lds + (bufoff) + ldsw + _i * 8192), 16, 0, 0); } while (0)
#define PG8_LDA(dst, b, h) do { _Pragma("unroll") for (int m = 0; m < 4; ++m) _Pragma("unroll") for (int k = 0; k < 2; ++k) dst[m][k] = *(const PG8_LAS bf16x8*)(lds + PG8_SA(b, h) + aoff + m * 2048 + k * 1024); } while (0)
#define PG8_LDB(dst, b, h) do { _Pragma("unroll") for (int n = 0; n < 2; ++n) _Pragma("unroll") for (int k = 0; k < 2; ++k) dst[n][k] = *(const PG8_LAS bf16x8*)(lds + PG8_SB(b, h) + boff + n * 2048 + k * 1024); } while (0)
#define PG8_MMA(ai, bj, At, Bt) do { __builtin_amdgcn_s_setprio(1); _Pragma("unroll") for (int m = 0; m < 4; ++m) _Pragma("unroll") for (int n = 0; n < 2; ++n) _Pragma("unroll") for (int k = 0; k < 2; ++k) \
        acc[ai][bj][m][n] = __builtin_amdgcn_mfma_f32_16x16x32_bf16(Bt[n][k], At[m][k], acc[ai][bj][m][n], 0, 0, 0); __builtin_amdgcn_s_setprio(0); } while (0)
#define PG8_WAIT_V(n) asm volatile("s_waitcnt vmcnt(" #n ")" ::: "memory")
#define PG8_WAIT_L(n) asm volatile("s_waitcnt lgkmcnt(" #n ")" ::: "memory")
#define PG8_BAR __builtin_amdgcn_s_barrier()
#define PG8_SCHED __builtin_amdgcn_sched_barrier(0)
    Unit cur, nxt; int ui = 0;
    if (!S.next(0, cur)) return;
    float zz_ = 0.f; asm volatile("" : "+v"(zz_));
    f32x4 acc[2][2][4][2];
#pragma unroll
    for (int a = 0; a < 2; ++a)
#pragma unroll
        for (int b = 0; b < 2; ++b)
#pragma unroll
            for (int m = 0; m < 4; ++m)
#pragma unroll
                for (int n = 0; n < 2; ++n) acc[a][b][m][n] = (f32x4){zz_, zz_, zz_, zz_};
    bf16x8 At[4][2], B0[2][2], B1[2][2];
    const char* cA = (const char*)g.A + (size_t)cur.pm * tstepA; const char* cB = (const char*)g.Bt + (size_t)cur.pn * tstepB;
    S.a_ready(cur);
    if constexpr (SP2) {
        PG8_STAGE(PG8_SB(0, 0), cB, voffB); PG8_STAGE(PG8_SB(0, 1), cB + hstepB, voffB); PG8_STAGE(PG8_SA(0, 0), cA, voffA); PG8_STAGE(PG8_SA(0, 1), cA + hstepA, voffA);
        if (wr == 1) PG8_BAR;
        PG8_WAIT_V(2); PG8_BAR;
        PG8_STAGE(PG8_SB(1, 0), cB + kstep, voffB); PG8_STAGE(PG8_SA(1, 0), cA + kstep, voffA); PG8_STAGE(PG8_SB(1, 1), cB + hstepB + kstep, voffB);
        PG8_WAIT_V(6); PG8_BAR;
    } else {
        PG8_STAGE(PG8_SB(0, 0), cB, voffB); PG8_STAGE(PG8_SA(0, 0), cA, voffA); PG8_STAGE(PG8_SB(0, 1), cB + hstepB, voffB); PG8_STAGE(PG8_SA(0, 1), cA + hstepA, voffA);
        if (wr == 1) PG8_BAR;
        PG8_WAIT_V(4); PG8_BAR;
        PG8_STAGE(PG8_SB(1, 0), cB + kstep, voffB); PG8_STAGE(PG8_SA(1, 0), cA + kstep, voffA); PG8_STAGE(PG8_SB(1, 1), cB + hstepB + kstep, voffB);
        PG8_WAIT_V(6); PG8_BAR;
    }
    for (;;) {
        const bool has_next = S.next(ui + 1, nxt);
        const char* nA = has_next ? (const char*)g.A + (size_t)nxt.pm * tstepA : cA; const char* nB = has_next ? (const char*)g.Bt + (size_t)nxt.pn * tstepB : cB;
        for (int t = 0; t < nt; t += 2) {
            const bool last = (t == nt - 2);
            const char* a1 = cA + (size_t)(t + 1) * kstep;
            const char* a2 = last ? nA : cA + (size_t)(t + 2) * kstep; const char* b2 = last ? nB : cB + (size_t)(t + 2) * kstep;
            const char* a3 = a2 + kstep; const char* b3 = b2 + kstep;
            if (last && has_next) S.a_ready(nxt);
            if constexpr (SP2) {
            PG8_LDB(B0, 0, 0); PG8_LDB(B1, 0, 1); PG8_SCHED; PG8_LDA(At, 0, 0); PG8_STAGE(PG8_SA(1, 1), a1 + hstepA, voffA);
            PG8_WAIT_V(8); PG8_WAIT_L(0); PG8_BAR; PG8_MMA(0, 0, At, B0); PG8_MMA(0, 1, At, B1); PG8_BAR; PG8_SCHED;
            PG8_LDA(At, 0, 1); PG8_STAGE(PG8_SB(0, 0), b2, voffB); PG8_STAGE(PG8_SB(0, 1), b2 + hstepB, voffB); PG8_STAGE(PG8_SA(0, 0), a2, voffA);
            PG8_WAIT_V(8); PG8_WAIT_L(0); PG8_BAR; PG8_MMA(1, 0, At, B0); PG8_MMA(1, 1, At, B1); PG8_BAR; PG8_SCHED;
            PG8_LDB(B0, 1, 0); PG8_LDB(B1, 1, 1); PG8_SCHED; PG8_LDA(At, 1, 0); PG8_STAGE(PG8_SA(0, 1), a2 + hstepA, voffA);
            PG8_WAIT_V(8); PG8_WAIT_L(0); PG8_BAR; PG8_MMA(0, 0, At, B0); PG8_MMA(0, 1, At, B1); PG8_BAR; PG8_SCHED;
            PG8_LDA(At, 1, 1); PG8_STAGE(PG8_SB(1, 0), b3, voffB); PG8_STAGE(PG8_SB(1, 1), b3 + hstepB, voffB); PG8_STAGE(PG8_SA(1, 0), a3, voffA);
            PG8_WAIT_V(8); PG8_WAIT_L(0); PG8_BAR; PG8_MMA(1, 0, At, B0); PG8_MMA(1, 1, At, B1); PG8_BAR; PG8_SCHED;
            } else {
            PG8_LDB(B0, 0, 0); PG8_SCHED; PG8_LDA(At, 0, 0); PG8_STAGE(PG8_SA(1, 1), a1 + hstepA, voffA);
            PG8_WAIT_L(8); PG8_BAR; PG8_WAIT_L(0); PG8_MMA(0, 0, At, B0); PG8_BAR; PG8_SCHED;
            PG8_LDB(B1, 0, 1); PG8_STAGE(PG8_SB(0, 0), b2, voffB);
            PG8_BAR; PG8_WAIT_L(0); PG8_MMA(0, 1, At, B1); PG8_BAR;
            PG8_LDA(At, 0, 1); PG8_STAGE(PG8_SA(0, 0), a2, voffA);
            PG8_BAR; PG8_WAIT_L(0); PG8_MMA(1, 0, At, B0); PG8_BAR; PG8_SCHED;
            PG8_STAGE(PG8_SB(0, 1), b2 + hstepB, voffB);
            PG8_WAIT_V(6); PG8_BAR; PG8_MMA(1, 1, At, B1); PG8_BAR;
            PG8_LDB(B0, 1, 0); PG8_SCHED; PG8_LDA(At, 1, 0); PG8_STAGE(PG8_SA(0, 1), a2 + hstepA, voffA);
            PG8_WAIT_L(8); PG8_BAR; PG8_WAIT_L(0); PG8_MMA(0, 0, At, B0); PG8_BAR; PG8_SCHED;
            PG8_LDB(B1, 1, 1); PG8_STAGE(PG8_SB(1, 0), b3, voffB);
            PG8_BAR; PG8_WAIT_L(0); PG8_MMA(0, 1, At, B1); PG8_BAR;
            PG8_LDA(At, 1, 1); PG8_STAGE(PG8_SA(1, 0), a3, voffA);
            PG8_BAR; PG8_WAIT_L(0); PG8_MMA(1, 0, At, B0); PG8_BAR; PG8_SCHED;
            PG8_STAGE(PG8_SB(1, 1), b3 + hstepB, voffB);
            PG8_WAIT_V(6); PG8_BAR; PG8_MMA(1, 1, At, B1); PG8_BAR;
            }
        }
        if constexpr (ALIGN_EPI) { if (wr == 0) PG8_BAR; }
        if constexpr (!Epi::AFTER_DRAIN) { E(acc, cur, wr, wc, fr, fq); S.done(cur); }
        if (!has_next) break;
#pragma unroll
        for (int a = 0; a < 2; ++a)
#pragma unroll
            for (int b = 0; b < 2; ++b)
#pragma unroll
                for (int m = 0; m < 4; ++m)
#pragma unroll
                    for (int n = 0; n < 2; ++n) acc[a][b][m][n] = (f32x4){zz_, zz_, zz_, zz_};
        cur = nxt; cA = nA; cB = nB; ++ui;
        if constexpr (ALIGN_EPI) { if (wr == 1) PG8_BAR; }
    }
    PG8_WAIT_V(0);
    if constexpr (!ALIGN_EPI) { if (wr == 0) PG8_BAR; }
    PG8_BAR;
    if constexpr (Epi::AFTER_DRAIN) { E.fused(acc, cur, wr, wc, fr, fq, lds, wid, lane); S.done(cur); }
#undef PG8_SA
#undef PG8_SB
#undef PG8_STAGE
#undef PG8_LDA
#undef PG8_LDB
#undef PG8_MMA
#undef PG8_WAIT_V
#undef PG8_WAIT_L
#undef PG8_BAR
#undef PG8_SCHED
}
}
#define XB_TMO      128
#define XB_XCNT(j)  (256  + 64 * (j))
#define XB_XSUB(j)  (1280 + 64 * (j))
#define XB_XGEN(j)  (2304 + 64 * (j))
#define XB_TOP      3328
#define XB_TOPGEN   3392
#define XCD_BAR_WORDS 3456
#define XB_SPIN_CAP (1u << 18)

__device__ __forceinline__ unsigned xb_ld(unsigned* p)              { return __hip_atomic_load(p, __ATOMIC_RELAXED, __HIP_MEMORY_SCOPE_AGENT); }
__device__ __forceinline__ unsigned xb_add(unsigned* p, unsigned v) { return __hip_atomic_fetch_add(p, v, __ATOMIC_RELAXED, __HIP_MEMORY_SCOPE_AGENT); }
__device__ __forceinline__ unsigned xb_xcc_id() { return (unsigned)__builtin_amdgcn_s_getreg((3 << 11) | 20) & 0xFu; }
#define XB_SPIN(cond, bar) do { unsigned _sp = 0; while (cond) { __builtin_amdgcn_s_sleep(1); \
    if ((++_sp & 255u) == 0u) { if (xb_ld(&(bar)[XB_TMO])) break; if (_sp > XB_SPIN_CAP) { atomicAdd(&(bar)[XB_TMO], 1u); break; } } } } while (0)

struct XcdBarrier {
    unsigned* bar; unsigned x;
    volatile LAS unsigned* st;
};

__device__ __forceinline__ XcdBarrier xcd_barrier_post(unsigned* bar, volatile LAS unsigned* st) {
    XcdBarrier b; b.bar = bar; b.x = xb_xcc_id(); b.st = st;
    if (threadIdx.x == 0) (void)xb_add(&bar[XB_XCNT(b.x)], 1u);
    return b;
}
__device__ __forceinline__ void xcd_barrier_complete(unsigned* bar, unsigned x, unsigned& nloc, unsigned& nx) {
    const unsigned G = gridDim.x * gridDim.y * gridDim.z;
    unsigned sum, cnt, mine, sp = 0u;
    for (;;) {
        sum = 0u; cnt = 0u; mine = 0u;
#pragma unroll
        for (unsigned j = 0; j < 16; ++j) { const unsigned c = xb_ld(&bar[XB_XCNT(j)]); sum += c; cnt += (c > 0u) ? 1u : 0u; mine = (j == x) ? c : mine; }
        if (sum == G) break;
        __builtin_amdgcn_s_sleep(1);
        if ((++sp & 255u) == 0u) { if (xb_ld(&bar[XB_TMO])) break; if (sp > XB_SPIN_CAP) { atomicAdd(&bar[XB_TMO], 1u); break; } }
    }
    nloc = mine > 0u ? mine : 1u; nx = cnt > 0u ? cnt : 1u;
}

__device__ __forceinline__ void xcd_barrier(const XcdBarrier& b) {
    asm volatile("s_waitcnt vmcnt(0)" ::: "memory");
    __syncthreads();
    if (threadIdx.x == 0) {
        unsigned* bar = b.bar;
        __builtin_amdgcn_s_waitcnt(0);
        unsigned nloc = b.st[0], nx = b.st[1];
        if (nloc == 0u) { xcd_barrier_complete(bar, b.x, nloc, nx); b.st[0] = nloc; b.st[1] = nx; }
        const unsigned old = xb_add(&bar[XB_XSUB(b.x)], 1u);
        const unsigned gen = old / nloc;
        if (old + 1u == (gen + 1u) * nloc) {
            __builtin_amdgcn_fence(__ATOMIC_RELEASE, "agent");
            asm volatile("s_waitcnt vmcnt(0)" ::: "memory");
            const unsigned og = xb_add(&bar[XB_TOP], 1u);
            const unsigned tg = og / nx;
            if (og + 1u == (tg + 1u) * nx) xb_add(&bar[XB_TOPGEN], 1u);
            else XB_SPIN(xb_ld(&bar[XB_TOPGEN]) == tg, bar);
            __builtin_amdgcn_fence(__ATOMIC_ACQUIRE, "agent");
            xb_add(&bar[XB_XGEN(b.x)], 1u);
            asm volatile("s_waitcnt vmcnt(0)" ::: "memory");
        } else {
            XB_SPIN(xb_ld(&bar[XB_XGEN(b.x)]) == gen, bar);
            __builtin_amdgcn_fence(__ATOMIC_ACQUIRE, "agent");
            asm volatile("s_waitcnt vmcnt(0)" ::: "memory");
        }
    }
    __syncthreads();
}

namespace pg8 {
typedef unsigned u32x4e __attribute__((ext_vector_type(4)));
typedef int i32x4e __attribute__((ext_vector_type(4)));
__device__ __forceinline__ __amdgpu_buffer_rsrc_t wt_rsrc(const void* base) {
    const unsigned long long b = (unsigned long long)base;
    void* ub = (void*)(((unsigned long long)(unsigned)__builtin_amdgcn_readfirstlane((int)(b >> 32)) << 32) | (unsigned)__builtin_amdgcn_readfirstlane((int)b));
    return __builtin_amdgcn_make_buffer_rsrc(ub, (short)0, (int)0x7ffffff0, 0x00020000); }
__device__ __forceinline__ void st16_wt(__amdgpu_buffer_rsrc_t r, unsigned off, u32x4e w) { __builtin_amdgcn_raw_buffer_store_b128(w, r, (int)off, 0, 16); }
struct EpiPlain {
    static constexpr bool PERM = true, AFTER_DRAIN = false;
    bf16_t* O; int ld;
    __device__ __forceinline__ void operator()(const f32x4 (&acc)[2][2][4][2], const Unit& u, int wr, int wc, int fr, int fq) const {
        bf16_t* base = O + (size_t)(u.pm * BM + wr * 64 + fr) * ld + u.pn * BM + wc * 32 + 8 * fq;
        const bf16_t* wt_base_ = O; const __amdgpu_buffer_rsrc_t wt_r_ = wt_rsrc(wt_base_);
#pragma unroll
        for (int ai = 0; ai < 2; ++ai)
#pragma unroll
            for (int m = 0; m < 4; ++m) { bf16_t* rowp = base + (size_t)(ai * HALF + m * 16) * ld;
#pragma unroll
                for (int bj = 0; bj < 2; ++bj) { const f32x4 v0 = acc[ai][bj][m][0], v1 = acc[ai][bj][m][1];
                    u32x4e w; w.x = cvt_pk_bf16(v0[0], v0[1]); w.y = cvt_pk_bf16(v0[2], v0[3]); w.z = cvt_pk_bf16(v1[0], v1[1]); w.w = cvt_pk_bf16(v1[2], v1[3]);
                    st16_wt(wt_r_, (unsigned)((const char*)(rowp + bj * HALF) - (const char*)wt_base_), w); } }
    }
};
struct EpiProj {
    static constexpr bool PERM = true, AFTER_DRAIN = false;
    bf16_t* ck;
    bf16_t* oq; bf16_t* kv;
    int Mrows;
    __device__ __forceinline__ void operator()(const f32x4 (&acc)[2][2][4][2], const Unit& u, int wr, int wc, int fr, int fq) const {
        const int pn = u.pn; const size_t MS = (size_t)Mrows * 512;
        bf16_t* dst; int ld, c0;
        if (pn < 2)       { dst = oq;            ld = 512; c0 = pn * 256; }
        else if (pn < 4)  { dst = kv;            ld = 512; c0 = (pn - 2) * 256; }
        else if (pn < 6)  { dst = kv + MS;       ld = 512; c0 = (pn - 4) * 256; }
        else if (pn < 8)  { dst = oq + MS;       ld = 512; c0 = (pn - 6) * 256; }
        else if (pn < 11) { dst = kv + 4 * MS;   ld = 768; c0 = (pn - 8) * 256; }
        else if (pn < 13) { dst = oq + 2 * MS;   ld = 512; c0 = (pn - 11) * 256; }
        else if (pn < 15) { dst = kv + 2 * MS;   ld = 512; c0 = (pn - 13) * 256; }
        else if (pn < 17) { dst = kv + 3 * MS;   ld = 512; c0 = (pn - 15) * 256; }
        else              { dst = kv + 4 * MS + (size_t)Mrows * 768; ld = 256; c0 = 0; }
        bf16_t* base = dst + (size_t)(u.pm * BM + wr * 64 + fr) * ld + c0 + wc * 32 + 8 * fq;
        size_t bjs = HALF;
        if (pn == 8) {
            base = ck + ((size_t)(wc >> 1) * Mrows + (size_t)(u.pm * BM + wr * 64 + fr)) * 64 + (wc & 1) * 32 + 8 * fq; ld = 64; bjs = (size_t)2 * Mrows * 64; }
        const bf16_t* wt_base_ = (pn == 8 ? ck : dst); const __amdgpu_buffer_rsrc_t wt_r_ = wt_rsrc(wt_base_);
#pragma unroll
        for (int ai = 0; ai < 2; ++ai)
#pragma unroll
            for (int m = 0; m < 4; ++m) { bf16_t* rowp = base + (size_t)(ai * HALF + m * 16) * ld;
#pragma unroll
                for (int bj = 0; bj < 2; ++bj) { const f32x4 v0 = acc[ai][bj][m][0], v1 = acc[ai][bj][m][1];
                    u32x4e w; w.x = cvt_pk_bf16(v0[0], v0[1]); w.y = cvt_pk_bf16(v0[2], v0[3]); w.z = cvt_pk_bf16(v1[0], v1[1]); w.w = cvt_pk_bf16(v1[2], v1[3]);
                    st16_wt(wt_r_, (unsigned)((const char*)(rowp + bj * bjs) - (const char*)wt_base_), w); } }
    }
};
__device__ __forceinline__ float sigmoidf_(float x) { return __builtin_amdgcn_rcpf(1.0f + __expf(-x)); }
struct EpiSigmoid {
    static constexpr bool PERM = true, AFTER_DRAIN = false;
    bf16_t* O; int ld;
    __device__ __forceinline__ void operator()(const f32x4 (&acc)[2][2][4][2], const Unit& u, int wr, int wc, int fr, int fq) const {
        bf16_t* base = O + (size_t)(u.pm * BM + wr * 64 + fr) * ld + u.pn * BM + wc * 32 + 8 * fq;
#pragma unroll
        for (int ai = 0; ai < 2; ++ai)
#pragma unroll
            for (int m = 0; m < 4; ++m) { bf16_t* rowp = base + (size_t)(ai * HALF + m * 16) * ld;
#pragma unroll
                for (int bj = 0; bj < 2; ++bj) { f32x4 v0 = acc[ai][bj][m][0], v1 = acc[ai][bj][m][1];
#pragma unroll
                    for (int e = 0; e < 4; ++e) { v0[e] = sigmoidf_(v0[e]); v1[e] = sigmoidf_(v1[e]); }
                    u32x4e w; w.x = cvt_pk_bf16(v0[0], v0[1]); w.y = cvt_pk_bf16(v0[2], v0[3]); w.z = cvt_pk_bf16(v1[0], v1[1]); w.w = cvt_pk_bf16(v1[2], v1[3]);
                    *(u32x4e*)(rowp + bj * HALF) = w; } }
    }
};
struct EpiGateY {
    static constexpr bool PERM = true, AFTER_DRAIN = false;
    const bf16_t* MG; bf16_t* Y; bool dry;
    __device__ __forceinline__ void operator()(const f32x4 (&acc)[2][2][4][2], const Unit& u, int wr, int wc, int fr, int fq) const {
        const int branch = u.pm >> 6, pmr = u.pm & 63, pnr = u.pn & 3;
        const size_t r0 = (size_t)(pmr * BM + wr * 64 + fr); const int c0 = pnr * BM + wc * 32 + 8 * fq;
#pragma unroll
        for (int ai = 0; ai < 2; ++ai)
#pragma unroll
            for (int m = 0; m < 4; ++m) { const size_t row = r0 + ai * HALF + m * 16;
#pragma unroll
                for (int bj = 0; bj < 2; ++bj) { const f32x4 v0 = acc[ai][bj][m][0], v1 = acc[ai][bj][m][1];
                    const u32x4e g = *(const u32x4e*)(MG + row * 3072 + branch * 1024 + c0 + bj * HALF);
                    bf16_t* yp = Y + row * 1024 + c0 + bj * HALF;
                    float y[8];
                    y[0] = v0[0] * __uint_as_float(g.x << 16); y[1] = v0[1] * __uint_as_float(g.x & 0xffff0000u); y[2] = v0[2] * __uint_as_float(g.y << 16); y[3] = v0[3] * __uint_as_float(g.y & 0xffff0000u);
                    y[4] = v1[0] * __uint_as_float(g.z << 16); y[5] = v1[1] * __uint_as_float(g.z & 0xffff0000u); y[6] = v1[2] * __uint_as_float(g.w << 16); y[7] = v1[3] * __uint_as_float(g.w & 0xffff0000u);
                    if (branch != 0) { const u32x4e p = *(const u32x4e*)yp;
                        y[0] += __uint_as_float(p.x << 16); y[1] += __uint_as_float(p.x & 0xffff0000u); y[2] += __uint_as_float(p.y << 16); y[3] += __uint_as_float(p.y & 0xffff0000u);
                        y[4] += __uint_as_float(p.z << 16); y[5] += __uint_as_float(p.z & 0xffff0000u); y[6] += __uint_as_float(p.w << 16); y[7] += __uint_as_float(p.w & 0xffff0000u); }
                    u32x4e w; w.x = cvt_pk_bf16(y[0], y[1]); w.y = cvt_pk_bf16(y[2], y[3]); w.z = cvt_pk_bf16(y[4], y[5]); w.w = cvt_pk_bf16(y[6], y[7]);
                    if (!dry) *(u32x4e*)yp = w; } }
    }
};
struct EpiUpU {
    static constexpr bool PERM = true, AFTER_DRAIN = false;
    bf16_t* U;
    __device__ __forceinline__ void operator()(const f32x4 (&acc)[2][2][4][2], const Unit& u, int wr, int wc, int fr, int fq) const {
        const int pmr = u.pm & 63;
        bf16_t* base = U + (size_t)(pmr * BM + wr * 64 + fr) * 3072 + u.pn * BM + wc * 32 + 8 * fq;
        const bf16_t* wt_base_ = U; const __amdgpu_buffer_rsrc_t wt_r_ = wt_rsrc(wt_base_);
#pragma unroll
        for (int ai = 0; ai < 2; ++ai)
#pragma unroll
            for (int m = 0; m < 4; ++m) { bf16_t* rowp = base + (size_t)(ai * HALF + m * 16) * 3072;
#pragma unroll
                for (int bj = 0; bj < 2; ++bj) { const f32x4 v0 = acc[ai][bj][m][0], v1 = acc[ai][bj][m][1];
                    u32x4e w; w.x = cvt_pk_bf16(v0[0], v0[1]); w.y = cvt_pk_bf16(v0[2], v0[3]); w.z = cvt_pk_bf16(v1[0], v1[1]); w.w = cvt_pk_bf16(v1[2], v1[3]);
                    st16_wt(wt_r_, (unsigned)((const char*)(rowp + bj * HALF) - (const char*)wt_base_), w); } }
    }
};
struct EpiGateY2 {
    static constexpr bool PERM = true, AFTER_DRAIN = false;
    const bf16_t* U; bf16_t* Y; bool dry;
    __device__ __forceinline__ void operator()(const f32x4 (&acc)[2][2][4][2], const Unit& u, int wr, int wc, int fr, int fq) const {
        const int branch = u.pn >> 2, pnr = u.pn & 3;
        const size_t r0 = (size_t)(u.pm * BM + wr * 64 + fr); const int c0 = pnr * BM + wc * 32 + 8 * fq;
        const __amdgpu_buffer_rsrc_t yr_ = wt_rsrc(Y);
#pragma unroll
        for (int ai = 0; ai < 2; ++ai)
#pragma unroll
            for (int m = 0; m < 4; ++m) { const size_t row = r0 + ai * HALF + m * 16;
#pragma unroll
                for (int bj = 0; bj < 2; ++bj) { const f32x4 v0 = acc[ai][bj][m][0], v1 = acc[ai][bj][m][1];
                    const u32x4e g = __builtin_nontemporal_load((const u32x4e*)(U + row * 3072 + branch * 1024 + c0 + bj * HALF));
                    bf16_t* yp = Y + row * 1024 + c0 + bj * HALF;
                    float y[8];
                    y[0] = sigmoidf_(v0[0]) * __uint_as_float(g.x << 16); y[1] = sigmoidf_(v0[1]) * __uint_as_float(g.x & 0xffff0000u); y[2] = sigmoidf_(v0[2]) * __uint_as_float(g.y << 16); y[3] = sigmoidf_(v0[3]) * __uint_as_float(g.y & 0xffff0000u);
                    y[4] = sigmoidf_(v1[0]) * __uint_as_float(g.z << 16); y[5] = sigmoidf_(v1[1]) * __uint_as_float(g.z & 0xffff0000u); y[6] = sigmoidf_(v1[2]) * __uint_as_float(g.w << 16); y[7] = sigmoidf_(v1[3]) * __uint_as_float(g.w & 0xffff0000u);
                    if (branch != 0) { const u32x4e p = *(const u32x4e*)yp;
                        y[0] += __uint_as_float(p.x << 16); y[1] += __uint_as_float(p.x & 0xffff0000u); y[2] += __uint_as_float(p.y << 16); y[3] += __uint_as_float(p.y & 0xffff0000u);
                        y[4] += __uint_as_float(p.z << 16); y[5] += __uint_as_float(p.z & 0xffff0000u); y[6] += __uint_as_float(p.w << 16); y[7] += __uint_as_float(p.w & 0xffff0000u); }
                    u32x4e w; w.x = cvt_pk_bf16(y[0], y[1]); w.y = cvt_pk_bf16(y[2], y[3]); w.z = cvt_pk_bf16(y[4], y[5]); w.w = cvt_pk_bf16(y[6], y[7]);
                    if (!dry) st16_wt(yr_, (unsigned)((const char*)yp - (const char*)Y), w); } }
    }
};
struct MergeOrder {
    StaticOrder so; int G, c;
    __host__ __device__ void init(int M_, int G_, int c_) { so.init(M_, 1024, 256, 0); G = G_; c = c_; }
    __host__ __device__ bool next(int i, Unit& u) const {
        const int tile = c + (i / 3) * G, branch = i % 3; if (tile >= 256) return false;
        StaticOrder t = so; t.c = tile; Unit v; t.next(0, v);
        u.pm = v.pm; u.pn = branch * 4 + v.pn; return true;
    }
    __device__ __forceinline__ void a_ready(const Unit&) const {}
    __device__ __forceinline__ void done(const Unit&) const {}
};
struct EpiSwiglu {
    static constexpr bool PERM = true, AFTER_DRAIN = false;
    bf16_t* O; int ld;
    __device__ __forceinline__ void operator()(const f32x4 (&acc)[2][2][4][2], const Unit& u, int wr, int wc, int fr, int fq) const {
        bf16_t* base = O + (size_t)(u.pm * BM + wr * 64 + fr) * ld + u.pn * HALF + wc * 32 + 8 * fq;
        const bf16_t* wt_base_ = O; const __amdgpu_buffer_rsrc_t wt_r_ = wt_rsrc(wt_base_);
#pragma unroll
        for (int ai = 0; ai < 2; ++ai)
#pragma unroll
            for (int m = 0; m < 4; ++m) { bf16_t* rowp = base + (size_t)(ai * HALF + m * 16) * ld;
                f32x4 v0 = acc[ai][0][m][0], v1 = acc[ai][0][m][1]; const f32x4 u0 = acc[ai][1][m][0], u1 = acc[ai][1][m][1];
#pragma unroll
                for (int e = 0; e < 4; ++e) { v0[e] = v0[e] * sigmoidf_(v0[e]) * u0[e]; v1[e] = v1[e] * sigmoidf_(v1[e]) * u1[e]; }
                u32x4e w; w.x = cvt_pk_bf16(v0[0], v0[1]); w.y = cvt_pk_bf16(v0[2], v0[3]); w.z = cvt_pk_bf16(v1[0], v1[1]); w.w = cvt_pk_bf16(v1[2], v1[3]);
                st16_wt(wt_r_, (unsigned)((const char*)rowp - (const char*)wt_base_), w); }
    }
};
struct UpOrder {
    StaticOrder so; int G, c;
    __host__ __device__ void init(int M_, int G_, int c_) { so.init(M_, 1024, 256, 0); G = G_; c = c_; }
    __host__ __device__ bool next(int i, Unit& u) const {
        const int tile = c + (i / 3) * G, branch = i % 3; if (tile >= 256) return false;
        StaticOrder t = so; t.c = tile; Unit v; t.next(0, v);
        u.pm = branch * 64 + v.pm; u.pn = branch * 4 + v.pn; return true;
    }
    __device__ __forceinline__ void a_ready(const Unit&) const {}
    __device__ __forceinline__ void done(const Unit&) const {}
};
}

constexpr int NB = 8, SEQ = 2048, DM = 1024, M = NB * SEQ;
constexpr int NMEM = 256, MMEM = NB * NMEM;
constexpr int DFF = 2816, DIN = 7456, NA = 4608;
constexpr float RMS_EPS = 1e-6f;
constexpr int NWAVES = 8, NTHREADS = 512;

constexpr size_t MiB = 1u << 20;
constexpr size_t WS_CTL = 0, CTL_ZERO_BYTES = 64 * 1024;
constexpr size_t WS_W = 1 * MiB;
constexpr size_t W_A = WS_W, W_M = W_A + (size_t)NA * 1024 * 2, W_C1K = W_M + 3072ull * 1024 * 2, W_C1V = W_C1K + 512ull * 1024 * 2,
                 W_UP = W_C1V + 512ull * 1024 * 2, W_OUT3 = W_UP + 3072ull * 512 * 2, W_MQ = W_OUT3 + 1024ull * 3072 * 2, W_MKV = W_MQ + 256ull * 1024 * 2,
                 W_MO = W_MKV + 512ull * 1024 * 2, W_GU = W_MO + 1024ull * 256 * 2, W_DN = W_GU + 5632ull * 1024 * 2, W_B1PART = W_DN + 1024ull * 2816 * 2,
                 W_END = W_B1PART + 2ull * 32 * 256 * 4;
constexpr size_t WS_H = 47 * MiB;
constexpr size_t WS_OQ = 79 * MiB;
constexpr size_t WS_KV = 127 * MiB;
constexpr size_t WS_MG = WS_KV;
constexpr size_t WS_ACT = WS_OQ;
constexpr size_t WS_MQ = WS_OQ, WS_MO = WS_OQ + 32 * MiB;
constexpr size_t WS_MISC = 223 * MiB;
constexpr size_t WS_CF = WS_MISC;
constexpr size_t WS_KCMP = WS_CF + 512 * 1024, WS_VCMP = WS_KCMP + 256 * 1024, WS_SELM = WS_VCMP + 256 * 1024;
constexpr size_t WS_MEMN = WS_MISC + 3 * MiB / 2;
constexpr size_t WS_MEMKV = WS_MEMN + 4 * MiB;
constexpr size_t WS_PSLC = WS_MEMKV + 2 * MiB;
constexpr size_t WS_OCMP = WS_PSLC + 4 * MiB;
constexpr size_t WS_CK = WS_OCMP, WS_CV = WS_CK + 4 * MiB, WS_PK = WS_CV + 4 * MiB, WS_PV = WS_PK + 2 * MiB;
constexpr size_t WS_END = WS_OCMP + 16 * MiB;
static_assert(W_END <= WS_H && WS_H + 32 * MiB == WS_OQ && WS_OQ + 48 * MiB == WS_KV && WS_KV + 96 * MiB == WS_MISC && WS_END <= 256 * MiB && WS_PV + 2 * MiB <= WS_END, "ws map");
constexpr int CW_BAR = 4096, CW_SB = 8192, CW_CVB = 8192 + 32 * 64;

typedef unsigned short bf16;
typedef float f32x4 __attribute__((ext_vector_type(4)));
typedef unsigned u32x4 __attribute__((ext_vector_type(4)));
typedef unsigned u32x2 __attribute__((ext_vector_type(2)));

__device__ __forceinline__ float bf2f(unsigned short b) { return __uint_as_float((unsigned)b << 16); }
__device__ __forceinline__ unsigned pk2(float lo, float hi) { return pg8::cvt_pk_bf16(lo, hi); }
__device__ __forceinline__ unsigned short f2bf(float f) { return (unsigned short)(pk2(f, 0.f) & 0xffffu); }
__device__ __forceinline__ float wave_sum(float v) {
#pragma unroll
    for (int o = 1; o < 64; o <<= 1) v += __shfl_xor(v, o);
    return v;
}
__device__ __forceinline__ float sigm(float x) { return __builtin_amdgcn_rcpf(1.0f + __expf(-x)); }
__device__ __forceinline__ float logsig(float x) { return fminf(x, 0.f) - log1pf(__expf(-fabsf(x))); }

struct Args { const void* in[31]; float* out; unsigned char* ws; int ph_lo, ph_hi; };

struct MapOff { int off; float s; __device__ __forceinline__ int row(int n) const { return n + off; } __device__ __forceinline__ float sc(int) const { return s; } };
struct MapA {
    __device__ __forceinline__ int row(int n) const { return n < 2816 ? n : (n < 2840 ? n + 1536 : (n < 4376 ? n - 24 : n)); }
    __device__ __forceinline__ float sc(int n) const { return (n < 512 || (n >= 1536 && n < 2048) || (n >= 2840 && n < 3352)) ? 0.125f : 1.0f; }
};
struct MapGU { int half; __device__ __forceinline__ int row(int n) const { return (n >> 7) * 256 + half * 128 + (n & 127); } __device__ __forceinline__ float sc(int) const { return 1.0f; } };

template <class Map>
__device__ __forceinline__ void conv_item(const float* W, int N, int ldw, bf16* WT, int ldt, int dk0, const Map map, LAS float* scr, int it, int lane) {
    const int nblk = N / 32, kb = it / nblk, nb = it % nblk, k0 = 64 * kb, n0 = 32 * nb;
    const float* src = W + (size_t)(k0 + (lane >> 3)) * ldw + n0 + 4 * (lane & 7);
    f32x4 v[8];
#pragma unroll
    for (int i = 0; i < 8; ++i) v[i] = *(const f32x4*)(src + (size_t)(8 * i) * ldw);
#pragma unroll
    for (int i = 0; i < 8; ++i) { LAS float* d = scr + (8 * i + (lane >> 3)) * 33 + 4 * (lane & 7); d[0] = v[i].x; d[1] = v[i].y; d[2] = v[i].z; d[3] = v[i].w; }
    asm volatile("s_waitcnt lgkmcnt(0)" ::: "memory");
    const int c = lane & 7;
#pragma unroll
    for (int j = 0; j < 4; ++j) { const int n = (lane >> 3) + 8 * j; const LAS float* s = scr + (8 * c) * 33 + n; const float sc = map.sc(n0 + n);
        u32x4 o; o.x = pk2(s[0 * 33] * sc, s[1 * 33] * sc); o.y = pk2(s[2 * 33] * sc, s[3 * 33] * sc); o.z = pk2(s[4 * 33] * sc, s[5 * 33] * sc); o.w = pk2(s[6 * 33] * sc, s[7 * 33] * sc);
        *(u32x4*)(WT + (size_t)map.row(n0 + n) * ldt + dk0 + k0 + 8 * c) = o; }
    asm volatile("s_waitcnt lgkmcnt(0)" ::: "memory");
}

__device__ __forceinline__ void norm_row_to_bf16(const float* xrow, const float* g, bf16* hrow, int lane) {
    const f32x4* xr = (const f32x4*)xrow + lane; const f32x4* gr = (const f32x4*)g + lane;
    f32x4 v[4]; float s = 0.f;
#pragma unroll
    for (int j = 0; j < 4; ++j) { v[j] = xr[64 * j]; s += (v[j].x * v[j].x + v[j].y * v[j].y) + (v[j].z * v[j].z + v[j].w * v[j].w); }
    const float rstd = __builtin_amdgcn_rsqf(wave_sum(s) * (1.f / DM) + RMS_EPS);
    u32x2* o8 = (u32x2*)hrow + lane;
#pragma unroll
    for (int j = 0; j < 4; ++j) { const f32x4 gg = gr[64 * j]; u32x2 w; w.x = pk2(v[j].x * rstd * gg.x, v[j].y * rstd * gg.y); w.y = pk2(v[j].z * rstd * gg.z, v[j].w * rstd * gg.w); o8[64 * j] = w; }
}
__device__ __forceinline__ void post_norm_row(const bf16* yrow, const float* xs, float* xd, const float* gpost, const float* gpre, bf16* hrow, bool write_h, bool dry, int lane) {
    const u32x2* yr = (const u32x2*)yrow + lane; const f32x4* xr = (const f32x4*)xs + lane;
    f32x4 y[4], x[4]; float s = 0.f;
#pragma unroll
    for (int j = 0; j < 4; ++j) { const u32x2 w = yr[64 * j]; y[j].x = __uint_as_float(w.x << 16); y[j].y = __uint_as_float(w.x & 0xffff0000u); y[j].z = __uint_as_float(w.y << 16); y[j].w = __uint_as_float(w.y & 0xffff0000u);
        x[j] = xr[64 * j]; s += (y[j].x * y[j].x + y[j].y * y[j].y) + (y[j].z * y[j].z + y[j].w * y[j].w); }
    const float rstd = __builtin_amdgcn_rsqf(wave_sum(s) * (1.f / DM) + RMS_EPS);
    float s2 = 0.f;
#pragma unroll
    for (int j = 0; j < 4; ++j) { const f32x4 gg = ((const f32x4*)gpost + lane)[64 * j];
        x[j].x += y[j].x * rstd * gg.x; x[j].y += y[j].y * rstd * gg.y; x[j].z += y[j].z * rstd * gg.z; x[j].w += y[j].w * rstd * gg.w;
        if (!dry) ((f32x4*)xd + lane)[64 * j] = x[j]; s2 += (x[j].x * x[j].x + x[j].y * x[j].y) + (x[j].z * x[j].z + x[j].w * x[j].w); }
    if (write_h && !dry) {
        const float r2 = __builtin_amdgcn_rsqf(wave_sum(s2) * (1.f / DM) + RMS_EPS);
        u32x2* o8 = (u32x2*)hrow + lane;
#pragma unroll
        for (int j = 0; j < 4; ++j) { const f32x4 gg = ((const f32x4*)gpre + lane)[64 * j]; u32x2 w; w.x = pk2(x[j].x * r2 * gg.x, x[j].y * r2 * gg.y); w.y = pk2(x[j].z * r2 * gg.z, x[j].w * r2 * gg.w); o8[64 * j] = w; }
    }
}

__device__ __forceinline__ void post_norm_rows2(const bf16* y0, const bf16* y1, const float* xs0, const float* xs1, float* xd0, float* xd1, const float* gpost, const float* gpre, bf16* h0, bf16* h1, bool write_h, bool dry, int lane) {
    f32x4 y[2][4], x[2][4], gp[4]; u32x2 w[2][4];
#pragma unroll
    for (int j = 0; j < 4; ++j) { w[0][j] = __builtin_nontemporal_load((const u32x2*)y0 + lane + 64 * j); w[1][j] = __builtin_nontemporal_load((const u32x2*)y1 + lane + 64 * j); }
#pragma unroll
    for (int j = 0; j < 4; ++j) { x[0][j] = __builtin_nontemporal_load((const f32x4*)xs0 + lane + 64 * j); x[1][j] = __builtin_nontemporal_load((const f32x4*)xs1 + lane + 64 * j); gp[j] = ((const f32x4*)gpost + lane)[64 * j]; }
    float s[2] = {0.f, 0.f};
#pragma unroll
    for (int q = 0; q < 2; ++q)
#pragma unroll
        for (int j = 0; j < 4; ++j) { y[q][j].x = __uint_as_float(w[q][j].x << 16); y[q][j].y = __uint_as_float(w[q][j].x & 0xffff0000u); y[q][j].z = __uint_as_float(w[q][j].y << 16); y[q][j].w = __uint_as_float(w[q][j].y & 0xffff0000u);
            s[q] += (y[q][j].x * y[q][j].x + y[q][j].y * y[q][j].y) + (y[q][j].z * y[q][j].z + y[q][j].w * y[q][j].w); }
#pragma unroll
    for (int o = 1; o < 64; o <<= 1) { s[0] += __shfl_xor(s[0], o); s[1] += __shfl_xor(s[1], o); }
    float s2[2] = {0.f, 0.f};
#pragma unroll
    for (int q = 0; q < 2; ++q) { const float rstd = __builtin_amdgcn_rsqf(s[q] * (1.f / DM) + RMS_EPS); float* xd = q ? xd1 : xd0;
#pragma unroll
        for (int j = 0; j < 4; ++j) {
            x[q][j].x += y[q][j].x * rstd * gp[j].x; x[q][j].y += y[q][j].y * rstd * gp[j].y; x[q][j].z += y[q][j].z * rstd * gp[j].z; x[q][j].w += y[q][j].w * rstd * gp[j].w;
            if (!dry) __builtin_nontemporal_store(x[q][j], (f32x4*)xd + lane + 64 * j); s2[q] += (x[q][j].x * x[q][j].x + x[q][j].y * x[q][j].y) + (x[q][j].z * x[q][j].z + x[q][j].w * x[q][j].w); } }
    if (write_h && !dry) {
#pragma unroll
        for (int o = 1; o < 64; o <<= 1) { s2[0] += __shfl_xor(s2[0], o); s2[1] += __shfl_xor(s2[1], o); }
#pragma unroll
        for (int j = 0; j < 4; ++j) gp[j] = ((const f32x4*)gpre + lane)[64 * j];
#pragma unroll
        for (int q = 0; q < 2; ++q) { const float r2 = __builtin_amdgcn_rsqf(s2[q] * (1.f / DM) + RMS_EPS); const __amdgpu_buffer_rsrc_t hr_ = pg8::wt_rsrc(q ? h1 : h0);
#pragma unroll
            for (int j = 0; j < 4; ++j) { u32x2 ww; ww.x = pk2(x[q][j].x * r2 * gp[j].x, x[q][j].y * r2 * gp[j].y); ww.y = pk2(x[q][j].z * r2 * gp[j].z, x[q][j].w * r2 * gp[j].w); __builtin_amdgcn_raw_buffer_store_b64(ww, hr_, (lane + 64 * j) * 8, 0, 16); } }
    }
}

__device__ __forceinline__ void rope_cs(int pos, int i, float& c, float& s) {
    float hi, lo;
    switch (i) { case 0: hi = 0.1591796875f; lo = -2.474440771038644e-05f; break; case 1: hi = 0.0308685302734375f; lo = -4.76686864203657e-06f; break;
                 case 2: hi = 0.005985260009765625f; lo = -7.429704851347196e-08f; break; case 3: hi = 0.0011606216430664062f; lo = 4.1998173827551e-08f; break;
                 case 4: hi = 0.000225067138671875f; lo = 1.1940367805607366e-08f; break; case 5: hi = 4.366040229797363e-05f; lo = -1.2449505426559426e-08f; break;
                 case 6: hi = 8.463859558105469e-06f; lo = 4.712501500137023e-10f; break; default: hi = 1.6409903764724731e-06f; lo = 4.3588632703261965e-10f; break; }
    const float fp = (float)pos, p = fp * hi, fr = (p - rintf(p)) + fp * lo;
    c = __builtin_amdgcn_cosf(fr); s = __builtin_amdgcn_sinf(fr);
}

typedef __attribute__((address_space(4))) const unsigned char* kptr_t;
struct KA {
    kptr_t kp;
    __device__ __forceinline__ void refresh() { kp = (kptr_t)__builtin_amdgcn_kernarg_segment_ptr(); asm volatile("" : "+s"(kp)); }
    __device__ __forceinline__ const void* in(int i) const { return (const void*)(const GAS void*)(*(const __attribute__((address_space(4))) unsigned long long*)(kp + 8 * i)); }
    __device__ __forceinline__ float* out() const { return (float*)(GAS float*)(*(const __attribute__((address_space(4))) unsigned long long*)(kp + 8 * 31)); }
    __device__ __forceinline__ unsigned char* ws() const { return (unsigned char*)(GAS unsigned char*)(*(const __attribute__((address_space(4))) unsigned long long*)(kp + 8 * 32)); }
    __device__ __forceinline__ int ph_lo() const { return *(const __attribute__((address_space(4))) int*)(kp + 8 * 33); }
    __device__ __forceinline__ int ph_hi() const { return *(const __attribute__((address_space(4))) int*)(kp + 8 * 33 + 4); }
};
struct Frame {
    LAS unsigned char* lds;
    int tid, lane, wave, G, bid;
    int gw, ngw;
    int gt, ngt;
};

struct ConvDesc { const float* src; int ldw; bf16* dst; int ldt; int kd; int n0; int kind; int par; float sc; };
#define CVD(Wp, K_, N_, LDW_, DST_, LDT_, DK0_, KIND_, PAR_, SC_) { constexpr int n_ = ((N_) / 32) * ((K_) / 64); if (it < n_) { const int nblk = (N_) / 32, kb = it / nblk, nb = it % nblk; \
    d.src = (Wp) + (size_t)(64 * kb + (lane >> 3)) * (LDW_) + 32 * nb + 4 * (lane & 7); d.ldw = (LDW_); d.dst = (DST_); d.ldt = (LDT_); d.kd = (DK0_) + 64 * kb; d.n0 = 32 * nb; d.kind = (KIND_); d.par = (PAR_); d.sc = (SC_); return; } it -= n_; }
constexpr int N_CONV = 2192 + 1536 + 4 * 128 + 3 * 256 + 512 + 128 + 2 * 128 + 128 + 2 * 1408 + 1408;
__device__ __forceinline__ void conv_decode(ConvDesc& d, const KA& a, unsigned char* ws, int l, int it, int lane) {
    CVD((const float*)a.in(10) + (size_t)l * DM * DIN, DM, 4384, DIN, (bf16*)(ws + W_A), DM, 0, 1, 0, 1.0f)
    CVD((const float*)a.in(10) + (size_t)l * DM * DIN + 4384, DM, 3072, DIN, (bf16*)(ws + W_M), DM, 0, 0, 0, 1.0f)
    CVD((const float*)a.in(13) + (size_t)l * 2048 * 256, 1024, 256, 256, (bf16*)(ws + W_C1K), 1024, 0, 0, 0, 1.0f)
    CVD((const float*)a.in(13) + (size_t)l * 2048 * 256 + 1024 * 256, 1024, 256, 256, (bf16*)(ws + W_C1K), 1024, 0, 0, 256, 1.0f)
    CVD((const float*)a.in(17) + (size_t)l * 2048 * 256, 1024, 256, 256, (bf16*)(ws + W_C1V), 1024, 0, 0, 0, 1.0f)
    CVD((const float*)a.in(17) + (size_t)l * 2048 * 256 + 1024 * 256, 1024, 256, 256, (bf16*)(ws + W_C1V), 1024, 0, 0, 256, 1.0f)
    CVD((const float*)a.in(20) + (size_t)l * 512 * DM, 512, DM, DM, (bf16*)(ws + W_UP), 512, 0, 0, 0, 1.0f)
    CVD((const float*)a.in(21) + (size_t)l * 512 * DM, 512, DM, DM, (bf16*)(ws + W_UP), 512, 0, 0, 1024, 1.0f)
    CVD((const float*)a.in(22) + (size_t)l * 512 * DM, 512, DM, DM, (bf16*)(ws + W_UP), 512, 0, 0, 2048, 1.0f)
    CVD((const float*)a.in(23) + (size_t)l * DM * DM, DM, DM, DM, (bf16*)(ws + W_OUT3), DM, 0, 0, 0, 1.0f)
    CVD((const float*)a.in(24) + (size_t)l * DM * 256, DM, 256, 256, (bf16*)(ws + W_MQ), DM, 0, 0, 0, 0.125f)
    CVD((const float*)a.in(25) + (size_t)l * DM * 256, DM, 256, 256, (bf16*)(ws + W_MKV), DM, 0, 0, 0, 1.0f)
    CVD((const float*)a.in(26) + (size_t)l * DM * 256, DM, 256, 256, (bf16*)(ws + W_MKV), DM, 0, 0, 256, 1.0f)
    CVD((const float*)a.in(27) + (size_t)l * 256 * DM, 256, DM, DM, (bf16*)(ws + W_MO), 256, 0, 0, 0, 1.0f)
    CVD((const float*)a.in(28) + (size_t)l * DM * DFF, DM, DFF, DFF, (bf16*)(ws + W_GU), DM, 0, 2, 0, 1.0f)
    CVD((const float*)a.in(29) + (size_t)l * DM * DFF, DM, DFF, DFF, (bf16*)(ws + W_GU), DM, 0, 2, 1, 1.0f)
    CVD((const float*)a.in(30) + (size_t)l * DFF * DM, DFF, DM, DM, (bf16*)(ws + W_DN), DFF, 0, 0, 0, 1.0f)
}
#undef CVD
__device__ __forceinline__ void conv_load(const ConvDesc& d, f32x4 (&v)[8]) {
#pragma unroll
    for (int i = 0; i < 8; ++i) v[i] = __builtin_nontemporal_load((const f32x4*)(d.src + (size_t)(8 * i) * d.ldw));
}
__device__ __forceinline__ void conv_finish(const ConvDesc& d, const f32x4 (&v)[8], LAS float* scr, int lane) {
#pragma unroll
    for (int i = 0; i < 8; ++i) { LAS float* p = scr + (8 * i + (lane >> 3)) * 33 + 4 * (lane & 7); p[0] = v[i].x; p[1] = v[i].y; p[2] = v[i].z; p[3] = v[i].w; }
    asm volatile("s_waitcnt lgkmcnt(0)" ::: "memory");
    const int c = lane & 7;
#pragma unroll
    for (int j = 0; j < 4; ++j) { const int n = (lane >> 3) + 8 * j, gn = d.n0 + n; const LAS float* s = scr + (8 * c) * 33 + n;
        const int row = d.kind == 0 ? gn + d.par : (d.kind == 1 ? MapA{}.row(gn) : MapGU{d.par}.row(gn));
        const float sc = d.kind == 1 ? MapA{}.sc(gn) : d.sc;
        u32x4 o; o.x = pk2(s[0 * 33] * sc, s[1 * 33] * sc); o.y = pk2(s[2 * 33] * sc, s[3 * 33] * sc); o.z = pk2(s[4 * 33] * sc, s[5 * 33] * sc); o.w = pk2(s[6 * 33] * sc, s[7 * 33] * sc);
        *(u32x4*)(d.dst + (size_t)row * d.ldt + d.kd + 8 * c) = o; }
    asm volatile("s_waitcnt lgkmcnt(0)" ::: "memory");
}
__device__ __forceinline__ void norm_rows4_to_bf16(const float* x0, const float* g, bf16* h0, int lane) {
    f32x4 v[4][4], gg[4]; float s[4] = {0.f, 0.f, 0.f, 0.f};
#pragma unroll
    for (int q = 0; q < 4; ++q)
#pragma unroll
        for (int j = 0; j < 4; ++j) v[q][j] = __builtin_nontemporal_load((const f32x4*)(x0 + (size_t)q * DM) + lane + 64 * j);
#pragma unroll
    for (int j = 0; j < 4; ++j) gg[j] = ((const f32x4*)g + lane)[64 * j];
#pragma unroll
    for (int q = 0; q < 4; ++q)
#pragma unroll
        for (int j = 0; j < 4; ++j) s[q] += (v[q][j].x * v[q][j].x + v[q][j].y * v[q][j].y) + (v[q][j].z * v[q][j].z + v[q][j].w * v[q][j].w);
#pragma unroll
    for (int o = 1; o < 64; o <<= 1) { s[0] += __shfl_xor(s[0], o); s[1] += __shfl_xor(s[1], o); s[2] += __shfl_xor(s[2], o); s[3] += __shfl_xor(s[3], o); }
#pragma unroll
    for (int q = 0; q < 4; ++q) { const float rstd = __builtin_amdgcn_rsqf(s[q] * (1.f / DM) + RMS_EPS); u32x2* o8 = (u32x2*)(h0 + (size_t)q * DM) + lane;
#pragma unroll
        for (int j = 0; j < 4; ++j) { u32x2 w; w.x = pk2(v[q][j].x * rstd * gg[j].x, v[q][j].y * rstd * gg[j].y); w.y = pk2(v[q][j].z * rstd * gg[j].z, v[q][j].w * rstd * gg[j].w); o8[64 * j] = w; } }
}
struct ConvB { const float* src; int ldw; bf16* dst; int ldt; int kd; int n0; int kind; int par; float sc; };
#define CVB(Wp, K_, N_, LDW_, DST_, LDT_, DK0_, KIND_, PAR_, SC_) { constexpr int nb_ = (N_) / 256, n_ = nb_ * ((K_) / 64); if (it < n_) { const int kb = it / nb_, nb = it % nb_; \
    d.src = (Wp) + (size_t)(64 * kb) * (LDW_) + 256 * nb; d.ldw = (LDW_); d.dst = (DST_); d.ldt = (LDT_); d.kd = (DK0_) + 64 * kb; d.n0 = 256 * nb; d.kind = (KIND_); d.par = (PAR_); d.sc = (SC_); return; } it -= n_; }
constexpr int N_CONVB = 16 * 17 + 16 * 12 + 4 * 16 + 3 * 32 + 64 + 16 + 2 * 16 + 16 + 2 * 176 + 176;
constexpr int N_CONVA = N_CONVB - (2 * 176 + 176);
__device__ __forceinline__ void convb_decode(ConvB& d, const KA& a, unsigned char* ws, int l, int it) {
    CVB((const float*)a.in(10) + (size_t)l * DM * DIN, DM, 4352, DIN, (bf16*)(ws + W_A), DM, 0, 1, 0, 1.0f)
    CVB((const float*)a.in(10) + (size_t)l * DM * DIN + 4384, DM, 3072, DIN, (bf16*)(ws + W_M), DM, 0, 0, 0, 1.0f)
    CVB((const float*)a.in(13) + (size_t)l * 2048 * 256, 1024, 256, 256, (bf16*)(ws + W_C1K), 1024, 0, 0, 0, 1.0f)
    CVB((const float*)a.in(13) + (size_t)l * 2048 * 256 + 1024 * 256, 1024, 256, 256, (bf16*)(ws + W_C1K), 1024, 0, 0, 256, 1.0f)
    CVB((const float*)a.in(17) + (size_t)l * 2048 * 256, 1024, 256, 256, (bf16*)(ws + W_C1V), 1024, 0, 0, 0, 1.0f)
    CVB((const float*)a.in(17) + (size_t)l * 2048 * 256 + 1024 * 256, 1024, 256, 256, (bf16*)(ws + W_C1V), 1024, 0, 0, 256, 1.0f)
    CVB((const float*)a.in(20) + (size_t)l * 512 * DM, 512, DM, DM, (bf16*)(ws + W_UP), 512, 0, 0, 0, 1.0f)
    CVB((const float*)a.in(21) + (size_t)l * 512 * DM, 512, DM, DM, (bf16*)(ws + W_UP), 512, 0, 0, 1024, 1.0f)
    CVB((const float*)a.in(22) + (size_t)l * 512 * DM, 512, DM, DM, (bf16*)(ws + W_UP), 512, 0, 0, 2048, 1.0f)
    CVB((const float*)a.in(23) + (size_t)l * DM * DM, DM, DM, DM, (bf16*)(ws + W_OUT3), DM, 0, 0, 0, 1.0f)
    CVB((const float*)a.in(24) + (size_t)l * DM * 256, DM, 256, 256, (bf16*)(ws + W_MQ), DM, 0, 0, 0, 0.125f)
    CVB((const float*)a.in(25) + (size_t)l * DM * 256, DM, 256, 256, (bf16*)(ws + W_MKV), DM, 0, 0, 0, 1.0f)
    CVB((const float*)a.in(26) + (size_t)l * DM * 256, DM, 256, 256, (bf16*)(ws + W_MKV), DM, 0, 0, 256, 1.0f)
    CVB((const float*)a.in(27) + (size_t)l * 256 * DM, 256, DM, DM, (bf16*)(ws + W_MO), 256, 0, 0, 0, 1.0f)
    CVB((const float*)a.in(28) + (size_t)l * DM * DFF, DM, DFF, DFF, (bf16*)(ws + W_GU), DM, 0, 2, 0, 1.0f)
    CVB((const float*)a.in(29) + (size_t)l * DM * DFF, DM, DFF, DFF, (bf16*)(ws + W_GU), DM, 0, 2, 1, 1.0f)
    CVB((const float*)a.in(30) + (size_t)l * DFF * DM, DFF, DM, DM, (bf16*)(ws + W_DN), DFF, 0, 0, 0, 1.0f)
}
#undef CVB
__device__ __forceinline__ void convb_load(const ConvB& d, f32x4 (&v)[8], int wave, int lane) {
#pragma unroll
    for (int i = 0; i < 8; ++i) v[i] = __builtin_nontemporal_load((const f32x4*)(d.src + (size_t)(8 * wave + i) * d.ldw + 4 * lane));
}
__device__ __forceinline__ void convb_finish(const ConvB& d, const f32x4 (&v)[8], LAS float* scr, int tid, int wave, int lane) {
#pragma unroll
    for (int i = 0; i < 8; ++i) { LAS float* p = scr + (8 * wave + i) * 257 + 4 * lane; p[0] = v[i].x; p[1] = v[i].y; p[2] = v[i].z; p[3] = v[i].w; }
    __syncthreads();
#pragma unroll
    for (int j = 0; j < 4; ++j) { const int pc = tid + 512 * j, n = pc >> 3, c = pc & 7, gn = d.n0 + n; const LAS float* s = scr + (8 * c) * 257 + n;
        const int row = d.kind == 0 ? gn + d.par : (d.kind == 1 ? MapA{}.row(gn) : MapGU{d.par}.row(gn));
        const float sc = d.kind == 1 ? MapA{}.sc(gn) : d.sc;
        u32x4 o; o.x = pk2(s[0 * 257] * sc, s[1 * 257] * sc); o.y = pk2(s[2 * 257] * sc, s[3 * 257] * sc); o.z = pk2(s[4 * 257] * sc, s[5 * 257] * sc); o.w = pk2(s[6 * 257] * sc, s[7 * 257] * sc);
        *(u32x4*)(d.dst + (size_t)row * d.ldt + d.kd + 8 * c) = o; }
    __syncthreads();
}
__device__ __forceinline__ void phase_conv(const Frame& F, const KA& a, int l) {
    unsigned char* ws = a.ws();
    const int gw = F.gw, ngw = F.ngw, lane = F.lane;
    {
        LAS float* scr = (LAS float*)F.lds;
        ConvB da, db; f32x4 va[8], vb[8];
        int i0 = F.bid;
        if (i0 < N_CONVA) { convb_decode(da, a, ws, l, i0); convb_load(da, va, F.wave, lane); }
        for (; i0 < N_CONVA; i0 += 2 * F.G) {
            const int i1 = i0 + F.G, i2 = i1 + F.G; const bool h1 = i1 < N_CONVA, h2 = i2 < N_CONVA;
            if (h1) { convb_decode(db, a, ws, l, i1); convb_load(db, vb, F.wave, lane); }
            convb_finish(da, va, scr, F.tid, F.wave, lane);
            if (h2) { convb_decode(da, a, ws, l, i2); convb_load(da, va, F.wave, lane); }
            if (h1) convb_finish(db, vb, scr, F.tid, F.wave, lane);
        }
    }
    {
        LAS float* scr = (LAS float*)(F.lds + F.wave * 16384);
        for (int it = ngw - 1 - gw; it < 16; it += ngw) { ConvDesc d; f32x4 v[8];
            d.src = (const float*)a.in(10) + (size_t)l * DM * DIN + (size_t)(64 * it + (lane >> 3)) * DIN + 4352 + 4 * (lane & 7); d.ldw = DIN; d.dst = (bf16*)(ws + W_A); d.ldt = DM; d.kd = 64 * it; d.n0 = 4352; d.kind = 1; d.par = 0; d.sc = 1.0f;
            conv_load(d, v); conv_finish(d, v, scr, lane); }
    }
    __syncthreads();
    const int n_other = 14 + 64 + 512 + (l == 0 ? 4096 : 0);
    for (int it0 = ngw - 1 - gw; it0 < n_other; it0 += ngw) {
        int it = it0;
        if (it < 14) {
            u32x4* z = (u32x4*)(ws + W_A + (4384ull + 16 * it) * DM * 2) + lane; unsigned zz = 0u; asm volatile("" : "+v"(zz));
#pragma unroll 8
            for (int i = 0; i < 32; ++i) z[64 * i] = (u32x4){zz, zz, zz, zz};
            continue; }
        it -= 14;
        if (it < 64) {
            const int m = it >> 5, s = it & 31;
            const float* pe = (m ? (const float*)a.in(16) : (const float*)a.in(12)) + (size_t)l * 2048 + s * 64;
            const float* w1 = (m ? (const float*)a.in(17) : (const float*)a.in(13)) + (size_t)l * 2048 * 256 + (size_t)(s * 64) * 256;
            const unsigned pev = __float_as_uint(pe[lane]);
            f32x4 acc = (f32x4){0.f, 0.f, 0.f, 0.f}, acc2 = (f32x4){0.f, 0.f, 0.f, 0.f};
#pragma unroll 1
            for (int kb = 0; kb < 64; kb += 16) {
                f32x4 w[16];
#pragma unroll
                for (int i = 0; i < 16; ++i) w[i] = __builtin_nontemporal_load((const f32x4*)(w1 + (size_t)(kb + i) * 256) + lane);
#pragma unroll
                for (int i = 0; i < 16; i += 2) { const float p = __uint_as_float(__builtin_amdgcn_readlane(pev, kb + i)), p2 = __uint_as_float(__builtin_amdgcn_readlane(pev, kb + i + 1));
                    acc.x += p * w[i].x; acc.y += p * w[i].y; acc.z += p * w[i].z; acc.w += p * w[i].w; acc2.x += p2 * w[i + 1].x; acc2.y += p2 * w[i + 1].y; acc2.z += p2 * w[i + 1].z; acc2.w += p2 * w[i + 1].w; }
            }
            acc.x += acc2.x; acc.y += acc2.y; acc.z += acc2.z; acc.w += acc2.w;
            ((f32x4*)((float*)(ws + W_B1PART) + (size_t)(m * 32 + s) * 256))[lane] = acc;
            continue; }
        it -= 64;
        if (it < 512) { norm_rows4_to_bf16((const float*)a.in(1) + (size_t)(4 * it) * DM, (const float*)a.in(6) + (size_t)l * DM, (bf16*)(ws + WS_MEMN) + (size_t)(4 * it) * DM, lane); continue; }
        it -= 512;
        norm_rows4_to_bf16((const float*)a.in(0) + (size_t)(4 * it) * DM, (const float*)a.in(3), (bf16*)(ws + WS_H) + (size_t)(4 * it) * DM, lane);
    }
}

__device__ __forceinline__ void phase_conv_b(const Frame& F, const KA& a, int l) {
    unsigned char* ws = a.ws();
    LAS float* scr = (LAS float*)F.lds;
    LAS unsigned* qslot = (LAS unsigned*)(F.lds + 66048);
    unsigned* ctr = (unsigned*)(ws + WS_CTL) + CW_CVB + 64 * (unsigned)l;
    for (;;) {
        if (F.tid == 0) *qslot = __hip_atomic_fetch_add(ctr, 1u, __ATOMIC_RELAXED, __HIP_MEMORY_SCOPE_AGENT);
        __syncthreads();
        const unsigned k_ = *qslot;
        __syncthreads();
        if (k_ >= (unsigned)(N_CONVB - N_CONVA)) break;
        ConvB d; f32x4 v[8];
        convb_decode(d, a, ws, l, N_CONVA + (int)k_); convb_load(d, v, F.wave, F.lane);
        convb_finish(d, v, scr, F.tid, F.wave, F.lane);
    }
}

__device__ __forceinline__ void phase_post(const Frame& F, const KA& a, int l, bool dry) {
    unsigned char* ws = a.ws();
    bf16* nsakv = (bf16*)(ws + WS_KV + 64 * MiB);
    const bf16* small = (const bf16*)(ws + WS_KV + 88 * MiB);
    const int* pos = (const int*)a.in(2);
    for (int it = F.gt; it < M * 32; it += F.ngt) {
        const int tok = it >> 5, r = it & 31, which = r >> 4, g = (r >> 3) & 1, i = r & 7;
        bf16* p = nsakv + (size_t)tok * 768 + 256 + which * 256 + g * 64 + i;
        float c, s; rope_cs(pos[tok], i, c, s);
        const float x1 = bf2f(p[0]), x2 = bf2f(p[8]);
        if (!dry) { p[0] = f2bf(x1 * c - x2 * s); p[8] = f2bf(x2 * c + x1 * s); }
    }
    if (F.bid >= 64 && F.bid < 128) {
        const int it = F.bid - 64, b = it >> 3, h = it & 7; const float bias = ((const float*)a.in(11))[l * 8 + h];
        const bf16* fp = small + ((size_t)b * SEQ + 4 * F.tid) * 256 + 24 + h;
        float v0 = logsig(bf2f(fp[0]) + bias), v1 = logsig(bf2f(fp[256]) + bias), v2 = logsig(bf2f(fp[512]) + bias), v3 = logsig(bf2f(fp[768]) + bias);
        v1 += v0; v2 += v1; v3 += v2;
        float inc = v3;
#pragma unroll
        for (int o = 1; o < 64; o <<= 1) { const float t = __shfl_up(inc, o); if (F.lane >= o) inc += t; }
        LAS float* wtot = (LAS float*)F.lds;
        if (F.lane == 63) wtot[F.wave] = inc;
        __syncthreads();
        float base = inc - v3;
        for (int w = 0; w < F.wave; ++w) base += wtot[w];
        *(f32x4*)((float*)(ws + WS_CF) + ((size_t)b * 8 + h) * SEQ + 4 * F.tid) = (f32x4){base + v0, base + v1, base + v2, base + v3};
        __syncthreads();
    }
}

__device__ __forceinline__ void phase_cmp2(const Frame& F, const KA& a, int l) {
    unsigned char* ws = a.ws();
    LAS float* b1p = (LAS float*)F.lds;
    LAS float* hid = (LAS float*)(F.lds + 4096) + F.wave * 512;
    {
        const int m = F.tid >> 8, j = F.tid & 255;
        const float* part = (const float*)(ws + W_B1PART) + (size_t)m * 32 * 256 + j;
        float pv[32];
#pragma unroll
        for (int i = 0; i < 32; ++i) pv[i] = part[i * 256];
        float s = (m ? (const float*)a.in(18) : (const float*)a.in(14))[l * 256 + j];
#pragma unroll
        for (int i = 0; i < 32; ++i) s += pv[i];
        b1p[m * 256 + j] = s;
    }
    __syncthreads();
    for (int it = 2 * F.gw; it < 4096; it += 2 * F.ngw) {
        const int m = it >> 11, r = it & 2047, b = r >> 8, c = (r >> 1) & 127;
        bf16* out = (bf16*)(ws + (m ? WS_VCMP : WS_KCMP)) + (((size_t)b * 2 + 0) * 128 + c) * 64;
        if (c == 127) { out[F.lane] = 0; out[128 * 64 + F.lane] = 0; continue; }
#pragma unroll
        for (int g = 0; g < 2; ++g) {
            const bf16* P = (const bf16*)(ws + (m ? WS_PV : WS_PK)) + ((size_t)g * 1024 + b * 128 + c) * 512;
            const u32x2 p1 = *(const u32x2*)(P + 4 * F.lane), p2 = *(const u32x2*)(P + 512 + 256 + 4 * F.lane);
            float hv[4];
            hv[0] = __uint_as_float(p1.x << 16) + __uint_as_float(p2.x << 16); hv[1] = __uint_as_float(p1.x & 0xffff0000u) + __uint_as_float(p2.x & 0xffff0000u);
            hv[2] = __uint_as_float(p1.y << 16) + __uint_as_float(p2.y << 16); hv[3] = __uint_as_float(p1.y & 0xffff0000u) + __uint_as_float(p2.y & 0xffff0000u);
            f32x4 hx;
#pragma unroll
            for (int e = 0; e < 4; ++e) { const float x = hv[e] + b1p[m * 256 + 4 * F.lane + e]; hx[e] = x * sigm(x); }
            *(LAS f32x4*)(hid + g * 256 + 4 * F.lane) = hx;
        }
        asm volatile("s_waitcnt lgkmcnt(0)" ::: "memory");
        const float* w2 = (m ? (const float*)a.in(19) : (const float*)a.in(15)) + (size_t)l * 256 * 64 + F.lane;
        float acc0 = 0.f, acc1 = 0.f;
#pragma unroll 1
        for (int jb = 0; jb < 256; jb += 64) {
            float w[64];
#pragma unroll
            for (int i = 0; i < 64; ++i) w[i] = w2[(jb + i) * 64];
#pragma unroll
            for (int i = 0; i < 64; i += 4) { const f32x4 h0 = *(const LAS f32x4*)(hid + jb + i), h1 = *(const LAS f32x4*)(hid + 256 + jb + i);
                acc0 += h0.x * w[i] + h0.y * w[i + 1] + h0.z * w[i + 2] + h0.w * w[i + 3]; acc1 += h1.x * w[i] + h1.y * w[i + 1] + h1.z * w[i + 2] + h1.w * w[i + 3]; }
        }
        out[F.lane] = f2bf(acc0); out[128 * 64 + F.lane] = f2bf(acc1);
        asm volatile("s_waitcnt lgkmcnt(0)" ::: "memory");
    }
    __syncthreads();
}


namespace fa {
typedef short bf16x8 __attribute__((ext_vector_type(8)));
typedef short s16x4 __attribute__((ext_vector_type(4)));
typedef float f32x16 __attribute__((ext_vector_type(16)));
constexpr int KROW = 144;
constexpr int VROW = 192;
constexpr int TILE_B = 64 * KROW;
constexpr int VTILE_B = 64 * VROW;
constexpr int BIAS_OFF = TILE_B + VTILE_B;
constexpr int BUF_B = BIAS_OFF + 256;
constexpr float LOG2E = 1.4426950408889634f;
enum { MODE_NONE = 0, MODE_CAUSAL = 1, MODE_WINDOW = 2, MODE_SELECT = 3 };

__device__ __forceinline__ int crow(int r, int hi) { return (r & 3) + 8 * (r >> 2) + 4 * hi; }
__device__ __forceinline__ float xmax(float v) {
    auto rr = __builtin_amdgcn_permlane32_swap(__float_as_uint(v), __float_as_uint(v), false, false);
    return fmaxf(__uint_as_float(rr[0]), __uint_as_float(rr[1]));
}
typedef float f32x2 __attribute__((ext_vector_type(2)));
__device__ __forceinline__ float max3f(float a, float b, float c) { float r; asm("v_max3_f32 %0, %1, %2, %3" : "=v"(r) : "v"(a), "v"(b), "v"(c)); return r; }
__device__ __forceinline__ float xsum(float v) {
    auto rr = __builtin_amdgcn_permlane32_swap(__float_as_uint(v), __float_as_uint(v), false, false);
    return __uint_as_float(rr[0]) + __uint_as_float(rr[1]);
}
__device__ __forceinline__ s16x4 vtr(const LAS unsigned char* p) {
    typedef short v4i16_t __attribute__((ext_vector_type(4)));
    return __builtin_bit_cast(s16x4, __builtin_amdgcn_ds_read_tr16_b64_v4i16((LAS v4i16_t*)p));
}
__device__ __forceinline__ bf16x8 pack8(const f32x16& p, int b) {
    u32x4 w; w.x = pk2(p[b], p[b + 1]); w.y = pk2(p[b + 2], p[b + 3]); w.z = pk2(p[b + 4], p[b + 5]); w.w = pk2(p[b + 6], p[b + 7]);
    return __builtin_bit_cast(bf16x8, w);
}
__device__ __forceinline__ void load_q(bf16x8 (&qf)[4], const bf16* qrow, int hi) {
#pragma unroll
    for (int d0 = 0; d0 < 4; ++d0) qf[d0] = __builtin_bit_cast(bf16x8, *(const u32x4*)(qrow + 16 * d0 + 8 * hi));
}
__device__ __forceinline__ void rope_q(bf16x8& q0, int pos, int hi) {
    const u32x4 own = __builtin_bit_cast(u32x4, q0); u32x4 oth;
    oth.x = __shfl_xor(own.x, 32); oth.y = __shfl_xor(own.y, 32); oth.z = __shfl_xor(own.z, 32); oth.w = __shfl_xor(own.w, 32);
    float a[8], b[8];
    a[0] = __uint_as_float(own.x << 16); a[1] = __uint_as_float(own.x & 0xffff0000u); a[2] = __uint_as_float(own.y << 16); a[3] = __uint_as_float(own.y & 0xffff0000u);
    a[4] = __uint_as_float(own.z << 16); a[5] = __uint_as_float(own.z & 0xffff0000u); a[6] = __uint_as_float(own.w << 16); a[7] = __uint_as_float(own.w & 0xffff0000u);
    b[0] = __uint_as_float(oth.x << 16); b[1] = __uint_as_float(oth.x & 0xffff0000u); b[2] = __uint_as_float(oth.y << 16); b[3] = __uint_as_float(oth.y & 0xffff0000u);
    b[4] = __uint_as_float(oth.z << 16); b[5] = __uint_as_float(oth.z & 0xffff0000u); b[6] = __uint_as_float(oth.w << 16); b[7] = __uint_as_float(oth.w & 0xffff0000u);
    const float sg = hi ? 1.0f : -1.0f;
#pragma unroll
    for (int i = 0; i < 8; ++i) { float c, s; rope_cs(pos, i, c, s); a[i] = a[i] * c + sg * b[i] * s; }
    u32x4 w; w.x = pk2(a[0], a[1]); w.y = pk2(a[2], a[3]); w.z = pk2(a[4], a[5]); w.w = pk2(a[6], a[7]);
    q0 = __builtin_bit_cast(bf16x8, w);
}

struct KV { const bf16* K; const bf16* V; int ldk, ldv; const float* cb; };

struct Stage { u32x4 k, v; float b; };
template <bool BIAS> __device__ __forceinline__ void stage_load(Stage& s, const KV& P, int t, int tid) {
    const int row = 64 * t + (tid >> 3), ch = tid & 7;
    s.k = *(const u32x4*)(P.K + (size_t)row * P.ldk + ch * 8); s.v = *(const u32x4*)(P.V + (size_t)row * P.ldv + ch * 8);
    if (BIAS) { if (tid < 64) s.b = P.cb[64 * t + tid]; }
}
template <bool BIAS> __device__ __forceinline__ void stage_store(const Stage& s, LAS unsigned char* buf, int tid) {
    const int off = (tid >> 3) * KROW + (tid & 7) * 16, offv = (tid >> 3) * VROW + (tid & 7) * 16;
    *(LAS u32x4*)(buf + off) = s.k; *(LAS u32x4*)(buf + TILE_B + offv) = s.v;
    if (BIAS) { if (tid < 64) *(LAS float*)(buf + BIAS_OFF + tid * 4) = -s.b; }
}

template <int MODE> __device__ __forceinline__ bool tile_work(int t, int tq0, unsigned sel) {
    bool w = true;
    if (MODE == MODE_CAUSAL || MODE == MODE_WINDOW || MODE == MODE_SELECT) w = (64 * t <= tq0 + 31);
    if (MODE == MODE_WINDOW) w = w && (64 * t + 63 >= tq0 - 511);
    if (MODE == MODE_SELECT) w = w && (__ballot((sel >> t) & 1u) != 0ull);
    return w;
}
template <int MODE> __device__ __forceinline__ bool tile_full(int t, int tq0, unsigned sel) {
    bool f = true;
    if (MODE == MODE_CAUSAL || MODE == MODE_WINDOW || MODE == MODE_SELECT) f = (64 * t + 63 <= tq0);
    if (MODE == MODE_WINDOW) f = f && (tq0 + 31 - 64 * t < 512);
    if (MODE == MODE_SELECT) f = f && (__ballot((sel >> t) & 1u) == ~0ull);
    return f;
}

template <int MODE, bool BIAS, int XP = 0>
__device__ __forceinline__ void flash_tile(const LAS unsigned char* buf, int t, const bf16x8 (&qf)[4], int tq, int tq0, unsigned sel, int koff, int voff, int hi, f32x16 (&o)[2], float& m, float& l) {
    if (tile_work<MODE>(t, tq0, sel)) {
        bf16x8 kf[8];
#pragma unroll
        for (int d0 = 0; d0 < 4; ++d0) { kf[2 * d0] = *(const LAS bf16x8*)(buf + koff + d0 * 32); kf[2 * d0 + 1] = *(const LAS bf16x8*)(buf + koff + 32 * KROW + d0 * 32); }
        f32x16 s0, s1;
        if (BIAS) {
#pragma unroll
            for (int u = 0; u < 4; ++u) { const f32x4 b0 = *(const LAS f32x4*)(buf + BIAS_OFF + (8 * u + 4 * hi) * 4), b1 = *(const LAS f32x4*)(buf + BIAS_OFF + (32 + 8 * u + 4 * hi) * 4);
                s0[4 * u] = b0.x; s0[4 * u + 1] = b0.y; s0[4 * u + 2] = b0.z; s0[4 * u + 3] = b0.w; s1[4 * u] = b1.x; s1[4 * u + 1] = b1.y; s1[4 * u + 2] = b1.z; s1[4 * u + 3] = b1.w; }
        } else { s0 = f32x16{}; s1 = f32x16{}; }
        asm volatile("s_waitcnt lgkmcnt(0)" ::: "memory");
#pragma unroll
        for (int d0 = 0; d0 < 4; ++d0) { if (XP == 2) { asm volatile("" :: "v"(kf[2 * d0]), "v"(kf[2 * d0 + 1])); } else { s0 = __builtin_amdgcn_mfma_f32_32x32x16_bf16(kf[2 * d0], qf[d0], s0, 0, 0, 0); s1 = __builtin_amdgcn_mfma_f32_32x32x16_bf16(kf[2 * d0 + 1], qf[d0], s1, 0, 0, 0); } }
        s16x4 vlo[8], vhh[8];
#pragma unroll
        for (int j = 0; j < 2; ++j)
#pragma unroll
            for (int s = 0; s < 2; ++s)
#pragma unroll
                for (int d0 = 0; d0 < 2; ++d0) { const LAS unsigned char* vp = buf + voff + (32 * j + 16 * s) * VROW + d0 * 64; vlo[4 * j + 2 * s + d0] = vtr(vp); vhh[4 * j + 2 * s + d0] = vtr(vp + 8 * VROW); }
        asm volatile("" ::: "memory");
        asm volatile("s_nop 15\n\ts_nop 7" : "+v"(s0), "+v"(s1));
        if (MODE != MODE_NONE) {
            if (!tile_full<MODE>(t, tq0, sel)) {
                const int d = tq - (64 * t + 4 * hi);
                const bool selt = (MODE == MODE_SELECT) ? (((sel >> t) & 1u) != 0u) : true;
#pragma unroll
                for (int r = 0; r < 16; ++r) {
                    const int ca = (r & 3) + 8 * (r >> 2), cb = ca + 32;
                    bool va = selt && (ca <= d), vb = selt && (cb <= d);
                    if (MODE == MODE_WINDOW) { va = va && (ca > d - 512); vb = vb && (cb > d - 512); }
                    s0[r] = va ? s0[r] : -INFINITY; s1[r] = vb ? s1[r] : -INFINITY;
                }
            }
        }
        float mx0 = max3f(s0[0], s1[0], s0[1]), mx1 = max3f(s1[1], s0[2], s1[2]);
#pragma unroll
        for (int r = 3; r < 15; r += 2) { mx0 = max3f(mx0, s0[r], s1[r]); mx1 = max3f(mx1, s0[r + 1], s1[r + 1]); }
        const float mx = xmax(max3f(mx0, mx1, max3f(s0[15], s1[15], mx0)));
        const float mn = fmaxf(m, mx * LOG2E), ms = (mn == -INFINITY) ? 0.f : mn;
        const float alpha = __builtin_amdgcn_exp2f(m - ms);
        const bool resc = (mn != m);
        m = mn;
        f32x2 ps = (f32x2){0.f, 0.f};
#pragma unroll
        for (int r = 0; r < 16; r += 2) {
            const f32x2 ta = (f32x2){s0[r], s0[r + 1]} * LOG2E - ms, tb = (f32x2){s1[r], s1[r + 1]} * LOG2E - ms;
            if (XP == 1) { s0[r] = ta.x; s0[r + 1] = ta.y; s1[r] = tb.x; s1[r + 1] = tb.y; } else { s0[r] = __builtin_amdgcn_exp2f(ta.x); s0[r + 1] = __builtin_amdgcn_exp2f(ta.y); s1[r] = __builtin_amdgcn_exp2f(tb.x); s1[r + 1] = __builtin_amdgcn_exp2f(tb.y); }
            ps += (f32x2){s0[r], s0[r + 1]}; ps += (f32x2){s1[r], s1[r + 1]};
        }
        l = l * alpha + (ps.x + ps.y);
        if (__any(resc)) {
#pragma unroll
            for (int r = 0; r < 16; ++r) { o[0][r] *= alpha; o[1][r] *= alpha; }
        }
#pragma unroll
        for (int j = 0; j < 2; ++j)
#pragma unroll
            for (int s = 0; s < 2; ++s) {
                const bf16x8 pb = pack8(j ? s1 : s0, 8 * s);
#pragma unroll
                for (int d0 = 0; d0 < 2; ++d0) { const s16x4 lo = vlo[4 * j + 2 * s + d0], hh = vhh[4 * j + 2 * s + d0];
                    const bf16x8 vf = (bf16x8){lo[0], lo[1], lo[2], lo[3], hh[0], hh[1], hh[2], hh[3]};
                    if (XP == 2) { asm volatile("" :: "v"(vf), "v"(pb)); } else o[d0] = __builtin_amdgcn_mfma_f32_32x32x16_bf16(vf, pb, o[d0], 0, 0, 0); }
            }
    }
}
template <int MODE, bool BIAS, int XP = 0>
__device__ __forceinline__ void flash_core_v4(LAS unsigned char* lds, const KV& P, int t_lo, int t_hi, const bf16x8 (&qf)[4], int tq, int tq0, unsigned sel, f32x16 (&o)[2], float& l_out) {
    int tid_ = threadIdx.x; asm volatile("" : "+v"(tid_));
    const int tid = tid_, lane = tid & 63, r32 = lane & 31, hi = lane >> 5;
    o[0] = f32x16{}; o[1] = f32x16{};
    float m = -INFINITY, l = 0.f;
    const int koff = r32 * KROW + hi * 16;
    const int voff = TILE_B + (4 * hi + ((lane & 15) >> 2)) * VROW + (((lane >> 4) & 1) * 16 + (lane & 3) * 4) * 2;
    Stage sa, sb;
    stage_load<BIAS>(sa, P, t_lo, tid); stage_store<BIAS>(sa, lds, tid);
    if (t_lo + 1 < t_hi) stage_load<BIAS>(sa, P, t_lo + 1, tid);
    __syncthreads();
    for (int t = t_lo; t < t_hi; t += 2) {
        if (XP < 3 && t + 2 < t_hi) stage_load<BIAS>(sb, P, t + 2, tid);
        flash_tile<MODE, BIAS, XP>(lds, t, qf, tq, tq0, sel, koff, voff, hi, o, m, l);
        if (XP < 3 && t + 1 < t_hi) stage_store<BIAS>(sa, lds + BUF_B, tid);
        if (XP < 4) __syncthreads();
        if (t + 1 >= t_hi) break;
        if (XP < 3 && t + 3 < t_hi) stage_load<BIAS>(sa, P, t + 3, tid);
        flash_tile<MODE, BIAS, XP>(lds + BUF_B, t + 1, qf, tq, tq0, sel, koff, voff, hi, o, m, l);
        if (XP < 3 && t + 2 < t_hi) stage_store<BIAS>(sb, lds, tid);
        if (XP < 4) __syncthreads();
    }
    l_out = xsum(l);
}
__device__ __forceinline__ void store_o(bf16* orow, const f32x16 (&o)[2], float a, int hi) {
#pragma unroll
    for (int d0 = 0; d0 < 2; ++d0)
#pragma unroll
        for (int u = 0; u < 4; ++u) { u32x2 w; w.x = pk2(o[d0][4 * u] * a, o[d0][4 * u + 1] * a); w.y = pk2(o[d0][4 * u + 2] * a, o[d0][4 * u + 3] * a);
            *(u32x2*)(orow + 32 * d0 + 8 * u + 4 * hi) = w; }
}
}

__device__ __forceinline__ void phase_mem_mfma(const Frame& F, const KA& a) {
    unsigned char* ws = a.ws();
    const int vcu = (F.G % 8 == 0) ? (F.bid % 8) * (F.G / 8) + F.bid / 8 : F.bid;
    for (int u = vcu; u < 256; u += F.G) {
        const int b = u >> 5, h = (u >> 3) & 3, qb = u & 7;
        const int hi = F.lane >> 5, r32 = F.lane & 31, tq0 = 256 * qb + 32 * F.wave;
        const size_t tok = (size_t)b * SEQ + tq0 + r32;
        fa::bf16x8 qf[4];
#pragma unroll
        for (int d0 = 0; d0 < 4; ++d0) {
            float qa[8];
#pragma unroll
            for (int e = 0; e < 8; ++e) qa[e] = 0.f;
#pragma unroll
            for (int kq = 0; kq < 4; ++kq) { const u32x4 v = *(const u32x4*)((const bf16*)(ws + WS_MQ) + ((size_t)kq * M + tok) * 256 + h * 64 + 16 * d0 + 8 * hi);
                qa[0] += __uint_as_float(v.x << 16); qa[1] += __uint_as_float(v.x & 0xffff0000u); qa[2] += __uint_as_float(v.y << 16); qa[3] += __uint_as_float(v.y & 0xffff0000u);
                qa[4] += __uint_as_float(v.z << 16); qa[5] += __uint_as_float(v.z & 0xffff0000u); qa[6] += __uint_as_float(v.w << 16); qa[7] += __uint_as_float(v.w & 0xffff0000u); }
            u32x4 w; w.x = pk2(qa[0], qa[1]); w.y = pk2(qa[2], qa[3]); w.z = pk2(qa[4], qa[5]); w.w = pk2(qa[6], qa[7]);
            qf[d0] = __builtin_bit_cast(fa::bf16x8, w);
        }
        fa::KV P{(const bf16*)(ws + WS_MEMKV) + (size_t)b * NMEM * 512 + h * 64, (const bf16*)(ws + WS_MEMKV) + (size_t)b * NMEM * 512 + 256 + h * 64, 512, 512, nullptr};
        fa::f32x16 o[2]; float l;
        int nt_ = 4; asm volatile("" : "+s"(nt_));
        FA_CORE_MEM<fa::MODE_NONE, false>(F.lds, P, 0, nt_, qf, tq0 + r32, tq0, 0u, o, l);
        fa::store_o((bf16*)(ws + WS_MO) + tok * 256 + h * 64, o, 1.0f / l, hi);
    }
}
__device__ __forceinline__ void phase_fox_mfma(const Frame& F, const KA& a, bool dry) {
    unsigned char* ws = a.ws();
    const int vcu = (F.G % 8 == 0) ? (F.bid % 8) * (F.G / 8) + F.bid / 8 : F.bid;
    for (int u = vcu; u < 256; u += F.G) {
        const int bh = u >> 2, b = bh >> 3, h = bh & 7, s4 = u & 3;
        for (int half = 0; half < 2; ++half) {
            const int qb = half ? 7 - s4 : s4;
            const int hi = F.lane >> 5, r32 = F.lane & 31, tq0 = 256 * qb + 32 * F.wave;
            const size_t row0 = (size_t)b * SEQ, tok = row0 + tq0 + r32;
            bf16* Q = (bf16*)(ws + WS_OQ + 32 * MiB);
            fa::bf16x8 qf[4]; fa::load_q(qf, Q + tok * 512 + h * 64, hi);
            fa::KV P{(const bf16*)(ws + WS_KV + 32 * MiB) + row0 * 512 + h * 64, (const bf16*)(ws + WS_KV + 48 * MiB) + row0 * 512 + h * 64, 512, 512, (const float*)(ws + WS_CF) + (size_t)bh * SEQ};
            fa::f32x16 o[2]; float l;
            if (dry && PROBE_XP) fa::flash_core_v4<fa::MODE_CAUSAL, true, PROBE_XP>(F.lds, P, 0, 4 * (qb + 1), qf, tq0 + r32, tq0, 0u, o, l);
            else FA_CORE_FOX<fa::MODE_CAUSAL, true>(F.lds, P, 0, 4 * (qb + 1), qf, tq0 + r32, tq0, 0u, o, l);
            if (!dry) fa::store_o(Q + tok * 512 + h * 64, o, 1.0f / l, hi);
        }
    }
}

__device__ __forceinline__ void phase_nsa_fused(const Frame& F, const KA& a, bool dry) {
    using namespace fa;
    unsigned char* ws = a.ws();
    const int vcu = (F.G % 8 == 0) ? (F.bid % 8) * (F.G / 8) + F.bid / 8 : F.bid;
    const int* pos = (const int*)a.in(2);
    const int lane = F.lane, r32 = lane & 31, hi = lane >> 5, tid = F.tid, wave = F.wave;
    LAS unsigned char* lds = F.lds;
    constexpr int CT = 128 * KROW, SC_OFF = 45056, MK_OFF = SC_OFF + 8 * 32 * 32 * 4;
    for (int u = vcu; u < 256; u += F.G) {
        const int bg = u >> 4, b = bg >> 1, g = bg & 1, s16 = u & 15;
        for (int half = 0; half < 2; ++half) {
            const int qb = half ? 31 - s16 : s16;
            const int h = 4 * g + (wave >> 1), tq0 = 64 * qb + 32 * (wave & 1), tq = tq0 + r32;
            const size_t row0 = (size_t)b * SEQ, tok = row0 + tq;
            bf16* Q = (bf16*)(ws + WS_OQ + 16 * MiB);
            const bf16* kv = (const bf16*)(ws + WS_KV + 64 * MiB) + row0 * 768 + g * 64;
            const bf16* small = (const bf16*)(ws + WS_KV + 88 * MiB) + tok * 256 + h * 3;
            const float g0 = sigm(bf2f(small[0])), g1 = sigm(bf2f(small[1])), g2 = sigm(bf2f(small[2]));
            bf16x8 qf[4]; load_q(qf, Q + tok * 512 + h * 64, hi);
            {   const bf16* Kc = (const bf16*)(ws + WS_KCMP) + (size_t)bg * 128 * 64; const bf16* Vc = (const bf16*)(ws + WS_VCMP) + (size_t)bg * 128 * 64;
#pragma unroll
                for (int i = 0; i < 2; ++i) { const int pc = tid + 512 * i, row = pc >> 3, ch = pc & 7;
                    *(LAS u32x4*)(lds + row * KROW + ch * 16) = *(const u32x4*)(Kc + row * 64 + ch * 8);
                    *(LAS u32x4*)(lds + CT + row * VROW + ch * 16) = *(const u32x4*)(Vc + row * 64 + ch * 8); } }
            __syncthreads();
            {
                f32x16 acc[2];
                const int koff = r32 * KROW + hi * 16;
                const int voff = CT + (4 * hi + ((lane & 15) >> 2)) * VROW + (((lane >> 4) & 1) * 16 + (lane & 3) * 4) * 2;
                const int ncmax = tq0 >= 0 ? min(127, (tq0 + 31 - 31) / 16 + 1) : 0, nsub = (ncmax + 31) >> 5;
                f32x16 s[4];
#pragma unroll
                for (int j = 0; j < 4; ++j) s[j] = f32x16{};
#pragma unroll
                for (int j = 0; j < 4; ++j) if (j < nsub) {
#pragma unroll
                    for (int d0 = 0; d0 < 4; ++d0) { const bf16x8 kf = *(const LAS bf16x8*)(lds + koff + 32 * j * KROW + d0 * 32); s[j] = __builtin_amdgcn_mfma_f32_32x32x16_bf16(kf, qf[d0], s[j], 0, 0, 0); } }
                float mx = -INFINITY;
#pragma unroll
                for (int j = 0; j < 4; ++j)
#pragma unroll
                    for (int rr = 0; rr < 16; ++rr) { const int c = 32 * j + crow(rr, hi); const bool v = (16 * c + 31 <= tq) && (c < 127) && (j < nsub); s[j][rr] = v ? s[j][rr] : -INFINITY; mx = fmaxf(mx, s[j][rr]); }
                mx = xmax(mx);
                const float ms = (mx == -INFINITY) ? 0.f : mx * LOG2E;
                float ps = 0.f;
#pragma unroll
                for (int j = 0; j < 4; ++j)
#pragma unroll
                    for (int rr = 0; rr < 16; ++rr) { s[j][rr] = __builtin_amdgcn_exp2f(s[j][rr] * LOG2E - ms); ps += s[j][rr]; }
                ps = xsum(ps);
                const float inv = ps > 0.f ? 1.0f / ps : 0.f;
#pragma unroll
                for (int j = 0; j < 4; ++j)
#pragma unroll
                    for (int rr = 0; rr < 16; ++rr) s[j][rr] *= inv;
                LAS float* sc_out = (LAS float*)(lds + SC_OFF) + (wave * 32 + r32) * 32;
                float prev = 0.f;
#pragma unroll
                for (int idx = 0; idx < 16; ++idx) { const int j = idx >> 2, uu = idx & 3;
                    const float G = (s[j][4 * uu] + s[j][4 * uu + 1]) + (s[j][4 * uu + 2] + s[j][4 * uu + 3]), L = s[j][4 * uu + 3];
                    const float recv = __shfl_xor(L, 32);
                    sc_out[2 * idx + hi] = G + (hi ? recv : prev);
                    prev = recv; }
                acc[0] = f32x16{}; acc[1] = f32x16{};
#pragma unroll
                for (int j = 0; j < 4; ++j) if (j < nsub) {
#pragma unroll
                    for (int ss = 0; ss < 2; ++ss) {
                        const bf16x8 pb = pack8(s[j], 8 * ss);
#pragma unroll
                        for (int d0 = 0; d0 < 2; ++d0) {
                            const LAS unsigned char* vp = lds + voff + (32 * j + 16 * ss) * VROW + d0 * 64;
                            const s16x4 lo = vtr(vp), hh = vtr(vp + 8 * VROW);
                            const bf16x8 vf = (bf16x8){lo[0], lo[1], lo[2], lo[3], hh[0], hh[1], hh[2], hh[3]};
                            acc[d0] = __builtin_amdgcn_mfma_f32_32x32x16_bf16(vf, pb, acc[d0], 0, 0, 0);
                        }
                    } }
                store_o((bf16*)(ws + WS_OCMP) + tok * 512 + h * 64, acc, g0, hi);
            }
            __syncthreads();
            if (tid < 64) {
                const int t = 64 * qb + tid, sub = tid >> 5, rr = tid & 31;
                float sc[32];
#pragma unroll
                for (int n = 0; n < 32; ++n) sc[n] = 0.f;
#pragma unroll
                for (int r = 0; r < 4; ++r) { const LAS f32x4* p = (const LAS f32x4*)(lds + SC_OFF) + ((2 * r + sub) * 32 + rr) * 8;
#pragma unroll
                    for (int i = 0; i < 8; ++i) { const f32x4 v = p[i]; sc[4 * i] += v.x; sc[4 * i + 1] += v.y; sc[4 * i + 2] += v.z; sc[4 * i + 3] += v.w; } }
                const int cur = t >> 6;
#pragma unroll
                for (int n = 0; n < 32; ++n) sc[n] = (n == 0 || n == cur) ? 1e4f : ((64 * n <= t) ? sc[n] : -1.0f);
                unsigned mask = 0u;
#pragma unroll
                for (int k = 0; k < 8; ++k) {
                    float best = sc[0]; int bi = 0;
#pragma unroll
                    for (int n = 1; n < 32; ++n) { const bool take = sc[n] > best; best = take ? sc[n] : best; bi = take ? n : bi; }
                    mask |= 1u << bi;
#pragma unroll
                    for (int n = 0; n < 32; ++n) sc[n] = (n == bi) ? -INFINITY : sc[n];
                }
                ((LAS unsigned*)(lds + MK_OFF))[tid] = mask;
            }
            __syncthreads();
            const unsigned sel = ((const LAS unsigned*)(lds + MK_OFF))[32 * (wave & 1) + r32];
            rope_q(qf[0], pos[tok], hi);
            f32x16 o[2]; float l;
            { KV P{kv + 256, kv + 384, 768, 768, nullptr};
              FA_CORE_SEL<MODE_SELECT, false>(lds, P, 0, qb + 1, qf, tq, tq0, sel, o, l); }
            f32x16 acc[2];
            { const float sc = l > 0.f ? g1 / l : 0.f;
#pragma unroll
              for (int r = 0; r < 16; ++r) { acc[0][r] = o[0][r] * sc; acc[1][r] = o[1][r] * sc; } }
            { KV P{kv + 512, kv + 640, 768, 768, nullptr};
              FA_CORE_SEL<MODE_WINDOW, false>(lds, P, qb > 8 ? qb - 8 : 0, qb + 1, qf, tq, tq0, 0u, o, l); }
            { const float sc = l > 0.f ? g2 / l : 0.f;
              const bf16* oc = (const bf16*)(ws + WS_OCMP) + tok * 512 + h * 64;
#pragma unroll
              for (int d0 = 0; d0 < 2; ++d0)
#pragma unroll
                  for (int uu = 0; uu < 4; ++uu) { const u32x2 w = *(const u32x2*)(oc + 32 * d0 + 8 * uu + 4 * hi);
                      acc[d0][4 * uu] += o[d0][4 * uu] * sc + __uint_as_float(w.x << 16); acc[d0][4 * uu + 1] += o[d0][4 * uu + 1] * sc + __uint_as_float(w.x & 0xffff0000u);
                      acc[d0][4 * uu + 2] += o[d0][4 * uu + 2] * sc + __uint_as_float(w.y << 16); acc[d0][4 * uu + 3] += o[d0][4 * uu + 3] * sc + __uint_as_float(w.y & 0xffff0000u); } }
            if (!dry) store_o(Q + tok * 512 + h * 64, acc, 1.0f, hi);
        }
    }
}


__device__ __forceinline__ void phase_sb_mfma(const Frame& F, const KA& a, int l, bool dry) {
    using namespace fa;
    unsigned char* ws = a.ws();
    const int lane = F.lane, r32 = lane & 31, hi = lane >> 5;
    LAS unsigned char* lds = F.lds + F.wave * (32 * KROW + 32 * VROW);
    constexpr int SUB_B = 32 * KROW;
    const int koff = r32 * KROW + hi * 16;
    const int voff = SUB_B + (4 * hi + ((lane & 15) >> 2)) * VROW + (((lane >> 4) & 1) * 16 + (lane & 3) * 4) * 2;
    const unsigned shard = (unsigned)F.bid & 7u;
    unsigned* ctr = (unsigned*)(ws + WS_CTL) + CW_SB + 64 * (shard + 8 * (unsigned)l);
    for (;;) {
        unsigned k_ = 0u;
        if (lane == 0) k_ = __hip_atomic_fetch_add(ctr, 1u, __ATOMIC_RELAXED, __HIP_MEMORY_SCOPE_AGENT);
        k_ = (unsigned)__builtin_amdgcn_readfirstlane((int)k_);
        if (k_ >= 512u) break;
        const int u = (int)(shard * 512u + (511u - k_));
        const int bh = u >> 6, b = bh >> 3, h = bh & 7, rb = u & 63;
        const int tq0 = 32 * rb, tq = tq0 + r32;
        const size_t row0 = (size_t)b * SEQ, tok = row0 + tq;
        bf16* Q = (bf16*)(ws + WS_OQ);
        const bf16* Kg = (const bf16*)(ws + WS_KV) + row0 * 512 + h * 64; const bf16* Vg = (const bf16*)(ws + WS_KV + 16 * MiB) + row0 * 512 + h * 64;
        bf16x8 qf[4]; load_q(qf, Q + tok * 512 + h * 64, hi);
        f32x16 o[2]; o[0] = f32x16{}; o[1] = f32x16{};
        float carry = 1.0f;
        u32x4 ak[4], av[4], bk[4], bv[4];
#define SB_LOAD(K_, V_, j_) do { _Pragma("unroll") for (int i = 0; i < 4; ++i) { const int pc = lane + 64 * i, row = 32 * (j_) + (pc >> 3), ch = pc & 7; \
            K_[i] = *(const u32x4*)(Kg + (size_t)row * 512 + ch * 8); V_[i] = *(const u32x4*)(Vg + (size_t)row * 512 + ch * 8); } } while (0)
#define SB_STORE(K_, V_) do { _Pragma("unroll") for (int i = 0; i < 4; ++i) { const int pc = lane + 64 * i, off = (pc >> 3) * KROW + (pc & 7) * 16, offv = (pc >> 3) * VROW + (pc & 7) * 16; \
            *(LAS u32x4*)(lds + off) = K_[i]; *(LAS u32x4*)(lds + SUB_B + offv) = V_[i]; } } while (0)
#define SB_COMPUTE(jj_) do { const int jsub_ = (jj_); \
            f32x16 s = f32x16{}; \
_Pragma("unroll") \
            for (int d0 = 0; d0 < 4; ++d0) { const bf16x8 kf = *(const LAS bf16x8*)(lds + koff + d0 * 32); s = __builtin_amdgcn_mfma_f32_32x32x16_bf16(kf, qf[d0], s, 0, 0, 0); } \
            const int dd = tq - (32 * jsub_ + 4 * hi); \
            float keep[16]; \
_Pragma("unroll") \
            for (int r = 0; r < 16; ++r) { \
                const bool v = ((r & 3) + 8 * (r >> 2)) < dd; const float z = s[r]; \
                const float ea = __expf(-fabsf(z)), rr = __builtin_amdgcn_rcpf(1.0f + ea), sm = ea * rr; \
                const float beta = z >= 0.f ? rr : sm, kp = z >= 0.f ? sm : rr; \
                keep[r] = v ? kp : 1.0f; s[r] = v ? beta : 0.f; \
            } \
            float Go[4], Gp[4]; \
_Pragma("unroll") \
            for (int uu = 0; uu < 4; ++uu) { Go[uu] = (keep[4 * uu] * keep[4 * uu + 1]) * (keep[4 * uu + 2] * keep[4 * uu + 3]); Gp[uu] = __shfl_xor(Go[uu], 32); } \
            float above = carry; \
_Pragma("unroll") \
            for (int uu = 3; uu >= 0; --uu) { \
                const float e3 = above * (hi ? 1.0f : Gp[uu]); \
                const float e2 = e3 * keep[4 * uu + 3], e1 = e2 * keep[4 * uu + 2], e0 = e1 * keep[4 * uu + 1]; \
                s[4 * uu + 3] *= e3; s[4 * uu + 2] *= e2; s[4 * uu + 1] *= e1; s[4 * uu] *= e0; \
                above *= Go[uu] * Gp[uu]; \
            } \
            carry = above; \
_Pragma("unroll") \
            for (int ss = 0; ss < 2; ++ss) { \
                const bf16x8 pb = pack8(s, 8 * ss); \
_Pragma("unroll") \
                for (int d0 = 0; d0 < 2; ++d0) { \
                    const LAS unsigned char* vp = lds + voff + (16 * ss) * VROW + d0 * 64; \
                    const s16x4 lo = vtr(vp), hh = vtr(vp + 8 * VROW); \
                    const bf16x8 vf = (bf16x8){lo[0], lo[1], lo[2], lo[3], hh[0], hh[1], hh[2], hh[3]}; \
                    o[d0] = __builtin_amdgcn_mfma_f32_32x32x16_bf16(vf, pb, o[d0], 0, 0, 0); \
                } \
            } \
        } while (0)
        SB_LOAD(ak, av, rb);
        if (rb > 0) SB_LOAD(bk, bv, rb - 1);
        for (int j = rb; j >= 0; j -= 2) {
            SB_STORE(ak, av);
            if (j >= 2) SB_LOAD(ak, av, j - 2);
            SB_COMPUTE(j);
            if (__ballot(carry != 0.f) == 0ull) break;
            if (j == 0) break;
            SB_STORE(bk, bv);
            if (j >= 3) SB_LOAD(bk, bv, j - 3);
            SB_COMPUTE(j - 1);
            if (__ballot(carry != 0.f) == 0ull) break;
        }
#undef SB_LOAD
#undef SB_STORE
#undef SB_COMPUTE
        if (!dry) store_o(Q + tok * 512 + h * 64, o, 1.0f, hi);
    }
    __syncthreads();
}

__device__ __forceinline__ void phase_norm(const Frame& F, const KA& a, const bf16* ysrc, const float* xs, const float* gpost, const float* gpre, bool write_h, bool dry) {
    unsigned char* ws = a.ws();
    for (int r = F.gw; r < M; r += 2 * F.ngw) {
        const int r1 = (r + F.ngw < M) ? r + F.ngw : r;
        if (r1 != r) post_norm_rows2(ysrc + (size_t)r * DM, ysrc + (size_t)r1 * DM, xs + (size_t)r * DM, xs + (size_t)r1 * DM, a.out() + (size_t)r * DM, a.out() + (size_t)r1 * DM, gpost, gpre,
                                     (bf16*)(ws + WS_H) + (size_t)r * DM, (bf16*)(ws + WS_H) + (size_t)r1 * DM, write_h, dry, F.lane);
        else post_norm_row(ysrc + (size_t)r * DM, xs + (size_t)r * DM, a.out() + (size_t)r * DM, gpost, gpre, (bf16*)(ws + WS_H) + (size_t)r * DM, write_h, dry, F.lane);
    }
}

__device__ __forceinline__ void launder_frame(Frame& F) {
    int z = 0; asm volatile("" : "+s"(z));
    int t = threadIdx.x; asm volatile("" : "+v"(t));
    F.tid = t; F.lane = t & 63; F.wave = __builtin_amdgcn_readfirstlane(t >> 6);
    F.G = (int)gridDim.x + z; F.bid = (int)blockIdx.x + z;
    F.gw = F.bid * NWAVES + F.wave; F.ngw = F.G * NWAVES; F.gt = F.bid * NTHREADS + F.tid; F.ngt = F.G * NTHREADS;
}
constexpr int NPH = 19;
constexpr int LDS_BYTES = 147456;
constexpr int MISC_OFF = 131072 + 320;

template <int PSEL> __global__ void __launch_bounds__(NTHREADS, 2) hybrid_fwd(Args a_unused) {
    extern __shared__ __attribute__((aligned(16))) unsigned char lds_raw[];
    Frame F;
    F.lds = (LAS unsigned char*)lds_raw;
    F.tid = threadIdx.x; F.lane = F.tid & 63; F.wave = __builtin_amdgcn_readfirstlane(F.tid >> 6);
    F.G = gridDim.x; F.bid = blockIdx.x;
    F.gw = F.bid * NWAVES + F.wave; F.ngw = F.G * NWAVES; F.gt = F.bid * NTHREADS + F.tid; F.ngt = F.G * NTHREADS;
    volatile LAS unsigned* MISC = (volatile LAS unsigned*)(F.lds + MISC_OFF);
    if (F.tid < 32) MISC[F.tid] = 0u;
    __syncthreads();
    KA a; a.refresh();
    unsigned char* ws = a.ws();
    constexpr bool one_launch = PSEL < 0;
    XcdBarrier bar; bar.bar = (unsigned*)(ws + WS_CTL) + CW_BAR; bar.x = 0; bar.st = nullptr;
    if (one_launch) bar = xcd_barrier_post((unsigned*)(ws + WS_CTL) + CW_BAR, MISC + 8);
#define IN(k) (a.refresh(), ws = a.ws(), launder_frame(F), (PSEL < 0 || PSEL == ((k) - p0)))
#define REP(k) for (int rep_ = ((PROBE_MASK >> (k)) & 1) ? a.ph_hi() : 0; rep_ >= 0; --rep_)
#define DRY (rep_ > 0)
#define SEAM(k) do { if (PSEL < 0) { xcd_barrier(bar); if (PROBE_XBAR) xcd_barrier(bar); } } while (0)
    typedef pg8::bf16_t pb;
    const int l_lo = (PSEL < 0 ? 0 : a.ph_lo()), l_hi = (PSEL < 0 ? 2 : l_lo + 1);
    for (int l = l_lo; l < l_hi; ++l) {
        const int p0 = l * NPH;
        if (l == 0) { if (IN(p0 + 0)) REP(0) { phase_conv(F, a, 0); __syncthreads(); } SEAM(p0 + 0); }
        if (IN(p0 + 1)) REP(1) {
            pg8::Gemm g{(const pb*)(ws + WS_H), (const pb*)(ws + W_A), M, NA, DM}; pg8::StaticOrder S; S.init(M, NA, F.G, F.bid);
            pg8::EpiProj E{(pb*)(ws + WS_CK), (pb*)(ws + WS_OQ), (pb*)(ws + WS_KV), M};
            pg8::gemm_phase<pg8::EpiProj, pg8::StaticOrder, true, true>(F.lds, g, S, E);
            { pg8::Gemm g2{(const pb*)(ws + WS_MEMN), (const pb*)(ws + W_MKV), MMEM, 512, DM}; pg8::StaticOrder S2; S2.init(MMEM, 512, F.G, (F.bid + F.G - 128) % F.G);
              pg8::EpiPlain E2{(pb*)(ws + WS_MEMKV), 512}; pg8::gemm_phase<pg8::EpiPlain, pg8::StaticOrder, true, true>(F.lds, g2, S2, E2); }
            phase_conv_b(F, a, l);
        }
        SEAM(p0 + 1);
        if (IN(p0 + 3)) REP(3) {
            phase_post(F, a, l, DRY);
            { pg8::Gemm g{(const pb*)(ws + WS_CK), (const pb*)(ws + W_C1K), 2048, 512, 1024}; pg8::StaticOrder S; S.init(2048, 512, F.G, F.bid);
              pg8::EpiPlain E{(pb*)(ws + WS_PK), 512}; pg8::gemm_phase<pg8::EpiPlain, pg8::StaticOrder, true, true>(F.lds, g, S, E); }
            { pg8::Gemm g{(const pb*)(ws + WS_CV), (const pb*)(ws + W_C1V), 2048, 512, 1024}; pg8::StaticOrder S; S.init(2048, 512, F.G, (F.bid + F.G - 16) % F.G);
              pg8::EpiPlain E{(pb*)(ws + WS_PV), 512}; pg8::gemm_phase<pg8::EpiPlain, pg8::StaticOrder, true, true>(F.lds, g, S, E); }
            phase_sb_mfma(F, a, l, DRY);
        }
        SEAM(p0 + 3);
        if (IN(p0 + 4)) REP(4) { phase_cmp2(F, a, l); phase_fox_mfma(F, a, DRY); }
        SEAM(p0 + 4);
        if (IN(p0 + 5)) REP(5) phase_nsa_fused(F, a, DRY);
        SEAM(p0 + 5);
        if (IN(p0 + 8)) REP(8) {
            pg8::Gemm g{(const pb*)(ws + WS_OQ), (const pb*)(ws + W_UP), 3 * M, 3072, 512}; pg8::UpOrder S; S.init(M, F.G, F.bid);
            pg8::EpiUpU E{(pb*)(ws + WS_MG)};
            pg8::gemm_phase<pg8::EpiUpU, pg8::UpOrder, true, true>(F.lds, g, S, E);
        }
        SEAM(p0 + 8);
        if (IN(p0 + 9)) REP(9) {
            pg8::Gemm g{(const pb*)(ws + WS_H), (const pb*)(ws + W_M), M, 3072, DM}; pg8::MergeOrder S; S.init(M, F.G, F.bid);
            pg8::EpiGateY2 E{(const pb*)(ws + WS_MG), (pb*)(ws + WS_OQ), DRY};
            pg8::gemm_phase<pg8::EpiGateY2, pg8::MergeOrder, true, true>(F.lds, g, S, E);
        }
        SEAM(p0 + 9);
        if (IN(p0 + 10)) REP(10) {
            pg8::Gemm g{(const pb*)(ws + WS_OQ), (const pb*)(ws + W_OUT3), M, DM, DM}; pg8::StaticOrder S; S.init(M, DM, F.G, F.bid);
            pg8::EpiPlain E{(pb*)(ws + WS_MG), DM};
            pg8::gemm_phase<pg8::EpiPlain, pg8::StaticOrder, true, true>(F.lds, g, S, E);
        }
        SEAM(p0 + 10);
        if (IN(p0 + 11)) REP(11) phase_norm(F, a, (const bf16*)(ws + WS_MG), l == 0 ? (const float*)a.in(0) : (const float*)a.out(), (const float*)a.in(4) + l * DM, (const float*)a.in(5) + l * DM, true, DRY);
        SEAM(p0 + 11);
        if (IN(p0 + 12)) REP(12) {
            for (int kq = 0; kq < 4; ++kq) {
                pg8::Gemm g{(const pb*)(ws + WS_H) + kq * 256, (const pb*)(ws + W_MQ) + kq * 256, M, 256, 256, DM, DM}; pg8::StaticOrder S; S.init(M, 256, F.G, (F.bid + F.G - 64 * kq) % F.G);
                pg8::EpiPlain E{(pb*)(ws + WS_MQ) + (size_t)kq * M * 256, 256}; pg8::gemm_phase<pg8::EpiPlain, pg8::StaticOrder, true, true>(F.lds, g, S, E);
            }
        }
        SEAM(p0 + 12);
        if (IN(p0 + 13)) REP(13) phase_mem_mfma(F, a);
        SEAM(p0 + 13);
        if (IN(p0 + 14)) REP(14) {
            pg8::Gemm g{(const pb*)(ws + WS_MO), (const pb*)(ws + W_MO), M, DM, 256}; pg8::StaticOrder S; S.init(M, DM, F.G, F.bid);
            pg8::EpiPlain E{(pb*)(ws + WS_H), DM};
            pg8::gemm_phase<pg8::EpiPlain, pg8::StaticOrder, true, true>(F.lds, g, S, E);
        }
        SEAM(p0 + 14);
        if (IN(p0 + 15)) REP(15) phase_norm(F, a, (const bf16*)(ws + WS_H), (const float*)a.out(), (const float*)a.in(7) + l * DM, (const float*)a.in(8) + l * DM, true, DRY);
        SEAM(p0 + 15);
        if (IN(p0 + 16)) REP(16) {
            pg8::Gemm g{(const pb*)(ws + WS_H), (const pb*)(ws + W_GU), M, 2 * DFF, DM}; pg8::StaticOrder S; S.init(M, 2 * DFF, F.G, F.bid);
            pg8::EpiSwiglu E{(pb*)(ws + WS_ACT), DFF};
            pg8::gemm_phase<pg8::EpiSwiglu, pg8::StaticOrder, true, true>(F.lds, g, S, E);
        }
        SEAM(p0 + 16);
        if (IN(p0 + 17)) REP(17) {
            pg8::Gemm g{(const pb*)(ws + WS_ACT), (const pb*)(ws + W_DN), M, DM, DFF}; pg8::StaticOrder S; S.init(M, DM, F.G, F.bid);
            pg8::EpiPlain E{(pb*)(ws + WS_H), DM};
            pg8::gemm_phase<pg8::EpiPlain, pg8::StaticOrder, true, true>(F.lds, g, S, E);
        }
        SEAM(p0 + 17);
        if (IN(p0 + 18)) REP(18) { phase_norm(F, a, (const bf16*)(ws + WS_H), (const float*)a.out(), (const float*)a.in(9) + l * DM, (const float*)a.in(3) + (l + 1 < 2 ? l + 1 : l) * DM, l == 0, DRY);
            if (l == 0) { phase_conv(F, a, 1); __syncthreads(); } }
        if (l == 0) SEAM(p0 + 18);
    }
#undef IN
#undef SEAM
}

template <int P> static hipError_t set_attr1() { return hipFuncSetAttribute((const void*)hybrid_fwd<P>, hipFuncAttributeMaxDynamicSharedMemorySize, LDS_BYTES); }
template <int... P> static hipError_t set_attrs_seq(std::integer_sequence<int, P...>) { hipError_t e = hipSuccess; hipError_t r[] = {set_attr1<P>()...}; for (hipError_t x : r) if (x != hipSuccess) e = x; return e; }
static hipError_t set_attrs() {
#if MK_ONE_LAUNCH
    return set_attr1<-1>();
#else
    return set_attrs_seq(std::make_integer_sequence<int, NPH>{});
#endif
}
template <int P> static int launch1(const Args& a, int grid, hipStream_t stream) { hybrid_fwd<P><<<dim3(grid), dim3(NTHREADS), LDS_BYTES, stream>>>(a); return 0; }
template <int... P> static void launch_phases(const Args& a, int grid, hipStream_t stream, std::integer_sequence<int, P...>) {
    (void)std::initializer_list<int>{launch1<P>(a, grid, stream)...};
}

extern "C" void kernel_launch(void* const* d_in, const int* in_sizes, int n_in, void* d_out, int out_size, void* d_ws, size_t ws_size, hipStream_t stream) {
    static int grid = 0;
    if (grid == 0) {
        if (n_in != 31 || out_size != M * DM || ws_size < WS_END) { fprintf(stderr, "kernel_launch: unexpected problem (n_in %d, out %d, ws %zu)\n", n_in, out_size, ws_size); grid = -1; return; }
        if (set_attrs() != hipSuccess) { fprintf(stderr, "kernel_launch: hipFuncSetAttribute failed\n"); grid = -1; return; }
        int dev = 0, cus = 0;
        if (hipGetDevice(&dev) != hipSuccess || hipDeviceGetAttribute(&cus, hipDeviceAttributeMultiprocessorCount, dev) != hipSuccess) { grid = -1; return; }
        grid = cus;
    }
    if (grid < 0) return;
    (void)hipMemsetAsync((char*)d_ws + WS_CTL, 0, CTL_ZERO_BYTES, stream);
    Args a{};
    for (int i = 0; i < 31; ++i) a.in[i] = d_in[i];
    a.out = (float*)d_out; a.ws = (unsigned char*)d_ws;
#if MK_ONE_LAUNCH
    a.ph_lo = 0; a.ph_hi = PROBE_REPS;
    launch1<-1>(a, grid, stream);
#else
    for (int l = 0; l < 2; ++l) { a.ph_lo = l; a.ph_hi = l + 1; launch_phases(a, grid, stream, std::make_integer_sequence<int, NPH>{}); }
#endif
}
```

```cpp
#include <hip/hip_runtime.h>
#include <cstdio>
#include <cstdint>
#include <cmath>
#include <utility>
#include <initializer_list>
#define MK_ONE_LAUNCH 1
#define PROBE_MASK 0u
#define PROBE_REPS 0
#define PROBE_XBAR 0
#define PROBE_XP 0
#define FA_FULL 1
#define FA_RESC 1
#define FA_VAR 0
#define FA_CORE_MEM fa::flash_core_v4
#define FA_CORE_FOX fa::flash_core_v4
#define FA_CORE_SEL fa::flash_core_v4
#define GAS __attribute__((address_space(1)))
#define LAS __attribute__((address_space(3)))
namespace pg8 {
#define PG8_LAS __attribute__((address_space(3)))
typedef unsigned short bf16_t;
typedef short bf16x8 __attribute__((ext_vector_type(8)));
typedef float f32x4 __attribute__((ext_vector_type(4)));
typedef unsigned u32x4 __attribute__((ext_vector_type(4)));
constexpr int BM = 256, BK = 64, HALF = 128, HTB = HALF * BK * 2  , STAGE_BYTES = 8 * HTB, NXCD = 8, WGM = 8;

__host__ __device__ __forceinline__ int lds_byte(int r, int c) { const int st = (r >> 4) * 2 + (c >> 5), rr = r & 15, cc = c & 31, ob = rr * 64 + cc * 2; return st * 1024 + (ob ^ (((ob >> 9) & 1) << 5)); }
__host__ __device__ __forceinline__ void stage_rc(int b, int& R, int& C) { const int st = b / 1024, sb = b % 1024, swz = sb ^ (((sb >> 9) & 1) << 5); R = (st >> 1) * 16 + swz / 64; C = (st & 1) * 32 + (swz % 64) / 2; }
__host__ __device__ __forceinline__ int perm32(int rho) { const int n = rho >> 4, i = rho & 15; return 8 * (i >> 2) + 4 * n + (i & 3); }

struct Unit { int pm, pn; };
struct Gemm { const bf16_t* A; const bf16_t* Bt; int M, N, K; int lda, ldb; };

struct StaticOrder {
    int nM, nN, nwg, G, c;
    __host__ __device__ void init(int M, int N, int G_, int c_) { nM = M / BM; nN = N / BM; nwg = nM * nN; G = G_; c = c_; }
    __host__ __device__ bool next(int i, Unit& u) const {
        const long L = (long)i * G + c; if (L >= nwg) return false;
        int wgid = (int)L; { const int q = nwg / NXCD, r = nwg % NXCD, xcd = wgid % NXCD, off = wgid / NXCD; wgid = (xcd < r ? xcd * (q + 1) : r * (q + 1) + (xcd - r) * q) + off; }
        const int nig = WGM * nN, gid = wgid / nig, fm = gid * WGM, gsz = (nM - fm) < WGM ? (nM - fm) : WGM;
        u.pm = fm + ((wgid % nig) % gsz); u.pn = (wgid % nig) / gsz; return true;
    }
    __device__ __forceinline__ void a_ready(const Unit&) const {}
    __device__ __forceinline__ void done(const Unit&) const {}
};

typedef float cvt_f32x2_t __attribute__((ext_vector_type(2))); typedef __bf16 cvt_bf16x2_t __attribute__((ext_vector_type(2)));
__device__ __forceinline__ unsigned cvt_pk_bf16(float lo, float hi) { const cvt_f32x2_t v = {lo, hi}; const cvt_bf16x2_t b = __builtin_convertvector(v, cvt_bf16x2_t); return __builtin_bit_cast(unsigned, b); }
typedef float f32x2 __attribute__((ext_vector_type(2)));
template <class Epi, class Sched, bool ALIGN_EPI = false, bool SP2 = false>
__device__ __forceinline__ void gemm_phase(PG8_LAS unsigned char* lds, const Gemm g, const Sched& S, const Epi& E) {
    int tid_ = threadIdx.x; asm volatile("" : "+v"(tid_));
    const int tid = tid_, wid = __builtin_amdgcn_readfirstlane(tid >> 6), lane = tid & 63, wr = wid >> 2, wc = wid & 3, fr = lane & 15, fq = lane >> 4;
    const int K = g.K, nt = K / BK, lda = g.lda ? g.lda : K, ldb = g.ldb ? g.ldb : K;
    unsigned voffA[2], voffB[2];
#pragma unroll
    for (int i = 0; i < 2; ++i) { int R, C; stage_rc(tid * 16 + i * 8192, R, C); const int Rb = Epi::PERM ? ((R & ~31) + perm32(R & 31)) : R;
        voffA[i] = (unsigned)(R * lda + C) * 2u; voffB[i] = (unsigned)(Rb * ldb + C) * 2u; }
    const size_t kstep = (size_t)(BK * 2);
    const size_t hstepA = (size_t)HALF * lda * 2, hstepB = (size_t)HALF * ldb * 2;
    const size_t tstepA = 2 * hstepA, tstepB = 2 * hstepB;
    const unsigned ldsw = (unsigned)wid * 1024u;
    const int aoff = lds_byte(wr * 64 + fr, fq * 8), boff = lds_byte(wc * 32 + fr, fq * 8);
#define PG8_SA(b, h) (((b) * 2 + (h)) * HTB)
#define PG8_SB(b, h) ((4 + (b) * 2 + (h)) * HTB)
#define PG8_STAGE(bufoff, gbase, voff) do { _Pragma("unroll") for (int _i = 0; _i < 2; ++_i) \
        __builtin_amdgcn_global_load_lds((const unsigned*)((const char*)(gbase) + (voff)[_i]), (PG8_LAS unsigned*)(lds + (bufoff) + ldsw + _i * 8192), 16, 0, 0); } while (0)
#define PG8_LDA(dst, b, h) do { _Pragma("unroll") for (int m = 0; m < 4; ++m) _Pragma("unroll") for (int k = 0; k < 2; ++k) dst[m][k] = *(const PG8_LAS bf16x8*)(lds + PG8_SA(b, h) + aoff + m * 2048 + k * 1024); } while (0)
#define PG8_LDB(dst, b, h) do { _Pragma("unroll") for (int n = 0; n < 2; ++n) _Pragma("unroll") for (int k = 0; k < 2; ++k) dst[n][k] = *(const PG8_LAS bf16x8*)(lds + PG8_SB(b, h) + boff + n * 2048 + k * 1024); } while (0)
#define PG8_MMA(ai, bj, At, Bt) do { __builtin_amdgcn_s_setprio(1); _Pragma("unroll") for (int m = 0; m < 4; ++m) _Pragma("unroll") for (int n = 0; n < 2; ++n) _Pragma("unroll") for (int k = 0; k < 2; ++k) \
        acc[ai][bj][m][n] = __builtin_amdgcn_mfma_f32_16x16x32_bf16(Bt[n][k], At[m][k], acc[ai][bj][m][n], 0, 0, 0); __builtin_amdgcn_s_setprio(0); } while (0)
#define PG8_WAIT_V(n) asm volatile("s_waitcnt vmcnt(" #n ")" ::: "memory")
#define PG8_WAIT_L(n) asm volatile("s_waitcnt lgkmcnt(" #n ")" ::: "memory")
#define PG8_BAR __builtin_amdgcn_s_barrier()
#define PG8_SCHED __builtin_amdgcn_sched_barrier(0)
    Unit cur, nxt; int ui = 0;
    if (!S.next(0, cur)) return;
    float zz_ = 0.f; asm volatile("" : "+v"(zz_));
    f32x4 acc[2][2][4][2];
#pragma unroll
    for (int a = 0; a < 2; ++a)
#pragma unroll
        for (int b = 0; b < 2; ++b)
#pragma unroll
            for (int m = 0; m < 4; ++m)
#pragma unroll
                for (int n = 0; n < 2; ++n) acc[a][b][m][n] = (f32x4){zz_, zz_, zz_, zz_};
    bf16x8 At[4][2], B0[2][2], B1[2][2];
    const char* cA = (const char*)g.A + (size_t)cur.pm * tstepA; const char* cB = (const char*)g.Bt + (size_t)cur.pn * tstepB;
    S.a_ready(cur);
    if constexpr (SP2) {
        PG8_STAGE(PG8_SB(0, 0), cB, voffB); PG8_STAGE(PG8_SB(0, 1), cB + hstepB, voffB); PG8_STAGE(PG8_SA(0, 0), cA, voffA); PG8_STAGE(PG8_SA(0, 1), cA + hstepA, voffA);
        if (wr == 1) PG8_BAR;
        PG8_WAIT_V(2); PG8_BAR;
        PG8_STAGE(PG8_SB(1, 0), cB + kstep, voffB); PG8_STAGE(PG8_SA(1, 0), cA + kstep, voffA); PG8_STAGE(PG8_SB(1, 1), cB + hstepB + kstep, voffB);
        PG8_WAIT_V(6); PG8_BAR;
    } else {
        PG8_STAGE(PG8_SB(0, 0), cB, voffB); PG8_STAGE(PG8_SA(0, 0), cA, voffA); PG8_STAGE(PG8_SB(0, 1), cB + hstepB, voffB); PG8_STAGE(PG8_SA(0, 1), cA + hstepA, voffA);
        if (wr == 1) PG8_BAR;
        PG8_WAIT_V(4); PG8_BAR;
        PG8_STAGE(PG8_SB(1, 0), cB + kstep, voffB); PG8_STAGE(PG8_SA(1, 0), cA + kstep, voffA); PG8_STAGE(PG8_SB(1, 1), cB + hstepB + kstep, voffB);
        PG8_WAIT_V(6); PG8_BAR;
    }
    for (;;) {
        const bool has_next = S.next(ui + 1, nxt);
        const char* nA = has_next ? (const char*)g.A + (size_t)nxt.pm * tstepA : cA; const char* nB = has_next ? (const char*)g.Bt + (size_t)nxt.pn * tstepB : cB;
        for (int t = 0; t < nt; t += 2) {
            const bool last = (t == nt - 2);
            const char* a1 = cA + (size_t)(t + 1) * kstep;
            const char* a2 = last ? nA : cA + (size_t)(t + 2) * kstep; const char* b2 = last ? nB : cB + (size_t)(t + 2) * kstep;
            const char* a3 = a2 + kstep; const char* b3 = b2 + kstep;
            if (last && has_next) S.a_ready(nxt);
            if constexpr (SP2) {
            PG8_LDB(B0, 0, 0); PG8_LDB(B1, 0, 1); PG8_SCHED; PG8_LDA(At, 0, 0); PG8_STAGE(PG8_SA(1, 1), a1 + hstepA, voffA);
            PG8_WAIT_V(8); PG8_WAIT_L(0); PG8_BAR; PG8_MMA(0, 0, At, B0); PG8_MMA(0, 1, At, B1); PG8_BAR; PG8_SCHED;
            PG8_LDA(At, 0, 1); PG8_STAGE(PG8_SB(0, 0), b2, voffB); PG8_STAGE(PG8_SB(0, 1), b2 + hstepB, voffB); PG8_STAGE(PG8_SA(0, 0), a2, voffA);
            PG8_WAIT_V(8); PG8_WAIT_L(0); PG8_BAR; PG8_MMA(1, 0, At, B0); PG8_MMA(1, 1, At, B1); PG8_BAR; PG8_SCHED;
            PG8_LDB(B0, 1, 0); PG8_LDB(B1, 1, 1); PG8_SCHED; PG8_LDA(At, 1, 0); PG8_STAGE(PG8_SA(0, 1), a2 + hstepA, voffA);
            PG8_WAIT_V(8); PG8_WAIT_L(0); PG8_BAR; PG8_MMA(0, 0, At, B0); PG8_MMA(0, 1, At, B1); PG8_BAR; PG8_SCHED;
            PG8_LDA(At, 1, 1); PG8_STAGE(PG8_SB(1, 0), b3, voffB); PG8_STAGE(PG8_SB(1, 1), b3 + hstepB, voffB); PG8_STAGE(PG8_SA(1, 0), a3, voffA);
            PG8_WAIT_V(8); PG8_WAIT_L(0); PG8_BAR; PG8_MMA(1, 0, At, B0); PG8_MMA(1, 1, At, B1); PG8_BAR; PG8_SCHED;
            } else {
            PG8_LDB(B0, 0, 0); PG8_SCHED; PG8_LDA(At, 0, 0); PG8_STAGE(PG8_SA(1, 1), a1 + hstepA, voffA);
            PG8_WAIT_L(8); PG8_BAR; PG8_WAIT_L(0); PG8_MMA(0, 0, At, B0); PG8_BAR; PG8_SCHED;
            PG8_LDB(B1, 0, 1); PG8_STAGE(PG8_SB(0, 0), b2, voffB);
            PG8_BAR; PG8_WAIT_L(0); PG8_MMA(0, 1, At, B1); PG8_BAR;
            PG8_LDA(At, 0, 1); PG8_STAGE(PG8_SA(0, 0), a2, voffA);
            PG8_BAR; PG8_WAIT_L(0); PG8_MMA(1, 0, At, B0); PG8_BAR; PG8_SCHED;
            PG8_STAGE(PG8_SB(0, 1), b2 + hstepB, voffB);
            PG8_WAIT_V(6); PG8_BAR; PG8_MMA(1, 1, At, B1); PG8_BAR;
            PG8_LDB(B0, 1, 0); PG8_SCHED; PG8_LDA(At, 1, 0); PG8_STAGE(PG8_SA(0, 1), a2 + hstepA, voffA);
            PG8_WAIT_L(8); PG8_BAR; PG8_WAIT_L(0); PG8_MMA(0, 0, At, B0); PG8_BAR; PG8_SCHED;
            PG8_LDB(B1, 1, 1); PG8_STAGE(PG8_SB(1, 0), b3, voffB);
            PG8_BAR; PG8_WAIT_L(0); PG8_MMA(0, 1, At, B1); PG8_BAR;
            PG8_LDA(At, 1, 1); PG8_STAGE(PG8_SA(1, 0), a3, voffA);
            PG8_BAR; PG8_WAIT_L(0); PG8_MMA(1, 0, At, B0); PG8_BAR; PG8_SCHED;
            PG8_STAGE(PG8_SB(1, 1), b3 + hstepB, voffB);
            PG8_WAIT_V(6); PG8_BAR; PG8_MMA(1, 1, At, B1); PG8_BAR;
            }
        }
        if constexpr (ALIGN_EPI) { if (wr == 0) PG8_BAR; }
        if constexpr (!Epi::AFTER_DRAIN) { E(acc, cur, wr, wc, fr, fq); S.done(cur); }
        if (!has_next) break;
#pragma unroll
        for (int a = 0; a < 2; ++a)
#pragma unroll
            for (int b = 0; b < 2; ++b)
#pragma unroll
                for (int m = 0; m < 4; ++m)
#pragma unroll
                    for (int n = 0; n < 2; ++n) acc[a][b][m][n] = (f32x4){zz_, zz_, zz_, zz_};
        cur = nxt; cA = nA; cB = nB; ++ui;
        if constexpr (ALIGN_EPI) { if (wr == 1) PG8_BAR; }
    }
    PG8_WAIT_V(0);
    if constexpr (!ALIGN_EPI) { if (wr == 0) PG8_BAR; }
    PG8_BAR;
    if constexpr (Epi::AFTER_DRAIN) { E.fused(acc, cur, wr, wc, fr, fq, lds, wid, lane); S.done(cur); }
#undef PG8_SA
#undef PG8_SB
#undef PG8_STAGE
#undef PG8_LDA
#undef PG8_LDB
#undef PG8_MMA
#undef PG8_WAIT_V
#undef PG8_WAIT_L
#undef PG8_BAR
#undef PG8_SCHED
}
}
#define XB_TMO      128
#define XB_XCNT(j)  (256  + 64 * (j))
#define XB_XSUB(j)  (1280 + 64 * (j))
#define XB_XGEN(j)  (2304 + 64 * (j))
#define XB_TOP      3328
#define XB_TOPGEN   3392
#define XCD_BAR_WORDS 3456
#define XB_SPIN_CAP (1u << 18)

__device__ __forceinline__ unsigned xb_ld(unsigned* p)              { return __hip_atomic_load(p, __ATOMIC_RELAXED, __HIP_MEMORY_SCOPE_AGENT); }
__device__ __forceinline__ unsigned xb_add(unsigned* p, unsigned v) { return __hip_atomic_fetch_add(p, v, __ATOMIC_RELAXED, __HIP_MEMORY_SCOPE_AGENT); }
__device__ __forceinline__ unsigned xb_xcc_id() { return (unsigned)__builtin_amdgcn_s_getreg((3 << 11) | 20) & 0xFu; }
#define XB_SPIN(cond, bar) do { unsigned _sp = 0; while (cond) { __builtin_amdgcn_s_sleep(1); \
    if ((++_sp & 255u) == 0u) { if (xb_ld(&(bar)[XB_TMO])) break; if (_sp > XB_SPIN_CAP) { atomicAdd(&(bar)[XB_TMO], 1u); break; } } } } while (0)

struct XcdBarrier {
    unsigned* bar; unsigned x;
    volatile LAS unsigned* st;
};

__device__ __forceinline__ XcdBarrier xcd_barrier_post(unsigned* bar, volatile LAS unsigned* st) {
    XcdBarrier b; b.bar = bar; b.x = xb_xcc_id(); b.st = st;
    if (threadIdx.x == 0) (void)xb_add(&bar[XB_XCNT(b.x)], 1u);
    return b;
}
__device__ __forceinline__ void xcd_barrier_complete(unsigned* bar, unsigned x, unsigned& nloc, unsigned& nx) {
    const unsigned G = gridDim.x * gridDim.y * gridDim.z;
    unsigned sum, cnt, mine, sp = 0u;
    for (;;) {
        sum = 0u; cnt = 0u; mine = 0u;
#pragma unroll
        for (unsigned j = 0; j < 16; ++j) { const unsigned c = xb_ld(&bar[XB_XCNT(j)]); sum += c; cnt += (c > 0u) ? 1u : 0u; mine = (j == x) ? c : mine; }
        if (sum == G) break;
        __builtin_amdgcn_s_sleep(1);
        if ((++sp & 255u) == 0u) { if (xb_ld(&bar[XB_TMO])) break; if (sp > XB_SPIN_CAP) { atomicAdd(&bar[XB_TMO], 1u); break; } }
    }
    nloc = mine > 0u ? mine : 1u; nx = cnt > 0u ? cnt : 1u;
}

__device__ __forceinline__ void xcd_barrier(const XcdBarrier& b) {
    asm volatile("s_waitcnt vmcnt(0)" ::: "memory");
    __syncthreads();
    if (threadIdx.x == 0) {
        unsigned* bar = b.bar;
        __builtin_amdgcn_s_waitcnt(0);
        unsigned nloc = b.st[0], nx = b.st[1];
        if (nloc == 0u) { xcd_barrier_complete(bar, b.x, nloc, nx); b.st[0] = nloc; b.st[1] = nx; }
        const unsigned old = xb_add(&bar[XB_XSUB(b.x)], 1u);
        const unsigned gen = old / nloc;
        if (old + 1u == (gen + 1u) * nloc) {
            __builtin_amdgcn_fence(__ATOMIC_RELEASE, "agent");
            asm volatile("s_waitcnt vmcnt(0)" ::: "memory");
            const unsigned og = xb_add(&bar[XB_TOP], 1u);
            const unsigned tg = og / nx;
            if (og + 1u == (tg + 1u) * nx) xb_add(&bar[XB_TOPGEN], 1u);
            else XB_SPIN(xb_ld(&bar[XB_TOPGEN]) == tg, bar);
            __builtin_amdgcn_fence(__ATOMIC_ACQUIRE, "agent");
            xb_add(&bar[XB_XGEN(b.x)], 1u);
            asm volatile("s_waitcnt vmcnt(0)" ::: "memory");
        } else {
            XB_SPIN(xb_ld(&bar[XB_XGEN(b.x)]) == gen, bar);
            __builtin_amdgcn_fence(__ATOMIC_ACQUIRE, "agent");
            asm volatile("s_waitcnt vmcnt(0)" ::: "memory");
        }
    }
    __syncthreads();
}

namespace pg8 {
typedef unsigned u32x4e __attribute__((ext_vector_type(4)));
typedef int i32x4e __attribute__((ext_vector_type(4)));
__device__ __forceinline__ __amdgpu_buffer_rsrc_t wt_rsrc(const void* base) {
    const unsigned long long b = (unsigned long long)base;
    void* ub = (void*)(((unsigned long long)(unsigned)__builtin_amdgcn_readfirstlane((int)(b >> 32)) << 32) | (unsigned)__builtin_amdgcn_readfirstlane((int)b));
    return __builtin_amdgcn_make_buffer_rsrc(ub, (short)0, (int)0x7ffffff0, 0x00020000); }
__device__ __forceinline__ void st16_wt(__amdgpu_buffer_rsrc_t r, unsigned off, u32x4e w) { __builtin_amdgcn_raw_buffer_store_b128(w, r, (int)off, 0, 16); }
struct EpiPlain {
    static constexpr bool PERM = true, AFTER_DRAIN = false;
    bf16_t* O; int ld;
    __device__ __forceinline__ void operator()(const f32x4 (&acc)[2][2][4][2], const Unit& u, int wr, int wc, int fr, int fq) const {
        bf16_t* base = O + (size_t)(u.pm * BM + wr * 64 + fr) * ld + u.pn * BM + wc * 32 + 8 * fq;
        const bf16_t* wt_base_ = O; const __amdgpu_buffer_rsrc_t wt_r_ = wt_rsrc(wt_base_);
#pragma unroll
        for (int ai = 0; ai < 2; ++ai)
#pragma unroll
            for (int m = 0; m < 4; ++m) { bf16_t* rowp = base + (size_t)(ai * HALF + m * 16) * ld;
#pragma unroll
                for (int bj = 0; bj < 2; ++bj) { const f32x4 v0 = acc[ai][bj][m][0], v1 = acc[ai][bj][m][1];
                    u32x4e w; w.x = cvt_pk_bf16(v0[0], v0[1]); w.y = cvt_pk_bf16(v0[2], v0[3]); w.z = cvt_pk_bf16(v1[0], v1[1]); w.w = cvt_pk_bf16(v1[2], v1[3]);
                    st16_wt(wt_r_, (unsigned)((const char*)(rowp + bj * HALF) - (const char*)wt_base_), w); } }
    }
};
struct EpiProj {
    static constexpr bool PERM = true, AFTER_DRAIN = false;
    bf16_t* ck;
    bf16_t* oq; bf16_t* kv;
    int Mrows;
    __device__ __forceinline__ void operator()(const f32x4 (&acc)[2][2][4][2], const Unit& u, int wr, int wc, int fr, int fq) const {
        const int pn = u.pn; const size_t MS = (size_t)Mrows * 512;
        bf16_t* dst; int ld, c0;
        if (pn < 2)       { dst = oq;            ld = 512; c0 = pn * 256; }
        else if (pn < 4)  { dst = kv;            ld = 512; c0 = (pn - 2) * 256; }
        else if (pn < 6)  { dst = kv + MS;       ld = 512; c0 = (pn - 4) * 256; }
        else if (pn < 8)  { dst = oq + MS;       ld = 512; c0 = (pn - 6) * 256; }
        else if (pn < 11) { dst = kv + 4 * MS;   ld = 768; c0 = (pn - 8) * 256; }
        else if (pn < 13) { dst = oq + 2 * MS;   ld = 512; c0 = (pn - 11) * 256; }
        else if (pn < 15) { dst = kv + 2 * MS;   ld = 512; c0 = (pn - 13) * 256; }
        else if (pn < 17) { dst = kv + 3 * MS;   ld = 512; c0 = (pn - 15) * 256; }
        else              { dst = kv + 4 * MS + (size_t)Mrows * 768; ld = 256; c0 = 0; }
        bf16_t* base = dst + (size_t)(u.pm * BM + wr * 64 + fr) * ld + c0 + wc * 32 + 8 * fq;
        size_t bjs = HALF;
        if (pn == 8) {
            base = ck + ((size_t)(wc >> 1) * Mrows + (size_t)(u.pm * BM + wr * 64 + fr)) * 64 + (wc & 1) * 32 + 8 * fq; ld = 64; bjs = (size_t)2 * Mrows * 64; }
        const bf16_t* wt_base_ = (pn == 8 ? ck : dst); const __amdgpu_buffer_rsrc_t wt_r_ = wt_rsrc(wt_base_);
#pragma unroll
        for (int ai = 0; ai < 2; ++ai)
#pragma unroll
            for (int m = 0; m < 4; ++m) { bf16_t* rowp = base + (size_t)(ai * HALF + m * 16) * ld;
#pragma unroll
                for (int bj = 0; bj < 2; ++bj) { const f32x4 v0 = acc[ai][bj][m][0], v1 = acc[ai][bj][m][1];
                    u32x4e w; w.x = cvt_pk_bf16(v0[0], v0[1]); w.y = cvt_pk_bf16(v0[2], v0[3]); w.z = cvt_pk_bf16(v1[0], v1[1]); w.w = cvt_pk_bf16(v1[2], v1[3]);
                    st16_wt(wt_r_, (unsigned)((const char*)(rowp + bj * bjs) - (const char*)wt_base_), w); } }
    }
};
__device__ __forceinline__ float sigmoidf_(float x) { return __builtin_amdgcn_rcpf(1.0f + __expf(-x)); }
struct EpiSigmoid {
    static constexpr bool PERM = true, AFTER_DRAIN = false;
    bf16_t* O; int ld;
    __device__ __forceinline__ void operator()(const f32x4 (&acc)[2][2][4][2], const Unit& u, int wr, int wc, int fr, int fq) const {
        bf16_t* base = O + (size_t)(u.pm * BM + wr * 64 + fr) * ld + u.pn * BM + wc * 32 + 8 * fq;
#pragma unroll
        for (int ai = 0; ai < 2; ++ai)
#pragma unroll
            for (int m = 0; m < 4; ++m) { bf16_t* rowp = base + (size_t)(ai * HALF + m * 16) * ld;
#pragma unroll
                for (int bj = 0; bj < 2; ++bj) { f32x4 v0 = acc[ai][bj][m][0], v1 = acc[ai][bj][m][1];
#pragma unroll
                    for (int e = 0; e < 4; ++e) { v0[e] = sigmoidf_(v0[e]); v1[e] = sigmoidf_(v1[e]); }
                    u32x4e w; w.x = cvt_pk_bf16(v0[0], v0[1]); w.y = cvt_pk_bf16(v0[2], v0[3]); w.z = cvt_pk_bf16(v1[0], v1[1]); w.w = cvt_pk_bf16(v1[2], v1[3]);
                    *(u32x4e*)(rowp + bj * HALF) = w; } }
    }
};
struct EpiGateY {
    static constexpr bool PERM = true, AFTER_DRAIN = false;
    const bf16_t* MG; bf16_t* Y; bool dry;
    __device__ __forceinline__ void operator()(const f32x4 (&acc)[2][2][4][2], const Unit& u, int wr, int wc, int fr, int fq) const {
        const int branch = u.pm >> 6, pmr = u.pm & 63, pnr = u.pn & 3;
        const size_t r0 = (size_t)(pmr * BM + wr * 64 + fr); const int c0 = pnr * BM + wc * 32 + 8 * fq;
#pragma unroll
        for (int ai = 0; ai < 2; ++ai)
#pragma unroll
            for (int m = 0; m < 4; ++m) { const size_t row = r0 + ai * HALF + m * 16;
#pragma unroll
                for (int bj = 0; bj < 2; ++bj) { const f32x4 v0 = acc[ai][bj][m][0], v1 = acc[ai][bj][m][1];
                    const u32x4e g = *(const u32x4e*)(MG + row * 3072 + branch * 1024 + c0 + bj * HALF);
                    bf16_t* yp = Y + row * 1024 + c0 + bj * HALF;
                    float y[8];
                    y[0] = v0[0] * __uint_as_float(g.x << 16); y[1] = v0[1] * __uint_as_float(g.x & 0xffff0000u); y[2] = v0[2] * __uint_as_float(g.y << 16); y[3] = v0[3] * __uint_as_float(g.y & 0xffff0000u);
                    y[4] = v1[0] * __uint_as_float(g.z << 16); y[5] = v1[1] * __uint_as_float(g.z & 0xffff0000u); y[6] = v1[2] * __uint_as_float(g.w << 16); y[7] = v1[3] * __uint_as_float(g.w & 0xffff0000u);
                    if (branch != 0) { const u32x4e p = *(const u32x4e*)yp;
                        y[0] += __uint_as_float(p.x << 16); y[1] += __uint_as_float(p.x & 0xffff0000u); y[2] += __uint_as_float(p.y << 16); y[3] += __uint_as_float(p.y & 0xffff0000u);
                        y[4] += __uint_as_float(p.z << 16); y[5] += __uint_as_float(p.z & 0xffff0000u); y[6] += __uint_as_float(p.w << 16); y[7] += __uint_as_float(p.w & 0xffff0000u); }
                    u32x4e w; w.x = cvt_pk_bf16(y[0], y[1]); w.y = cvt_pk_bf16(y[2], y[3]); w.z = cvt_pk_bf16(y[4], y[5]); w.w = cvt_pk_bf16(y[6], y[7]);
                    if (!dry) *(u32x4e*)yp = w; } }
    }
};
struct EpiUpU {
    static constexpr bool PERM = true, AFTER_DRAIN = false;
    bf16_t* U;
    __device__ __forceinline__ void operator()(const f32x4 (&acc)[2][2][4][2], const Unit& u, int wr, int wc, int fr, int fq) const {
        const int pmr = u.pm & 63;
        bf16_t* base = U + (size_t)(pmr * BM + wr * 64 + fr) * 3072 + u.pn * BM + wc * 32 + 8 * fq;
        const bf16_t* wt_base_ = U; const __amdgpu_buffer_rsrc_t wt_r_ = wt_rsrc(wt_base_);
#pragma unroll
        for (int ai = 0; ai < 2; ++ai)
#pragma unroll
            for (int m = 0; m < 4; ++m) { bf16_t* rowp = base + (size_t)(ai * HALF + m * 16) * 3072;
#pragma unroll
                for (int bj = 0; bj < 2; ++bj) { const f32x4 v0 = acc[ai][bj][m][0], v1 = acc[ai][bj][m][1];
                    u32x4e w; w.x = cvt_pk_bf16(v0[0], v0[1]); w.y = cvt_pk_bf16(v0[2], v0[3]); w.z = cvt_pk_bf16(v1[0], v1[1]); w.w = cvt_pk_bf16(v1[2], v1[3]);
                    st16_wt(wt_r_, (unsigned)((const char*)(rowp + bj * HALF) - (const char*)wt_base_), w); } }
    }
};
struct EpiGateY2 {
    static constexpr bool PERM = true, AFTER_DRAIN = false;
    const bf16_t* U; bf16_t* Y; bool dry;
    __device__ __forceinline__ void operator()(const f32x4 (&acc)[2][2][4][2], const Unit& u, int wr, int wc, int fr, int fq) const {
        const int branch = u.pn >> 2, pnr = u.pn & 3;
        const size_t r0 = (size_t)(u.pm * BM + wr * 64 + fr); const int c0 = pnr * BM + wc * 32 + 8 * fq;
        const __amdgpu_buffer_rsrc_t yr_ = wt_rsrc(Y);
#pragma unroll
        for (int ai = 0; ai < 2; ++ai)
#pragma unroll
            for (int m = 0; m < 4; ++m) { const size_t row = r0 + ai * HALF + m * 16;
#pragma unroll
                for (int bj = 0; bj < 2; ++bj) { const f32x4 v0 = acc[ai][bj][m][0], v1 = acc[ai][bj][m][1];
                    const u32x4e g = __builtin_nontemporal_load((const u32x4e*)(U + row * 3072 + branch * 1024 + c0 + bj * HALF));
                    bf16_t* yp = Y + row * 1024 + c0 + bj * HALF;
                    float y[8];
                    y[0] = sigmoidf_(v0[0]) * __uint_as_float(g.x << 16); y[1] = sigmoidf_(v0[1]) * __uint_as_float(g.x & 0xffff0000u); y[2] = sigmoidf_(v0[2]) * __uint_as_float(g.y << 16); y[3] = sigmoidf_(v0[3]) * __uint_as_float(g.y & 0xffff0000u);
                    y[4] = sigmoidf_(v1[0]) * __uint_as_float(g.z << 16); y[5] = sigmoidf_(v1[1]) * __uint_as_float(g.z & 0xffff0000u); y[6] = sigmoidf_(v1[2]) * __uint_as_float(g.w << 16); y[7] = sigmoidf_(v1[3]) * __uint_as_float(g.w & 0xffff0000u);
                    if (branch != 0) { const u32x4e p = *(const u32x4e*)yp;
                        y[0] += __uint_as_float(p.x << 16); y[1] += __uint_as_float(p.x & 0xffff0000u); y[2] += __uint_as_float(p.y << 16); y[3] += __uint_as_float(p.y & 0xffff0000u);
                        y[4] += __uint_as_float(p.z << 16); y[5] += __uint_as_float(p.z & 0xffff0000u); y[6] += __uint_as_float(p.w << 16); y[7] += __uint_as_float(p.w & 0xffff0000u); }
                    u32x4e w; w.x = cvt_pk_bf16(y[0], y[1]); w.y = cvt_pk_bf16(y[2], y[3]); w.z = cvt_pk_bf16(y[4], y[5]); w.w = cvt_pk_bf16(y[6], y[7]);
                    if (!dry) st16_wt(yr_, (unsigned)((const char*)yp - (const char*)Y), w); } }
    }
};
struct MergeOrder {
    StaticOrder so; int G, c;
    __host__ __device__ void init(int M_, int G_, int c_) { so.init(M_, 1024, 256, 0); G = G_; c = c_; }
    __host__ __device__ bool next(int i, Unit& u) const {
        const int tile = c + (i / 3) * G, branch = i % 3; if (tile >= 256) return false;
        StaticOrder t = so; t.c = tile; Unit v; t.next(0, v);
        u.pm = v.pm; u.pn = branch * 4 + v.pn; return true;
    }
    __device__ __forceinline__ void a_ready(const Unit&) const {}
    __device__ __forceinline__ void done(const Unit&) const {}
};
struct EpiSwiglu {
    static constexpr bool PERM = true, AFTER_DRAIN = false;
    bf16_t* O; int ld;
    __device__ __forceinline__ void operator()(const f32x4 (&acc)[2][2][4][2], const Unit& u, int wr, int wc, int fr, int fq) const {
        bf16_t* base = O + (size_t)(u.pm * BM + wr * 64 + fr) * ld + u.pn * HALF + wc * 32 + 8 * fq;
        const bf16_t* wt_base_ = O; const __amdgpu_buffer_rsrc_t wt_r_ = wt_rsrc(wt_base_);
#pragma unroll
        for (int ai = 0; ai < 2; ++ai)
#pragma unroll
            for (int m = 0; m < 4; ++m) { bf16_t* rowp = base + (size_t)(ai * HALF + m * 16) * ld;
                f32x4 v0 = acc[ai][0][m][0], v1 = acc[ai][0][m][1]; const f32x4 u0 = acc[ai][1][m][0], u1 = acc[ai][1][m][1];
#pragma unroll
                for (int e = 0; e < 4; ++e) { v0[e] = v0[e] * sigmoidf_(v0[e]) * u0[e]; v1[e] = v1[e] * sigmoidf_(v1[e]) * u1[e]; }
                u32x4e w; w.x = cvt_pk_bf16(v0[0], v0[1]); w.y = cvt_pk_bf16(v0[2], v0[3]); w.z = cvt_pk_bf16(v1[0], v1[1]); w.w = cvt_pk_bf16(v1[2], v1[3]);
                st16_wt(wt_r_, (unsigned)((const char*)rowp - (const char*)wt_base_), w); }
    }
};
struct UpOrder {
    StaticOrder so; int G, c;
    __host__ __device__ void init(int M_, int G_, int c_) { so.init(M_, 1024, 256, 0); G = G_; c = c_; }
    __host__ __device__ bool next(int i, Unit& u) const {
        const int tile = c + (i / 3) * G, branch = i % 3; if (tile >= 256) return false;
        StaticOrder t = so; t.c = tile; Unit v; t.next(0, v);
        u.pm = branch * 64 + v.pm; u.pn = branch * 4 + v.pn; return true;
    }
    __device__ __forceinline__ void a_ready(const Unit&) const {}
    __device__ __forceinline__ void done(const Unit&) const {}
};
}

constexpr int NB = 8, SEQ = 2048, DM = 1024, M = NB * SEQ;
constexpr int NMEM = 256, MMEM = NB * NMEM;
constexpr int DFF = 2816, DIN = 7456, NA = 4608;
constexpr float RMS_EPS = 1e-6f;
constexpr int NWAVES = 8, NTHREADS = 512;

constexpr size_t MiB = 1u << 20;
constexpr size_t WS_CTL = 0, CTL_ZERO_BYTES = 64 * 1024;
constexpr size_t WS_W = 1 * MiB;
constexpr size_t W_A = WS_W, W_M = W_A + (size_t)NA * 1024 * 2, W_C1K = W_M + 3072ull * 1024 * 2, W_C1V = W_C1K + 512ull * 1024 * 2,
                 W_UP = W_C1V + 512ull * 1024 * 2, W_OUT3 = W_UP + 3072ull * 512 * 2, W_MQ = W_OUT3 + 1024ull * 3072 * 2, W_MKV = W_MQ + 256ull * 1024 * 2,
                 W_MO = W_MKV + 512ull * 1024 * 2, W_GU = W_MO + 1024ull * 256 * 2, W_DN = W_GU + 5632ull * 1024 * 2, W_B1PART = W_DN + 1024ull * 2816 * 2,
                 W_END = W_B1PART + 2ull * 32 * 256 * 4;
constexpr size_t WS_H = 47 * MiB;
constexpr size_t WS_OQ = 79 * MiB;
constexpr size_t WS_KV = 127 * MiB;
constexpr size_t WS_MG = WS_KV;
constexpr size_t WS_ACT = WS_OQ;
constexpr size_t WS_MQ = WS_OQ, WS_MO = WS_OQ + 32 * MiB;
constexpr size_t WS_MISC = 223 * MiB;
constexpr size_t WS_CF = WS_MISC;
constexpr size_t WS_KCMP = WS_CF + 512 * 1024, WS_VCMP = WS_KCMP + 256 * 1024, WS_SELM = WS_VCMP + 256 * 1024;
constexpr size_t WS_MEMN = WS_MISC + 3 * MiB / 2;
constexpr size_t WS_MEMKV = WS_MEMN + 4 * MiB;
constexpr size_t WS_PSLC = WS_MEMKV + 2 * MiB;
constexpr size_t WS_OCMP = WS_PSLC + 4 * MiB;
constexpr size_t WS_CK = WS_OCMP, WS_CV = WS_CK + 4 * MiB, WS_PK = WS_CV + 4 * MiB, WS_PV = WS_PK + 2 * MiB;
constexpr size_t WS_END = WS_OCMP + 16 * MiB;
static_assert(W_END <= WS_H && WS_H + 32 * MiB == WS_OQ && WS_OQ + 48 * MiB == WS_KV && WS_KV + 96 * MiB == WS_MISC && WS_END <= 256 * MiB && WS_PV + 2 * MiB <= WS_END, "ws map");
constexpr int CW_BAR = 4096, CW_SB = 8192, CW_CVB = 8192 + 32 * 64;

typedef unsigned short bf16;
typedef float f32x4 __attribute__((ext_vector_type(4)));
typedef unsigned u32x4 __attribute__((ext_vector_type(4)));
typedef unsigned u32x2 __attribute__((ext_vector_type(2)));

__device__ __forceinline__ float bf2f(unsigned short b) { return __uint_as_float((unsigned)b << 16); }
__device__ __forceinline__ unsigned pk2(float lo, float hi) { return pg8::cvt_pk_bf16(lo, hi); }
__device__ __forceinline__ unsigned short f2bf(float f) { return (unsigned short)(pk2(f, 0.f) & 0xffffu); }
__device__ __forceinline__ float wave_sum(float v) {
#pragma unroll
    for (int o = 1; o < 64; o <<= 1) v += __shfl_xor(v, o);
    return v;
}
__device__ __forceinline__ float sigm(float x) { return __builtin_amdgcn_rcpf(1.0f + __expf(-x)); }
__device__ __forceinline__ float logsig(float x) { return fminf(x, 0.f) - log1pf(__expf(-fabsf(x))); }

struct Args { const void* in[31]; float* out; unsigned char* ws; int ph_lo, ph_hi; };

struct MapOff { int off; float s; __device__ __forceinline__ int row(int n) const { return n + off; } __device__ __forceinline__ float sc(int) const { return s; } };
struct MapA {
    __device__ __forceinline__ int row(int n) const { return n < 2816 ? n : (n < 2840 ? n + 1536 : (n < 4376 ? n - 24 : n)); }
    __device__ __forceinline__ float sc(int n) const { return (n < 512 || (n >= 1536 && n < 2048) || (n >= 2840 && n < 3352)) ? 0.125f : 1.0f; }
};
struct MapGU { int half; __device__ __forceinline__ int row(int n) const { return (n >> 7) * 256 + half * 128 + (n & 127); } __device__ __forceinline__ float sc(int) const { return 1.0f; } };

template <class Map>
__device__ __forceinline__ void conv_item(const float* W, int N, int ldw, bf16* WT, int ldt, int dk0, const Map map, LAS float* scr, int it, int lane) {
    const int nblk = N / 32, kb = it / nblk, nb = it % nblk, k0 = 64 * kb, n0 = 32 * nb;
    const float* src = W + (size_t)(k0 + (lane >> 3)) * ldw + n0 + 4 * (lane & 7);
    f32x4 v[8];
#pragma unroll
    for (int i = 0; i < 8; ++i) v[i] = *(const f32x4*)(src + (size_t)(8 * i) * ldw);
#pragma unroll
    for (int i = 0; i < 8; ++i) { LAS float* d = scr + (8 * i + (lane >> 3)) * 33 + 4 * (lane & 7); d[0] = v[i].x; d[1] = v[i].y; d[2] = v[i].z; d[3] = v[i].w; }
    asm volatile("s_waitcnt lgkmcnt(0)" ::: "memory");
    const int c = lane & 7;
#pragma unroll
    for (int j = 0; j < 4; ++j) { const int n = (lane >> 3) + 8 * j; const LAS float* s = scr + (8 * c) * 33 + n; const float sc = map.sc(n0 + n);
        u32x4 o; o.x = pk2(s[0 * 33] * sc, s[1 * 33] * sc); o.y = pk2(s[2 * 33] * sc, s[3 * 33] * sc); o.z = pk2(s[4 * 33] * sc, s[5 * 33] * sc); o.w = pk2(s[6 * 33] * sc, s[7 * 33] * sc);
        *(u32x4*)(WT + (size_t)map.row(n0 + n) * ldt + dk0 + k0 + 8 * c) = o; }
    asm volatile("s_waitcnt lgkmcnt(0)" ::: "memory");
}

__device__ __forceinline__ void norm_row_to_bf16(const float* xrow, const float* g, bf16* hrow, int lane) {
    const f32x4* xr = (const f32x4*)xrow + lane; const f32x4* gr = (const f32x4*)g + lane;
    f32x4 v[4]; float s = 0.f;
#pragma unroll
    for (int j = 0; j < 4; ++j) { v[j] = xr[64 * j]; s += (v[j].x * v[j].x + v[j].y * v[j].y) + (v[j].z * v[j].z + v[j].w * v[j].w); }
    const float rstd = __builtin_amdgcn_rsqf(wave_sum(s) * (1.f / DM) + RMS_EPS);
    u32x2* o8 = (u32x2*)hrow + lane;
#pragma unroll
    for (int j = 0; j < 4; ++j) { const f32x4 gg = gr[64 * j]; u32x2 w; w.x = pk2(v[j].x * rstd * gg.x, v[j].y * rstd * gg.y); w.y = pk2(v[j].z * rstd * gg.z, v[j].w * rstd * gg.w); o8[64 * j] = w; }
}
__device__ __forceinline__ void post_norm_row(const bf16* yrow, const float* xs, float* xd, const float* gpost, const float* gpre, bf16* hrow, bool write_h, bool dry, int lane) {
    const u32x2* yr = (const u32x2*)yrow + lane; const f32x4* xr = (const f32x4*)xs + lane;
    f32x4 y[4], x[4]; float s = 0.f;
#pragma unroll
    for (int j = 0; j < 4; ++j) { const u32x2 w = yr[64 * j]; y[j].x = __uint_as_float(w.x << 16); y[j].y = __uint_as_float(w.x & 0xffff0000u); y[j].z = __uint_as_float(w.y << 16); y[j].w = __uint_as_float(w.y & 0xffff0000u);
        x[j] = xr[64 * j]; s += (y[j].x * y[j].x + y[j].y * y[j].y) + (y[j].z * y[j].z + y[j].w * y[j].w); }
    const float rstd = __builtin_amdgcn_rsqf(wave_sum(s) * (1.f / DM) + RMS_EPS);
    float s2 = 0.f;
#pragma unroll
    for (int j = 0; j < 4; ++j) { const f32x4 gg = ((const f32x4*)gpost + lane)[64 * j];
        x[j].x += y[j].x * rstd * gg.x; x[j].y += y[j].y * rstd * gg.y; x[j].z += y[j].z * rstd * gg.z; x[j].w += y[j].w * rstd * gg.w;
        if (!dry) ((f32x4*)xd + lane)[64 * j] = x[j]; s2 += (x[j].x * x[j].x + x[j].y * x[j].y) + (x[j].z * x[j].z + x[j].w * x[j].w); }
    if (write_h && !dry) {
        const float r2 = __builtin_amdgcn_rsqf(wave_sum(s2) * (1.f / DM) + RMS_EPS);
        u32x2* o8 = (u32x2*)hrow + lane;
#pragma unroll
        for (int j = 0; j < 4; ++j) { const f32x4 gg = ((const f32x4*)gpre + lane)[64 * j]; u32x2 w; w.x = pk2(x[j].x * r2 * gg.x, x[j].y * r2 * gg.y); w.y = pk2(x[j].z * r2 * gg.z, x[j].w * r2 * gg.w); o8[64 * j] = w; }
    }
}

__device__ __forceinline__ void post_norm_rows2(const bf16* y0, const bf16* y1, const float* xs0, const float* xs1, float* xd0, float* xd1, const float* gpost, const float* gpre, bf16* h0, bf16* h1, bool write_h, bool dry, int lane) {
    f32x4 y[2][4], x[2][4], gp[4]; u32x2 w[2][4];
#pragma unroll
    for (int j = 0; j < 4; ++j) { w[0][j] = __builtin_nontemporal_load((const u32x2*)y0 + lane + 64 * j); w[1][j] = __builtin_nontemporal_load((const u32x2*)y1 + lane + 64 * j); }
#pragma unroll
    for (int j = 0; j < 4; ++j) { x[0][j] = __builtin_nontemporal_load((const f32x4*)xs0 + lane + 64 * j); x[1][j] = __builtin_nontemporal_load((const f32x4*)xs1 + lane + 64 * j); gp[j] = ((const f32x4*)gpost + lane)[64 * j]; }
    float s[2] = {0.f, 0.f};
#pragma unroll
    for (int q = 0; q < 2; ++q)
#pragma unroll
        for (int j = 0; j < 4; ++j) { y[q][j].x = __uint_as_float(w[q][j].x << 16); y[q][j].y = __uint_as_float(w[q][j].x & 0xffff0000u); y[q][j].z = __uint_as_float(w[q][j].y << 16); y[q][j].w = __uint_as_float(w[q][j].y & 0xffff0000u);
            s[q] += (y[q][j].x * y[q][j].x + y[q][j].y * y[q][j].y) + (y[q][j].z * y[q][j].z + y[q][j].w * y[q][j].w); }
#pragma unroll
    for (int o = 1; o < 64; o <<= 1) { s[0] += __shfl_xor(s[0], o); s[1] += __shfl_xor(s[1], o); }
    float s2[2] = {0.f, 0.f};
#pragma unroll
    for (int q = 0; q < 2; ++q) { const float rstd = __builtin_amdgcn_rsqf(s[q] * (1.f / DM) + RMS_EPS); float* xd = q ? xd1 : xd0;
#pragma unroll
        for (int j = 0; j < 4; ++j) {
            x[q][j].x += y[q][j].x * rstd * gp[j].x; x[q][j].y += y[q][j].y * rstd * gp[j].y; x[q][j].z += y[q][j].z * rstd * gp[j].z; x[q][j].w += y[q][j].w * rstd * gp[j].w;
            if (!dry) __builtin_nontemporal_store(x[q][j], (f32x4*)xd + lane + 64 * j); s2[q] += (x[q][j].x * x[q][j].x + x[q][j].y * x[q][j].y) + (x[q][j].z * x[q][j].z + x[q][j].w * x[q][j].w); } }
    if (write_h && !dry) {
#pragma unroll
        for (int o = 1; o < 64; o <<= 1) { s2[0] += __shfl_xor(s2[0], o); s2[1] += __shfl_xor(s2[1], o); }
#pragma unroll
        for (int j = 0; j < 4; ++j) gp[j] = ((const f32x4*)gpre + lane)[64 * j];
#pragma unroll
        for (int q = 0; q < 2; ++q) { const float r2 = __builtin_amdgcn_rsqf(s2[q] * (1.f / DM) + RMS_EPS); const __amdgpu_buffer_rsrc_t hr_ = pg8::wt_rsrc(q ? h1 : h0);
#pragma unroll
            for (int j = 0; j < 4; ++j) { u32x2 ww; ww.x = pk2(x[q][j].x * r2 * gp[j].x, x[q][j].y * r2 * gp[j].y); ww.y = pk2(x[q][j].z * r2 * gp[j].z, x[q][j].w * r2 * gp[j].w); __builtin_amdgcn_raw_buffer_store_b64(ww, hr_, (lane + 64 * j) * 8, 0, 16); } }
    }
}

__device__ __forceinline__ void rope_cs(int pos, int i, float& c, float& s) {
    float hi, lo;
    switch (i) { case 0: hi = 0.1591796875f; lo = -2.474440771038644e-05f; break; case 1: hi = 0.0308685302734375f; lo = -4.76686864203657e-06f; break;
                 case 2: hi = 0.005985260009765625f; lo = -7.429704851347196e-08f; break; case 3: hi = 0.0011606216430664062f; lo = 4.1998173827551e-08f; break;
                 case 4: hi = 0.000225067138671875f; lo = 1.1940367805607366e-08f; break; case 5: hi = 4.366040229797363e-05f; lo = -1.2449505426559426e-08f; break;
                 case 6: hi = 8.463859558105469e-06f; lo = 4.712501500137023e-10f; break; default: hi = 1.6409903764724731e-06f; lo = 4.3588632703261965e-10f; break; }
    const float fp = (float)pos, p = fp * hi, fr = (p - rintf(p)) + fp * lo;
    c = __builtin_amdgcn_cosf(fr); s = __builtin_amdgcn_sinf(fr);
}

typedef __attribute__((address_space(4))) const unsigned char* kptr_t;
struct KA {
    kptr_t kp;
    __device__ __forceinline__ void refresh() { kp = (kptr_t)__builtin_amdgcn_kernarg_segment_ptr(); asm volatile("" : "+s"(kp)); }
    __device__ __forceinline__ const void* in(int i) const { return (const void*)(const GAS void*)(*(const __attribute__((address_space(4))) unsigned long long*)(kp + 8 * i)); }
    __device__ __forceinline__ float* out() const { return (float*)(GAS float*)(*(const __attribute__((address_space(4))) unsigned long long*)(kp + 8 * 31)); }
    __device__ __forceinline__ unsigned char* ws() const { return (unsigned char*)(GAS unsigned char*)(*(const __attribute__((address_space(4))) unsigned long long*)(kp + 8 * 32)); }
    __device__ __forceinline__ int ph_lo() const { return *(const __attribute__((address_space(4))) int*)(kp + 8 * 33); }
    __device__ __forceinline__ int ph_hi() const { return *(const __attribute__((address_space(4))) int*)(kp + 8 * 33 + 4); }
};
struct Frame {
    LAS unsigned char* lds;
    int tid, lane, wave, G, bid;
    int gw, ngw;
    int gt, ngt;
};

struct ConvDesc { const float* src; int ldw; bf16* dst; int ldt; int kd; int n0; int kind; int par; float sc; };
#define CVD(Wp, K_, N_, LDW_, DST_, LDT_, DK0_, KIND_, PAR_, SC_) { constexpr int n_ = ((N_) / 32) * ((K_) / 64); if (it < n_) { const int nblk = (N_) / 32, kb = it / nblk, nb = it % nblk; \
    d.src = (Wp) + (size_t)(64 * kb + (lane >> 3)) * (LDW_) + 32 * nb + 4 * (lane & 7); d.ldw = (LDW_); d.dst = (DST_); d.ldt = (LDT_); d.kd = (DK0_) + 64 * kb; d.n0 = 32 * nb; d.kind = (KIND_); d.par = (PAR_); d.sc = (SC_); return; } it -= n_; }
constexpr int N_CONV = 2192 + 1536 + 4 * 128 + 3 * 256 + 512 + 128 + 2 * 128 + 128 + 2 * 1408 + 1408;
__device__ __forceinline__ void conv_decode(ConvDesc& d, const KA& a, unsigned char* ws, int l, int it, int lane) {
    CVD((const float*)a.in(10) + (size_t)l * DM * DIN, DM, 4384, DIN, (bf16*)(ws + W_A), DM, 0, 1, 0, 1.0f)
    CVD((const float*)a.in(10) + (size_t)l * DM * DIN + 4384, DM, 3072, DIN, (bf16*)(ws + W_M), DM, 0, 0, 0, 1.0f)
    CVD((const float*)a.in(13) + (size_t)l * 2048 * 256, 1024, 256, 256, (bf16*)(ws + W_C1K), 1024, 0, 0, 0, 1.0f)
    CVD((const float*)a.in(13) + (size_t)l * 2048 * 256 + 1024 * 256, 1024, 256, 256, (bf16*)(ws + W_C1K), 1024, 0, 0, 256, 1.0f)
    CVD((const float*)a.in(17) + (size_t)l * 2048 * 256, 1024, 256, 256, (bf16*)(ws + W_C1V), 1024, 0, 0, 0, 1.0f)
    CVD((const float*)a.in(17) + (size_t)l * 2048 * 256 + 1024 * 256, 1024, 256, 256, (bf16*)(ws + W_C1V), 1024, 0, 0, 256, 1.0f)
    CVD((const float*)a.in(20) + (size_t)l * 512 * DM, 512, DM, DM, (bf16*)(ws + W_UP), 512, 0, 0, 0, 1.0f)
    CVD((const float*)a.in(21) + (size_t)l * 512 * DM, 512, DM, DM, (bf16*)(ws + W_UP), 512, 0, 0, 1024, 1.0f)
    CVD((const float*)a.in(22) + (size_t)l * 512 * DM, 512, DM, DM, (bf16*)(ws + W_UP), 512, 0, 0, 2048, 1.0f)
    CVD((const float*)a.in(23) + (size_t)l * DM * DM, DM, DM, DM, (bf16*)(ws + W_OUT3), DM, 0, 0, 0, 1.0f)
    CVD((const float*)a.in(24) + (size_t)l * DM * 256, DM, 256, 256, (bf16*)(ws + W_MQ), DM, 0, 0, 0, 0.125f)
    CVD((const float*)a.in(25) + (size_t)l * DM * 256, DM, 256, 256, (bf16*)(ws + W_MKV), DM, 0, 0, 0, 1.0f)
    CVD((const float*)a.in(26) + (size_t)l * DM * 256, DM, 256, 256, (bf16*)(ws + W_MKV), DM, 0, 0, 256, 1.0f)
    CVD((const float*)a.in(27) + (size_t)l * 256 * DM, 256, DM, DM, (bf16*)(ws + W_MO), 256, 0, 0, 0, 1.0f)
    CVD((const float*)a.in(28) + (size_t)l * DM * DFF, DM, DFF, DFF, (bf16*)(ws + W_GU), DM, 0, 2, 0, 1.0f)
    CVD((const float*)a.in(29) + (size_t)l * DM * DFF, DM, DFF, DFF, (bf16*)(ws + W_GU), DM, 0, 2, 1, 1.0f)
    CVD((const float*)a.in(30) + (size_t)l * DFF * DM, DFF, DM, DM, (bf16*)(ws + W_DN), DFF, 0, 0, 0, 1.0f)
}
#undef CVD
__device__ __forceinline__ void conv_load(const ConvDesc& d, f32x4 (&v)[8]) {
#pragma unroll
    for (int i = 0; i < 8; ++i) v[i] = __builtin_nontemporal_load((const f32x4*)(d.src + (size_t)(8 * i) * d.ldw));
}
__device__ __forceinline__ void conv_finish(const ConvDesc& d, const f32x4 (&v)[8], LAS float* scr, int lane) {
#pragma unroll
    for (int i = 0; i < 8; ++i) { LAS float* p = scr + (8 * i + (lane >> 3)) * 33 + 4 * (lane & 7); p[0] = v[i].x; p[1] = v[i].y; p[2] = v[i].z; p[3] = v[i].w; }
    asm volatile("s_waitcnt lgkmcnt(0)" ::: "memory");
    const int c = lane & 7;
#pragma unroll
    for (int j = 0; j < 4; ++j) { const int n = (lane >> 3) + 8 * j, gn = d.n0 + n; const LAS float* s = scr + (8 * c) * 33 + n;
        const int row = d.kind == 0 ? gn + d.par : (d.kind == 1 ? MapA{}.row(gn) : MapGU{d.par}.row(gn));
        const float sc = d.kind == 1 ? MapA{}.sc(gn) : d.sc;
        u32x4 o; o.x = pk2(s[0 * 33] * sc, s[1 * 33] * sc); o.y = pk2(s[2 * 33] * sc, s[3 * 33] * sc); o.z = pk2(s[4 * 33] * sc, s[5 * 33] * sc); o.w = pk2(s[6 * 33] * sc, s[7 * 33] * sc);
        *(u32x4*)(d.dst + (size_t)row * d.ldt + d.kd + 8 * c) = o; }
    asm volatile("s_waitcnt lgkmcnt(0)" ::: "memory");
}
__device__ __forceinline__ void norm_rows4_to_bf16(const float* x0, const float* g, bf16* h0, int lane) {
    f32x4 v[4][4], gg[4]; float s[4] = {0.f, 0.f, 0.f, 0.f};
#pragma unroll
    for (int q = 0; q < 4; ++q)
#pragma unroll
        for (int j = 0; j < 4; ++j) v[q][j] = __builtin_nontemporal_load((const f32x4*)(x0 + (size_t)q * DM) + lane + 64 * j);
#pragma unroll
    for (int j = 0; j < 4; ++j) gg[j] = ((const f32x4*)g + lane)[64 * j];
#pragma unroll
    for (int q = 0; q < 4; ++q)
#pragma unroll
        for (int j = 0; j < 4; ++j) s[q] += (v[q][j].x * v[q][j].x + v[q][j].y * v[q][j].y) + (v[q][j].z * v[q][j].z + v[q][j].w * v[q][j].w);
#pragma unroll
    for (int o = 1; o < 64; o <<= 1) { s[0] += __shfl_xor(s[0], o); s[1] += __shfl_xor(s[1], o); s[2] += __shfl_xor(s[2], o); s[3] += __shfl_xor(s[3], o); }
#pragma unroll
    for (int q = 0; q < 4; ++q) { const float rstd = __builtin_amdgcn_rsqf(s[q] * (1.f / DM) + RMS_EPS); u32x2* o8 = (u32x2*)(h0 + (size_t)q * DM) + lane;
#pragma unroll
        for (int j = 0; j < 4; ++j) { u32x2 w; w.x = pk2(v[q][j].x * rstd * gg[j].x, v[q][j].y * rstd * gg[j].y); w.y = pk2(v[q][j].z * rstd * gg[j].z, v[q][j].w * rstd * gg[j].w); o8[64 * j] = w; } }
}
struct ConvB { const float* src; int ldw; bf16* dst; int ldt; int kd; int n0; int kind; int par; float sc; };
#define CVB(Wp, K_, N_, LDW_, DST_, LDT_, DK0_, KIND_, PAR_, SC_) { constexpr int nb_ = (N_) / 256, n_ = nb_ * ((K_) / 64); if (it < n_) { const int kb = it / nb_, nb = it % nb_; \
    d.src = (Wp) + (size_t)(64 * kb) * (LDW_) + 256 * nb; d.ldw = (LDW_); d.dst = (DST_); d.ldt = (LDT_); d.kd = (DK0_) + 64 * kb; d.n0 = 256 * nb; d.kind = (KIND_); d.par = (PAR_); d.sc = (SC_); return; } it -= n_; }
constexpr int N_CONVB = 16 * 17 + 16 * 12 + 4 * 16 + 3 * 32 + 64 + 16 + 2 * 16 + 16 + 2 * 176 + 176;
constexpr int N_CONVA = N_CONVB - (2 * 176 + 176);
__device__ __forceinline__ void convb_decode(ConvB& d, const KA& a, unsigned char* ws, int l, int it) {
    CVB((const float*)a.in(10) + (size_t)l * DM * DIN, DM, 4352, DIN, (bf16*)(ws + W_A), DM, 0, 1, 0, 1.0f)
    CVB((const float*)a.in(10) + (size_t)l * DM * DIN + 4384, DM, 3072, DIN, (bf16*)(ws + W_M), DM, 0, 0, 0, 1.0f)
    CVB((const float*)a.in(13) + (size_t)l * 2048 * 256, 1024, 256, 256, (bf16*)(ws + W_C1K), 1024, 0, 0, 0, 1.0f)
    CVB((const float*)a.in(13) + (size_t)l * 2048 * 256 + 1024 * 256, 1024, 256, 256, (bf16*)(ws + W_C1K), 1024, 0, 0, 256, 1.0f)
    CVB((const float*)a.in(17) + (size_t)l * 2048 * 256, 1024, 256, 256, (bf16*)(ws + W_C1V), 1024, 0, 0, 0, 1.0f)
    CVB((const float*)a.in(17) + (size_t)l * 2048 * 256 + 1024 * 256, 1024, 256, 256, (bf16*)(ws + W_C1V), 1024, 0, 0, 256, 1.0f)
    CVB((const float*)a.in(20) + (size_t)l * 512 * DM, 512, DM, DM, (bf16*)(ws + W_UP), 512, 0, 0, 0, 1.0f)
    CVB((const float*)a.in(21) + (size_t)l * 512 * DM, 512, DM, DM, (bf16*)(ws + W_UP), 512, 0, 0, 1024, 1.0f)
    CVB((const float*)a.in(22) + (size_t)l * 512 * DM, 512, DM, DM, (bf16*)(ws + W_UP), 512, 0, 0, 2048, 1.0f)
    CVB((const float*)a.in(23) + (size_t)l * DM * DM, DM, DM, DM, (bf16*)(ws + W_OUT3), DM, 0, 0, 0, 1.0f)
    CVB((const float*)a.in(24) + (size_t)l * DM * 256, DM, 256, 256, (bf16*)(ws + W_MQ), DM, 0, 0, 0, 0.125f)
    CVB((const float*)a.in(25) + (size_t)l * DM * 256, DM, 256, 256, (bf16*)(ws + W_MKV), DM, 0, 0, 0, 1.0f)
    CVB((const float*)a.in(26) + (size_t)l * DM * 256, DM, 256, 256, (bf16*)(ws + W_MKV), DM, 0, 0, 256, 1.0f)
    CVB((const float*)a.in(27) + (size_t)l * 256 * DM, 256, DM, DM, (bf16*)(ws + W_MO), 256, 0, 0, 0, 1.0f)
    CVB((const float*)a.in(28) + (size_t)l * DM * DFF, DM, DFF, DFF, (bf16*)(ws + W_GU), DM, 0, 2, 0, 1.0f)
    CVB((const float*)a.in(29) + (size_t)l * DM * DFF, DM, DFF, DFF, (bf16*)(ws + W_GU), DM, 0, 2, 1, 1.0f)
    CVB((const float*)a.in(30) + (size_t)l * DFF * DM, DFF, DM, DM, (bf16*)(ws + W_DN), DFF, 0, 0, 0, 1.0f)
}
#undef CVB
__device__ __forceinline__ void convb_load(const ConvB& d, f32x4 (&v)[8], int wave, int lane) {
#pragma unroll
    for (int i = 0; i < 8; ++i) v[i] = __builtin_nontemporal_load((const f32x4*)(d.src + (size_t)(8 * wave + i) * d.ldw + 4 * lane));
}
__device__ __forceinline__ void convb_finish(const ConvB& d, const f32x4 (&v)[8], LAS float* scr, int tid, int wave, int lane) {
#pragma unroll
    for (int i = 0; i < 8; ++i) { LAS float* p = scr + (8 * wave + i) * 257 + 4 * lane; p[0] = v[i].x; p[1] = v[i].y; p[2] = v[i].z; p[3] = v[i].w; }
    __syncthreads();
#pragma unroll
    for (int j = 0; j < 4; ++j) { const int pc = tid + 512 * j, n = pc >> 3, c = pc & 7, gn = d.n0 + n; const LAS float* s = scr + (8 * c) * 257 + n;
        const int row = d.kind == 0 ? gn + d.par : (d.kind == 1 ? MapA{}.row(gn) : MapGU{d.par}.row(gn));
        const float sc = d.kind == 1 ? MapA{}.sc(gn) : d.sc;
        u32x4 o; o.x = pk2(s[0 * 257] * sc, s[1 * 257] * sc); o.y = pk2(s[2 * 257] * sc, s[3 * 257] * sc); o.z = pk2(s[4 * 257] * sc, s[5 * 257] * sc); o.w = pk2(s[6 * 257] * sc, s[7 * 257] * sc);
        *(u32x4*)(d.dst + (size_t)row * d.ldt + d.kd + 8 * c) = o; }
    __syncthreads();
}
__device__ __forceinline__ void phase_conv(const Frame& F, const KA& a, int l) {
    unsigned char* ws = a.ws();
    const int gw = F.gw, ngw = F.ngw, lane = F.lane;
    {
        LAS float* scr = (LAS float*)F.lds;
        ConvB da, db; f32x4 va[8], vb[8];
        int i0 = F.bid;
        if (i0 < N_CONVA) { convb_decode(da, a, ws, l, i0); convb_load(da, va, F.wave, lane); }
        for (; i0 < N_CONVA; i0 += 2 * F.G) {
            const int i1 = i0 + F.G, i2 = i1 + F.G; const bool h1 = i1 < N_CONVA, h2 = i2 < N_CONVA;
            if (h1) { convb_decode(db, a, ws, l, i1); convb_load(db, vb, F.wave, lane); }
            convb_finish(da, va, scr, F.tid, F.wave, lane);
            if (h2) { convb_decode(da, a, ws, l, i2); convb_load(da, va, F.wave, lane); }
            if (h1) convb_finish(db, vb, scr, F.tid, F.wave, lane);
        }
    }
    {
        LAS float* scr = (LAS float*)(F.lds + F.wave * 16384);
        for (int it = ngw - 1 - gw; it < 16; it += ngw) { ConvDesc d; f32x4 v[8];
            d.src = (const float*)a.in(10) + (size_t)l * DM * DIN + (size_t)(64 * it + (lane >> 3)) * DIN + 4352 + 4 * (lane & 7); d.ldw = DIN; d.dst = (bf16*)(ws + W_A); d.ldt = DM; d.kd = 64 * it; d.n0 = 4352; d.kind = 1; d.par = 0; d.sc = 1.0f;
            conv_load(d, v); conv_finish(d, v, scr, lane); }
    }
    __syncthreads();
    const int n_other = 14 + 64 + 512 + (l == 0 ? 4096 : 0);
    for (int it0 = ngw - 1 - gw; it0 < n_other; it0 += ngw) {
        int it = it0;
        if (it < 14) {
            u32x4* z = (u32x4*)(ws + W_A + (4384ull + 16 * it) * DM * 2) + lane; unsigned zz = 0u; asm volatile("" : "+v"(zz));
#pragma unroll 8
            for (int i = 0; i < 32; ++i) z[64 * i] = (u32x4){zz, zz, zz, zz};
            continue; }
        it -= 14;
        if (it < 64) {
            const int m = it >> 5, s = it & 31;
            const float* pe = (m ? (const float*)a.in(16) : (const float*)a.in(12)) + (size_t)l * 2048 + s * 64;
            const float* w1 = (m ? (const float*)a.in(17) : (const float*)a.in(13)) + (size_t)l * 2048 * 256 + (size_t)(s * 64) * 256;
            const unsigned pev = __float_as_uint(pe[lane]);
            f32x4 acc = (f32x4){0.f, 0.f, 0.f, 0.f}, acc2 = (f32x4){0.f, 0.f, 0.f, 0.f};
#pragma unroll 1
            for (int kb = 0; kb < 64; kb += 16) {
                f32x4 w[16];
#pragma unroll
                for (int i = 0; i < 16; ++i) w[i] = __builtin_nontemporal_load((const f32x4*)(w1 + (size_t)(kb + i) * 256) + lane);
#pragma unroll
                for (int i = 0; i < 16; i += 2) { const float p = __uint_as_float(__builtin_amdgcn_readlane(pev, kb + i)), p2 = __uint_as_float(__builtin_amdgcn_readlane(pev, kb + i + 1));
                    acc.x += p * w[i].x; acc.y += p * w[i].y; acc.z += p * w[i].z; acc.w += p * w[i].w; acc2.x += p2 * w[i + 1].x; acc2.y += p2 * w[i + 1].y; acc2.z += p2 * w[i + 1].z; acc2.w += p2 * w[i + 1].w; }
            }
            acc.x += acc2.x; acc.y += acc2.y; acc.z += acc2.z; acc.w += acc2.w;
            ((f32x4*)((float*)(ws + W_B1PART) + (size_t)(m * 32 + s) * 256))[lane] = acc;
            continue; }
        it -= 64;
        if (it < 512) { norm_rows4_to_bf16((const float*)a.in(1) + (size_t)(4 * it) * DM, (const float*)a.in(6) + (size_t)l * DM, (bf16*)(ws + WS_MEMN) + (size_t)(4 * it) * DM, lane); continue; }
        it -= 512;
        norm_rows4_to_bf16((const float*)a.in(0) + (size_t)(4 * it) * DM, (const float*)a.in(3), (bf16*)(ws + WS_H) + (size_t)(4 * it) * DM, lane);
    }
}

__device__ __forceinline__ void phase_conv_b(const Frame& F, const KA& a, int l) {
    unsigned char* ws = a.ws();
    LAS float* scr = (LAS float*)F.lds;
    LAS unsigned* qslot = (LAS unsigned*)(F.lds + 66048);
    unsigned* ctr = (unsigned*)(ws + WS_CTL) + CW_CVB + 64 * (unsigned)l;
    for (;;) {
        if (F.tid == 0) *qslot = __hip_atomic_fetch_add(ctr, 1u, __ATOMIC_RELAXED, __HIP_MEMORY_SCOPE_AGENT);
        __syncthreads();
        const unsigned k_ = *qslot;
        __syncthreads();
        if (k_ >= (unsigned)(N_CONVB - N_CONVA)) break;
        ConvB d; f32x4 v[8];
        convb_decode(d, a, ws, l, N_CONVA + (int)k_); convb_load(d, v, F.wave, F.lane);
        convb_finish(d, v, scr, F.tid, F.wave, F.lane);
    }
}

__device__ __forceinline__ void phase_post(const Frame& F, const KA& a, int l, bool dry) {
    unsigned char* ws = a.ws();
    bf16* nsakv = (bf16*)(ws + WS_KV + 64 * MiB);
    const bf16* small = (const bf16*)(ws + WS_KV + 88 * MiB);
    const int* pos = (const int*)a.in(2);
    for (int it = F.gt; it < M * 32; it += F.ngt) {
        const int tok = it >> 5, r = it & 31, which = r >> 4, g = (r >> 3) & 1, i = r & 7;
        bf16* p = nsakv + (size_t)tok * 768 + 256 + which * 256 + g * 64 + i;
        float c, s; rope_cs(pos[tok], i, c, s);
        const float x1 = bf2f(p[0]), x2 = bf2f(p[8]);
        if (!dry) { p[0] = f2bf(x1 * c - x2 * s); p[8] = f2bf(x2 * c + x1 * s); }
    }
    if (F.bid >= 64 && F.bid < 128) {
        const int it = F.bid - 64, b = it >> 3, h = it & 7; const float bias = ((const float*)a.in(11))[l * 8 + h];
        const bf16* fp = small + ((size_t)b * SEQ + 4 * F.tid) * 256 + 24 + h;
        float v0 = logsig(bf2f(fp[0]) + bias), v1 = logsig(bf2f(fp[256]) + bias), v2 = logsig(bf2f(fp[512]) + bias), v3 = logsig(bf2f(fp[768]) + bias);
        v1 += v0; v2 += v1; v3 += v2;
        float inc = v3;
#pragma unroll
        for (int o = 1; o < 64; o <<= 1) { const float t = __shfl_up(inc, o); if (F.lane >= o) inc += t; }
        LAS float* wtot = (LAS float*)F.lds;
        if (F.lane == 63) wtot[F.wave] = inc;
        __syncthreads();
        float base = inc - v3;
        for (int w = 0; w < F.wave; ++w) base += wtot[w];
        *(f32x4*)((float*)(ws + WS_CF) + ((size_t)b * 8 + h) * SEQ + 4 * F.tid) = (f32x4){base + v0, base + v1, base + v2, base + v3};
        __syncthreads();
    }
}

__device__ __forceinline__ void phase_cmp2(const Frame& F, const KA& a, int l) {
    unsigned char* ws = a.ws();
    LAS float* b1p = (LAS float*)F.lds;
    LAS float* hid = (LAS float*)(F.lds + 4096) + F.wave * 512;
    {
        const int m = F.tid >> 8, j = F.tid & 255;
        const float* part = (const float*)(ws + W_B1PART) + (size_t)m * 32 * 256 + j;
        float pv[32];
#pragma unroll
        for (int i = 0; i < 32; ++i) pv[i] = part[i * 256];
        float s = (m ? (const float*)a.in(18) : (const float*)a.in(14))[l * 256 + j];
#pragma unroll
        for (int i = 0; i < 32; ++i) s += pv[i];
        b1p[m * 256 + j] = s;
    }
    __syncthreads();
    for (int it = 2 * F.gw; it < 4096; it += 2 * F.ngw) {
        const int m = it >> 11, r = it & 2047, b = r >> 8, c = (r >> 1) & 127;
        bf16* out = (bf16*)(ws + (m ? WS_VCMP : WS_KCMP)) + (((size_t)b * 2 + 0) * 128 + c) * 64;
        if (c == 127) { out[F.lane] = 0; out[128 * 64 + F.lane] = 0; continue; }
#pragma unroll
        for (int g = 0; g < 2; ++g) {
            const bf16* P = (const bf16*)(ws + (m ? WS_PV : WS_PK)) + ((size_t)g * 1024 + b * 128 + c) * 512;
            const u32x2 p1 = *(const u32x2*)(P + 4 * F.lane), p2 = *(const u32x2*)(P + 512 + 256 + 4 * F.lane);
            float hv[4];
            hv[0] = __uint_as_float(p1.x << 16) + __uint_as_float(p2.x << 16); hv[1] = __uint_as_float(p1.x & 0xffff0000u) + __uint_as_float(p2.x & 0xffff0000u);
            hv[2] = __uint_as_float(p1.y << 16) + __uint_as_float(p2.y << 16); hv[3] = __uint_as_float(p1.y & 0xffff0000u) + __uint_as_float(p2.y & 0xffff0000u);
            f32x4 hx;
#pragma unroll
            for (int e = 0; e < 4; ++e) { const float x = hv[e] + b1p[m * 256 + 4 * F.lane + e]; hx[e] = x * sigm(x); }
            *(LAS f32x4*)(hid + g * 256 + 4 * F.lane) = hx;
        }
        asm volatile("s_waitcnt lgkmcnt(0)" ::: "memory");
        const float* w2 = (m ? (const float*)a.in(19) : (const float*)a.in(15)) + (size_t)l * 256 * 64 + F.lane;
        float acc0 = 0.f, acc1 = 0.f;
#pragma unroll 1
        for (int jb = 0; jb < 256; jb += 64) {
            float w[64];
#pragma unroll
            for (int i = 0; i < 64; ++i) w[i] = w2[(jb + i) * 64];
#pragma unroll
            for (int i = 0; i < 64; i += 4) { const f32x4 h0 = *(const LAS f32x4*)(hid + jb + i), h1 = *(const LAS f32x4*)(hid + 256 + jb + i);
                acc0 += h0.x * w[i] + h0.y * w[i + 1] + h0.z * w[i + 2] + h0.w * w[i + 3]; acc1 += h1.x * w[i] + h1.y * w[i + 1] + h1.z * w[i + 2] + h1.w * w[i + 3]; }
        }
        out[F.lane] = f2bf(acc0); out[128 * 64 + F.lane] = f2bf(acc1);
        asm volatile("s_waitcnt lgkmcnt(0)" ::: "memory");
    }
    __syncthreads();
}


namespace fa {
typedef short bf16x8 __attribute__((ext_vector_type(8)));
typedef short s16x4 __attribute__((ext_vector_type(4)));
typedef float f32x16 __attribute__((ext_vector_type(16)));
constexpr int KROW = 144;
constexpr int VROW = 192;
constexpr int TILE_B = 64 * KROW;
constexpr int VTILE_B = 64 * VROW;
constexpr int BIAS_OFF = TILE_B + VTILE_B;
constexpr int BUF_B = BIAS_OFF + 256;
constexpr float LOG2E = 1.4426950408889634f;
enum { MODE_NONE = 0, MODE_CAUSAL = 1, MODE_WINDOW = 2, MODE_SELECT = 3 };

__device__ __forceinline__ int crow(int r, int hi) { return (r & 3) + 8 * (r >> 2) + 4 * hi; }
__device__ __forceinline__ float xmax(float v) {
    auto rr = __builtin_amdgcn_permlane32_swap(__float_as_uint(v), __float_as_uint(v), false, false);
    return fmaxf(__uint_as_float(rr[0]), __uint_as_float(rr[1]));
}
typedef float f32x2 __attribute__((ext_vector_type(2)));
__device__ __forceinline__ float max3f(float a, float b, float c) { float r; asm("v_max3_f32 %0, %1, %2, %3" : "=v"(r) : "v"(a), "v"(b), "v"(c)); return r; }
__device__ __forceinline__ float xsum(float v) {
    auto rr = __builtin_amdgcn_permlane32_swap(__float_as_uint(v), __float_as_uint(v), false, false);
    return __uint_as_float(rr[0]) + __uint_as_float(rr[1]);
}
__device__ __forceinline__ s16x4 vtr(const LAS unsigned char* p) {
    typedef short v4i16_t __attribute__((ext_vector_type(4)));
    return __builtin_bit_cast(s16x4, __builtin_amdgcn_ds_read_tr16_b64_v4i16((LAS v4i16_t*)p));
}
__device__ __forceinline__ bf16x8 pack8(const f32x16& p, int b) {
    u32x4 w; w.x = pk2(p[b], p[b + 1]); w.y = pk2(p[b + 2], p[b + 3]); w.z = pk2(p[b + 4], p[b + 5]); w.w = pk2(p[b + 6], p[b + 7]);
    return __builtin_bit_cast(bf16x8, w);
}
__device__ __forceinline__ void load_q(bf16x8 (&qf)[4], const bf16* qrow, int hi) {
#pragma unroll
    for (int d0 = 0; d0 < 4; ++d0) qf[d0] = __builtin_bit_cast(bf16x8, *(const u32x4*)(qrow + 16 * d0 + 8 * hi));
}
__device__ __forceinline__ void rope_q(bf16x8& q0, int pos, int hi) {
    const u32x4 own = __builtin_bit_cast(u32x4, q0); u32x4 oth;
    oth.x = __shfl_xor(own.x, 32); oth.y = __shfl_xor(own.y, 32); oth.z = __shfl_xor(own.z, 32); oth.w = __shfl_xor(own.w, 32);
    float a[8], b[8];
    a[0] = __uint_as_float(own.x << 16); a[1] = __uint_as_float(own.x & 0xffff0000u); a[2] = __uint_as_float(own.y << 16); a[3] = __uint_as_float(own.y & 0xffff0000u);
    a[4] = __uint_as_float(own.z << 16); a[5] = __uint_as_float(own.z & 0xffff0000u); a[6] = __uint_as_float(own.w << 16); a[7] = __uint_as_float(own.w & 0xffff0000u);
    b[0] = __uint_as_float(oth.x << 16); b[1] = __uint_as_float(oth.x & 0xffff0000u); b[2] = __uint_as_float(oth.y << 16); b[3] = __uint_as_float(oth.y & 0xffff0000u);
    b[4] = __uint_as_float(oth.z << 16); b[5] = __uint_as_float(oth.z & 0xffff0000u); b[6] = __uint_as_float(oth.w << 16); b[7] = __uint_as_float(oth.w & 0xffff0000u);
    const float sg = hi ? 1.0f : -1.0f;
#pragma unroll
    for (int i = 0; i < 8; ++i) { float c, s; rope_cs(pos, i, c, s); a[i] = a[i] * c + sg * b[i] * s; }
    u32x4 w; w.x = pk2(a[0], a[1]); w.y = pk2(a[2], a[3]); w.z = pk2(a[4], a[5]); w.w = pk2(a[6], a[7]);
    q0 = __builtin_bit_cast(bf16x8, w);
}

struct KV { const bf16* K; const bf16* V; int ldk, ldv; const float* cb; };

struct Stage { u32x4 k, v; float b; };
template <bool BIAS> __device__ __forceinline__ void stage_load(Stage& s, const KV& P, int t, int tid) {
    const int row = 64 * t + (tid >> 3), ch = tid & 7;
    s.k = *(const u32x4*)(P.K + (size_t)row * P.ldk + ch * 8); s.v = *(const u32x4*)(P.V + (size_t)row * P.ldv + ch * 8);
    if (BIAS) { if (tid < 64) s.b = P.cb[64 * t + tid]; }
}
template <bool BIAS> __device__ __forceinline__ void stage_store(const Stage& s, LAS unsigned char* buf, int tid) {
    const int off = (tid >> 3) * KROW + (tid & 7) * 16, offv = (tid >> 3) * VROW + (tid & 7) * 16;
    *(LAS u32x4*)(buf + off) = s.k; *(LAS u32x4*)(buf + TILE_B + offv) = s.v;
    if (BIAS) { if (tid < 64) *(LAS float*)(buf + BIAS_OFF + tid * 4) = -s.b; }
}

template <int MODE> __device__ __forceinline__ bool tile_work(int t, int tq0, unsigned sel) {
    bool w = true;
    if (MODE == MODE_CAUSAL || MODE == MODE_WINDOW || MODE == MODE_SELECT) w = (64 * t <= tq0 + 31);
    if (MODE == MODE_WINDOW) w = w && (64 * t + 63 >= tq0 - 511);
    if (MODE == MODE_SELECT) w = w && (__ballot((sel >> t) & 1u) != 0ull);
    return w;
}
template <int MODE> __device__ __forceinline__ bool tile_full(int t, int tq0, unsigned sel) {
    bool f = true;
    if (MODE == MODE_CAUSAL || MODE == MODE_WINDOW || MODE == MODE_SELECT) f = (64 * t + 63 <= tq0);
    if (MODE == MODE_WINDOW) f = f && (tq0 + 31 - 64 * t < 512);
    if (MODE == MODE_SELECT) f = f && (__ballot((sel >> t) & 1u) == ~0ull);
    return f;
}

template <int MODE, bool BIAS, int XP = 0>
__device__ __forceinline__ void flash_tile(const LAS unsigned char* buf, int t, const bf16x8 (&qf)[4], int tq, int tq0, unsigned sel, int koff, int voff, int hi, f32x16 (&o)[2], float& m, float& l) {
    if (tile_work<MODE>(t, tq0, sel)) {
        bf16x8 kf[8];
#pragma unroll
        for (int d0 = 0; d0 < 4; ++d0) { kf[2 * d0] = *(const LAS bf16x8*)(buf + koff + d0 * 32); kf[2 * d0 + 1] = *(const LAS bf16x8*)(buf + koff + 32 * KROW + d0 * 32); }
        f32x16 s0, s1;
        if (BIAS) {
#pragma unroll
            for (int u = 0; u < 4; ++u) { const f32x4 b0 = *(const LAS f32x4*)(buf + BIAS_OFF + (8 * u + 4 * hi) * 4), b1 = *(const LAS f32x4*)(buf + BIAS_OFF + (32 + 8 * u + 4 * hi) * 4);
                s0[4 * u] = b0.x; s0[4 * u + 1] = b0.y; s0[4 * u + 2] = b0.z; s0[4 * u + 3] = b0.w; s1[4 * u] = b1.x; s1[4 * u + 1] = b1.y; s1[4 * u + 2] = b1.z; s1[4 * u + 3] = b1.w; }
        } else { s0 = f32x16{}; s1 = f32x16{}; }
        asm volatile("s_waitcnt lgkmcnt(0)" ::: "memory");
#pragma unroll
        for (int d0 = 0; d0 < 4; ++d0) { if (XP == 2) { asm volatile("" :: "v"(kf[2 * d0]), "v"(kf[2 * d0 + 1])); } else { s0 = __builtin_amdgcn_mfma_f32_32x32x16_bf16(kf[2 * d0], qf[d0], s0, 0, 0, 0); s1 = __builtin_amdgcn_mfma_f32_32x32x16_bf16(kf[2 * d0 + 1], qf[d0], s1, 0, 0, 0); } }
        s16x4 vlo[8], vhh[8];
#pragma unroll
        for (int j = 0; j < 2; ++j)
#pragma unroll
            for (int s = 0; s < 2; ++s)
#pragma unroll
                for (int d0 = 0; d0 < 2; ++d0) { const LAS unsigned char* vp = buf + voff + (32 * j + 16 * s) * VROW + d0 * 64; vlo[4 * j + 2 * s + d0] = vtr(vp); vhh[4 * j + 2 * s + d0] = vtr(vp + 8 * VROW); }
        asm volatile("" ::: "memory");
        asm volatile("s_nop 15\n\ts_nop 7" : "+v"(s0), "+v"(s1));
        if (MODE != MODE_NONE) {
            if (!tile_full<MODE>(t, tq0, sel)) {
                const int d = tq - (64 * t + 4 * hi);
                const bool selt = (MODE == MODE_SELECT) ? (((sel >> t) & 1u) != 0u) : true;
#pragma unroll
                for (int r = 0; r < 16; ++r) {
                    const int ca = (r & 3) + 8 * (r >> 2), cb = ca + 32;
                    bool va = selt && (ca <= d), vb = selt && (cb <= d);
                    if (MODE == MODE_WINDOW) { va = va && (ca > d - 512); vb = vb && (cb > d - 512); }
                    s0[r] = va ? s0[r] : -INFINITY; s1[r] = vb ? s1[r] : -INFINITY;
                }
            }
        }
        float mx0 = max3f(s0[0], s1[0], s0[1]), mx1 = max3f(s1[1], s0[2], s1[2]);
#pragma unroll
        for (int r = 3; r < 15; r += 2) { mx0 = max3f(mx0, s0[r], s1[r]); mx1 = max3f(mx1, s0[r + 1], s1[r + 1]); }
        const float mx = xmax(max3f(mx0, mx1, max3f(s0[15], s1[15], mx0)));
        const float mn = fmaxf(m, mx * LOG2E), ms = (mn == -INFINITY) ? 0.f : mn;
        const float alpha = __builtin_amdgcn_exp2f(m - ms);
        const bool resc = (mn != m);
        m = mn;
        f32x2 ps = (f32x2){0.f, 0.f};
#pragma unroll
        for (int r = 0; r < 16; r += 2) {
            const f32x2 ta = (f32x2){s0[r], s0[r + 1]} * LOG2E - ms, tb = (f32x2){s1[r], s1[r + 1]} * LOG2E - ms;
            if (XP == 1) { s0[r] = ta.x; s0[r + 1] = ta.y; s1[r] = tb.x; s1[r + 1] = tb.y; } else { s0[r] = __builtin_amdgcn_exp2f(ta.x); s0[r + 1] = __builtin_amdgcn_exp2f(ta.y); s1[r] = __builtin_amdgcn_exp2f(tb.x); s1[r + 1] = __builtin_amdgcn_exp2f(tb.y); }
            ps += (f32x2){s0[r], s0[r + 1]}; ps += (f32x2){s1[r], s1[r + 1]};
        }
        l = l * alpha + (ps.x + ps.y);
        if (__any(resc)) {
#pragma unroll
            for (int r = 0; r < 16; ++r) { o[0][r] *= alpha; o[1][r] *= alpha; }
        }
#pragma unroll
        for (int j = 0; j < 2; ++j)
#pragma unroll
            for (int s = 0; s < 2; ++s) {
                const bf16x8 pb = pack8(j ? s1 : s0, 8 * s);
#pragma unroll
                for (int d0 = 0; d0 < 2; ++d0) { const s16x4 lo = vlo[4 * j + 2 * s + d0], hh = vhh[4 * j + 2 * s + d0];
                    const bf16x8 vf = (bf16x8){lo[0], lo[1], lo[2], lo[3], hh[0], hh[1], hh[2], hh[3]};
                    if (XP == 2) { asm volatile("" :: "v"(vf), "v"(pb)); } else o[d0] = __builtin_amdgcn_mfma_f32_32x32x16_bf16(vf, pb, o[d0], 0, 0, 0); }
            }
    }
}
template <int MODE, bool BIAS, int XP = 0>
__device__ __forceinline__ void flash_core_v4(LAS unsigned char* lds, const KV& P, int t_lo, int t_hi, const bf16x8 (&qf)[4], int tq, int tq0, unsigned sel, f32x16 (&o)[2], float& l_out) {
    int tid_ = threadIdx.x; asm volatile("" : "+v"(tid_));
    const int tid = tid_, lane = tid & 63, r32 = lane & 31, hi = lane >> 5;
    o[0] = f32x16{}; o[1] = f32x16{};
    float m = -INFINITY, l = 0.f;
    const int koff = r32 * KROW + hi * 16;
    const int voff = TILE_B + (4 * hi + ((lane & 15) >> 2)) * VROW + (((lane >> 4) & 1) * 16 + (lane & 3) * 4) * 2;
    Stage sa, sb;
    stage_load<BIAS>(sa, P, t_lo, tid); stage_store<BIAS>(sa, lds, tid);
    if (t_lo + 1 < t_hi) stage_load<BIAS>(sa, P, t_lo + 1, tid);
    __syncthreads();
    for (int t = t_lo; t < t_hi; t += 2) {
        if (XP < 3 && t + 2 < t_hi) stage_load<BIAS>(sb, P, t + 2, tid);
        flash_tile<MODE, BIAS, XP>(lds, t, qf, tq, tq0, sel, koff, voff, hi, o, m, l);
        if (XP < 3 && t + 1 < t_hi) stage_store<BIAS>(sa, lds + BUF_B, tid);
        if (XP < 4) __syncthreads();
        if (t + 1 >= t_hi) break;
        if (XP < 3 && t + 3 < t_hi) stage_load<BIAS>(sa, P, t + 3, tid);
        flash_tile<MODE, BIAS, XP>(lds + BUF_B, t + 1, qf, tq, tq0, sel, koff, voff, hi, o, m, l);
        if (XP < 3 && t + 2 < t_hi) stage_store<BIAS>(sb, lds, tid);
        if (XP < 4) __syncthreads();
    }
    l_out = xsum(l);
}
__device__ __forceinline__ void store_o(bf16* orow, const f32x16 (&o)[2], float a, int hi) {
#pragma unroll
    for (int d0 = 0; d0 < 2; ++d0)
#pragma unroll
        for (int u = 0; u < 4; ++u) { u32x2 w; w.x = pk2(o[d0][4 * u] * a, o[d0][4 * u + 1] * a); w.y = pk2(o[d0][4 * u + 2] * a, o[d0][4 * u + 3] * a);
            *(u32x2*)(orow + 32 * d0 + 8 * u + 4 * hi) = w; }
}
}

__device__ __forceinline__ void phase_mem_mfma(const Frame& F, const KA& a) {
    unsigned char* ws = a.ws();
    const int vcu = (F.G % 8 == 0) ? (F.bid % 8) * (F.G / 8) + F.bid / 8 : F.bid;
    for (int u = vcu; u < 256; u += F.G) {
        const int b = u >> 5, h = (u >> 3) & 3, qb = u & 7;
        const int hi = F.lane >> 5, r32 = F.lane & 31, tq0 = 256 * qb + 32 * F.wave;
        const size_t tok = (size_t)b * SEQ + tq0 + r32;
        fa::bf16x8 qf[4];
#pragma unroll
        for (int d0 = 0; d0 < 4; ++d0) {
            float qa[8];
#pragma unroll
            for (int e = 0; e < 8; ++e) qa[e] = 0.f;
#pragma unroll
            for (int kq = 0; kq < 4; ++kq) { const u32x4 v = *(const u32x4*)((const bf16*)(ws + WS_MQ) + ((size_t)kq * M + tok) * 256 + h * 64 + 16 * d0 + 8 * hi);
                qa[0] += __uint_as_float(v.x << 16); qa[1] += __uint_as_float(v.x & 0xffff0000u); qa[2] += __uint_as_float(v.y << 16); qa[3] += __uint_as_float(v.y & 0xffff0000u);
                qa[4] += __uint_as_float(v.z << 16); qa[5] += __uint_as_float(v.z & 0xffff0000u); qa[6] += __uint_as_float(v.w << 16); qa[7] += __uint_as_float(v.w & 0xffff0000u); }
            u32x4 w; w.x = pk2(qa[0], qa[1]); w.y = pk2(qa[2], qa[3]); w.z = pk2(qa[4], qa[5]); w.w = pk2(qa[6], qa[7]);
            qf[d0] = __builtin_bit_cast(fa::bf16x8, w);
        }
        fa::KV P{(const bf16*)(ws + WS_MEMKV) + (size_t)b * NMEM * 512 + h * 64, (const bf16*)(ws + WS_MEMKV) + (size_t)b * NMEM * 512 + 256 + h * 64, 512, 512, nullptr};
        fa::f32x16 o[2]; float l;
        int nt_ = 4; asm volatile("" : "+s"(nt_));
        FA_CORE_MEM<fa::MODE_NONE, false>(F.lds, P, 0, nt_, qf, tq0 + r32, tq0, 0u, o, l);
        fa::store_o((bf16*)(ws + WS_MO) + tok * 256 + h * 64, o, 1.0f / l, hi);
    }
}
__device__ __forceinline__ void phase_fox_mfma(const Frame& F, const KA& a, bool dry) {
    unsigned char* ws = a.ws();
    const int vcu = (F.G % 8 == 0) ? (F.bid % 8) * (F.G / 8) + F.bid / 8 : F.bid;
    for (int u = vcu; u < 256; u += F.G) {
        const int bh = u >> 2, b = bh >> 3, h = bh & 7, s4 = u & 3;
        for (int half = 0; half < 2; ++half) {
            const int qb = half ? 7 - s4 : s4;
            const int hi = F.lane >> 5, r32 = F.lane & 31, tq0 = 256 * qb + 32 * F.wave;
            const size_t row0 = (size_t)b * SEQ, tok = row0 + tq0 + r32;
            bf16* Q = (bf16*)(ws + WS_OQ + 32 * MiB);
            fa::bf16x8 qf[4]; fa::load_q(qf, Q + tok * 512 + h * 64, hi);
            fa::KV P{(const bf16*)(ws + WS_KV + 32 * MiB) + row0 * 512 + h * 64, (const bf16*)(ws + WS_KV + 48 * MiB) + row0 * 512 + h * 64, 512, 512, (const float*)(ws + WS_CF) + (size_t)bh * SEQ};
            fa::f32x16 o[2]; float l;
            if (dry && PROBE_XP) fa::flash_core_v4<fa::MODE_CAUSAL, true, PROBE_XP>(F.lds, P, 0, 4 * (qb + 1), qf, tq0 + r32, tq0, 0u, o, l);
            else FA_CORE_FOX<fa::MODE_CAUSAL, true>(F.lds, P, 0, 4 * (qb + 1), qf, tq0 + r32, tq0, 0u, o, l);
            if (!dry) fa::store_o(Q + tok * 512 + h * 64, o, 1.0f / l, hi);
        }
    }
}

__device__ __forceinline__ void phase_nsa_fused(const Frame& F, const KA& a, bool dry) {
    using namespace fa;
    unsigned char* ws = a.ws();
    const int vcu = (F.G % 8 == 0) ? (F.bid % 8) * (F.G / 8) + F.bid / 8 : F.bid;
    const int* pos = (const int*)a.in(2);
    const int lane = F.lane, r32 = lane & 31, hi = lane >> 5, tid = F.tid, wave = F.wave;
    LAS unsigned char* lds = F.lds;
    constexpr int CT = 128 * KROW, SC_OFF = 45056, MK_OFF = SC_OFF + 8 * 32 * 32 * 4;
    for (int u = vcu; u < 256; u += F.G) {
        const int bg = u >> 4, b = bg >> 1, g = bg & 1, s16 = u & 15;
        for (int half = 0; half < 2; ++half) {
            const int qb = half ? 31 - s16 : s16;
            const int h = 4 * g + (wave >> 1), tq0 = 64 * qb + 32 * (wave & 1), tq = tq0 + r32;
            const size_t row0 = (size_t)b * SEQ, tok = row0 + tq;
            bf16* Q = (bf16*)(ws + WS_OQ + 16 * MiB);
            const bf16* kv = (const bf16*)(ws + WS_KV + 64 * MiB) + row0 * 768 + g * 64;
            const bf16* small = (const bf16*)(ws + WS_KV + 88 * MiB) + tok * 256 + h * 3;
            const float g0 = sigm(bf2f(small[0])), g1 = sigm(bf2f(small[1])), g2 = sigm(bf2f(small[2]));
            bf16x8 qf[4]; load_q(qf, Q + tok * 512 + h * 64, hi);
            {   const bf16* Kc = (const bf16*)(ws + WS_KCMP) + (size_t)bg * 128 * 64; const bf16* Vc = (const bf16*)(ws + WS_VCMP) + (size_t)bg * 128 * 64;
#pragma unroll
                for (int i = 0; i < 2; ++i) { const int pc = tid + 512 * i, row = pc >> 3, ch = pc & 7;
                    *(LAS u32x4*)(lds + row * KROW + ch * 16) = *(const u32x4*)(Kc + row * 64 + ch * 8);
                    *(LAS u32x4*)(lds + CT + row * VROW + ch * 16) = *(const u32x4*)(Vc + row * 64 + ch * 8); } }
            __syncthreads();
            {
                f32x16 acc[2];
                const int koff = r32 * KROW + hi * 16;
                const int voff = CT + (4 * hi + ((lane & 15) >> 2)) * VROW + (((lane >> 4) & 1) * 16 + (lane & 3) * 4) * 2;
                const int ncmax = tq0 >= 0 ? min(127, (tq0 + 31 - 31) / 16 + 1) : 0, nsub = (ncmax + 31) >> 5;
                f32x16 s[4];
#pragma unroll
                for (int j = 0; j < 4; ++j) s[j] = f32x16{};
#pragma unroll
                for (int j = 0; j < 4; ++j) if (j < nsub) {
#pragma unroll
                    for (int d0 = 0; d0 < 4; ++d0) { const bf16x8 kf = *(const LAS bf16x8*)(lds + koff + 32 * j * KROW + d0 * 32); s[j] = __builtin_amdgcn_mfma_f32_32x32x16_bf16(kf, qf[d0], s[j], 0, 0, 0); } }
                float mx = -INFINITY;
#pragma unroll
                for (int j = 0; j < 4; ++j)
#pragma unroll
                    for (int rr = 0; rr < 16; ++rr) { const int c = 32 * j + crow(rr, hi); const bool v = (16 * c + 31 <= tq) && (c < 127) && (j < nsub); s[j][rr] = v ? s[j][rr] : -INFINITY; mx = fmaxf(mx, s[j][rr]); }
                mx = xmax(mx);
                const float ms = (mx == -INFINITY) ? 0.f : mx * LOG2E;
                float ps = 0.f;
#pragma unroll
                for (int j = 0; j < 4; ++j)
#pragma unroll
                    for (int rr = 0; rr < 16; ++rr) { s[j][rr] = __builtin_amdgcn_exp2f(s[j][rr] * LOG2E - ms); ps += s[j][rr]; }
                ps = xsum(ps);
                const float inv = ps > 0.f ? 1.0f / ps : 0.f;
#pragma unroll
                for (int j = 0; j < 4; ++j)
#pragma unroll
                    for (int rr = 0; rr < 16; ++rr) s[j][rr] *= inv;
                LAS float* sc_out = (LAS float*)(lds + SC_OFF) + (wave * 32 + r32) * 32;
                float prev = 0.f;
#pragma unroll
                for (int idx = 0; idx < 16; ++idx) { const int j = idx >> 2, uu = idx & 3;
                    const float G = (s[j][4 * uu] + s[j][4 * uu + 1]) + (s[j][4 * uu + 2] + s[j][4 * uu + 3]), L = s[j][4 * uu + 3];
                    const float recv = __shfl_xor(L, 32);
                    sc_out[2 * idx + hi] = G + (hi ? recv : prev);
                    prev = recv; }
                acc[0] = f32x16{}; acc[1] = f32x16{};
#pragma unroll
                for (int j = 0; j < 4; ++j) if (j < nsub) {
#pragma unroll
                    for (int ss = 0; ss < 2; ++ss) {
                        const bf16x8 pb = pack8(s[j], 8 * ss);
#pragma unroll
                        for (int d0 = 0; d0 < 2; ++d0) {
                            const LAS unsigned char* vp = lds + voff + (32 * j + 16 * ss) * VROW + d0 * 64;
                            const s16x4 lo = vtr(vp), hh = vtr(vp + 8 * VROW);
                            const bf16x8 vf = (bf16x8){lo[0], lo[1], lo[2], lo[3], hh[0], hh[1], hh[2], hh[3]};
                            acc[d0] = __builtin_amdgcn_mfma_f32_32x32x16_bf16(vf, pb, acc[d0], 0, 0, 0);
                        }
                    } }
                store_o((bf16*)(ws + WS_OCMP) + tok * 512 + h * 64, acc, g0, hi);
            }
            __syncthreads();
            if (tid < 64) {
                const int t = 64 * qb + tid, sub = tid >> 5, rr = tid & 31;
                float sc[32];
#pragma unroll
                for (int n = 0; n < 32; ++n) sc[n] = 0.f;
#pragma unroll
                for (int r = 0; r < 4; ++r) { const LAS f32x4* p = (const LAS f32x4*)(lds + SC_OFF) + ((2 * r + sub) * 32 + rr) * 8;
#pragma unroll
                    for (int i = 0; i < 8; ++i) { const f32x4 v = p[i]; sc[4 * i] += v.x; sc[4 * i + 1] += v.y; sc[4 * i + 2] += v.z; sc[4 * i + 3] += v.w; } }
                const int cur = t >> 6;
#pragma unroll
                for (int n = 0; n < 32; ++n) sc[n] = (n == 0 || n == cur) ? 1e4f : ((64 * n <= t) ? sc[n] : -1.0f);
                unsigned mask = 0u;
#pragma unroll
                for (int k = 0; k < 8; ++k) {
                    float best = sc[0]; int bi = 0;
#pragma unroll
                    for (int n = 1; n < 32; ++n) { const bool take = sc[n] > best; best = take ? sc[n] : best; bi = take ? n : bi; }
                    mask |= 1u << bi;
#pragma unroll
                    for (int n = 0; n < 32; ++n) sc[n] = (n == bi) ? -INFINITY : sc[n];
                }
                ((LAS unsigned*)(lds + MK_OFF))[tid] = mask;
            }
            __syncthreads();
            const unsigned sel = ((const LAS unsigned*)(lds + MK_OFF))[32 * (wave & 1) + r32];
            rope_q(qf[0], pos[tok], hi);
            f32x16 o[2]; float l;
            { KV P{kv + 256, kv + 384, 768, 768, nullptr};
              FA_CORE_SEL<MODE_SELECT, false>(lds, P, 0, qb + 1, qf, tq, tq0, sel, o, l); }
            f32x16 acc[2];
            { const float sc = l > 0.f ? g1 / l : 0.f;
#pragma unroll
              for (int r = 0; r < 16; ++r) { acc[0][r] = o[0][r] * sc; acc[1][r] = o[1][r] * sc; } }
            { KV P{kv + 512, kv + 640, 768, 768, nullptr};
              FA_CORE_SEL<MODE_WINDOW, false>(lds, P, qb > 8 ? qb - 8 : 0, qb + 1, qf, tq, tq0, 0u, o, l); }
            { const float sc = l > 0.f ? g2 / l : 0.f;
              const bf16* oc = (const bf16*)(ws + WS_OCMP) + tok * 512 + h * 64;
#pragma unroll
              for (int d0 = 0; d0 < 2; ++d0)
#pragma unroll
                  for (int uu = 0; uu < 4; ++uu) { const u32x2 w = *(const u32x2*)(oc + 32 * d0 + 8 * uu + 4 * hi);
                      acc[d0][4 * uu] += o[d0][4 * uu] * sc + __uint_as_float(w.x << 16); acc[d0][4 * uu + 1] += o[d0][4 * uu + 1] * sc + __uint_as_float(w.x & 0xffff0000u);
                      acc[d0][4 * uu + 2] += o[d0][4 * uu + 2] * sc + __uint_as_float(w.y << 16); acc[d0][4 * uu + 3] += o[d0][4 * uu + 3] * sc + __uint_as_float(w.y & 0xffff0000u); } }
            if (!dry) store_o(Q + tok * 512 + h * 64, acc, 1.0f, hi);
        }
    }
}


__device__ __forceinline__ void phase_sb_mfma(const Frame& F, const KA& a, int l, bool dry) {
    using namespace fa;
    unsigned char* ws = a.ws();
    const int lane = F.lane, r32 = lane & 31, hi = lane >> 5;
    LAS unsigned char* lds = F.lds + F.wave * (32 * KROW + 32 * VROW);
    constexpr int SUB_B = 32 * KROW;
    const int koff = r32 * KROW + hi * 16;
    const int voff = SUB_B + (4 * hi + ((lane & 15) >> 2)) * VROW + (((lane >> 4) & 1) * 16 + (lane & 3) * 4) * 2;
    const unsigned shard = (unsigned)F.bid & 7u;
    unsigned* ctr = (unsigned*)(ws + WS_CTL) + CW_SB + 64 * (shard + 8 * (unsigned)l);
    for (;;) {
        unsigned k_ = 0u;
        if (lane == 0) k_ = __hip_atomic_fetch_add(ctr, 1u, __ATOMIC_RELAXED, __HIP_MEMORY_SCOPE_AGENT);
        k_ = (unsigned)__builtin_amdgcn_readfirstlane((int)k_);
        if (k_ >= 512u) break;
        const int u = (int)(shard * 512u + (511u - k_));
        const int bh = u >> 6, b = bh >> 3, h = bh & 7, rb = u & 63;
        const int tq0 = 32 * rb, tq = tq0 + r32;
        const size_t row0 = (size_t)b * SEQ, tok = row0 + tq;
        bf16* Q = (bf16*)(ws + WS_OQ);
        const bf16* Kg = (const bf16*)(ws + WS_KV) + row0 * 512 + h * 64; const bf16* Vg = (const bf16*)(ws + WS_KV + 16 * MiB) + row0 * 512 + h * 64;
        bf16x8 qf[4]; load_q(qf, Q + tok * 512 + h * 64, hi);
        f32x16 o[2]; o[0] = f32x16{}; o[1] = f32x16{};
        float carry = 1.0f;
        u32x4 ak[4], av[4], bk[4], bv[4];
#define SB_LOAD(K_, V_, j_) do { _Pragma("unroll") for (int i = 0; i < 4; ++i) { const int pc = lane + 64 * i, row = 32 * (j_) + (pc >> 3), ch = pc & 7; \
            K_[i] = *(const u32x4*)(Kg + (size_t)row * 512 + ch * 8); V_[i] = *(const u32x4*)(Vg + (size_t)row * 512 + ch * 8); } } while (0)
#define SB_STORE(K_, V_) do { _Pragma("unroll") for (int i = 0; i < 4; ++i) { const int pc = lane + 64 * i, off = (pc >> 3) * KROW + (pc & 7) * 16, offv = (pc >> 3) * VROW + (pc & 7) * 16; \
            *(LAS u32x4*)(lds + off) = K_[i]; *(LAS u32x4*)(lds + SUB_B + offv) = V_[i]; } } while (0)
#define SB_COMPUTE(jj_) do { const int jsub_ = (jj_); \
            f32x16 s = f32x16{}; \
_Pragma("unroll") \
            for (int d0 = 0; d0 < 4; ++d0) { const bf16x8 kf = *(const LAS bf16x8*)(lds + koff + d0 * 32); s = __builtin_amdgcn_mfma_f32_32x32x16_bf16(kf, qf[d0], s, 0, 0, 0); } \
            const int dd = tq - (32 * jsub_ + 4 * hi); \
            float keep[16]; \
_Pragma("unroll") \
            for (int r = 0; r < 16; ++r) { \
                const bool v = ((r & 3) + 8 * (r >> 2)) < dd; const float z = s[r]; \
                const float ea = __expf(-fabsf(z)), rr = __builtin_amdgcn_rcpf(1.0f + ea), sm = ea * rr; \
                const float beta = z >= 0.f ? rr : sm, kp = z >= 0.f ? sm : rr; \
                keep[r] = v ? kp : 1.0f; s[r] = v ? beta : 0.f; \
            } \
            float Go[4], Gp[4]; \
_Pragma("unroll") \
            for (int uu = 0; uu < 4; ++uu) { Go[uu] = (keep[4 * uu] * keep[4 * uu + 1]) * (keep[4 * uu + 2] * keep[4 * uu + 3]); Gp[uu] = __shfl_xor(Go[uu], 32); } \
            float above = carry; \
_Pragma("unroll") \
            for (int uu = 3; uu >= 0; --uu) { \
                const float e3 = above * (hi ? 1.0f : Gp[uu]); \
                const float e2 = e3 * keep[4 * uu + 3], e1 = e2 * keep[4 * uu + 2], e0 = e1 * keep[4 * uu + 1]; \
                s[4 * uu + 3] *= e3; s[4 * uu + 2] *= e2; s[4 * uu + 1] *= e1; s[4 * uu] *= e0; \
                above *= Go[uu] * Gp[uu]; \
            } \
            carry = above; \
_Pragma("unroll") \
            for (int ss = 0; ss < 2; ++ss) { \
                const bf16x8 pb = pack8(s, 8 * ss); \
_Pragma("unroll") \
                for (int d0 = 0; d0 < 2; ++d0) { \
                    const LAS unsigned char* vp = lds + voff + (16 * ss) * VROW + d0 * 64; \
                    const s16x4 lo = vtr(vp), hh = vtr(vp + 8 * VROW); \
                    const bf16x8 vf = (bf16x8){lo[0], lo[1], lo[2], lo[3], hh[0], hh[1], hh[2], hh[3]}; \
                    o[d0] = __builtin_amdgcn_mfma_f32_32x32x16_bf16(vf, pb, o[d0], 0, 0, 0); \
                } \
            } \
        } while (0)
        SB_LOAD(ak, av, rb);
        if (rb > 0) SB_LOAD(bk, bv, rb - 1);
        for (int j = rb; j >= 0; j -= 2) {
            SB_STORE(ak, av);
            if (j >= 2) SB_LOAD(ak, av, j - 2);
            SB_COMPUTE(j);
            if (__ballot(carry != 0.f) == 0ull) break;
            if (j == 0) break;
            SB_STORE(bk, bv);
            if (j >= 3) SB_LOAD(bk, bv, j - 3);
            SB_COMPUTE(j - 1);
            if (__ballot(carry != 0.f) == 0ull) break;
        }
#undef SB_LOAD
#undef SB_STORE
#undef SB_COMPUTE
        if (!dry) store_o(Q + tok * 512 + h * 64, o, 1.0f, hi);
    }
    __syncthreads();
}

__device__ __forceinline__ void phase_norm(const Frame& F, const KA& a, const bf16* ysrc, const float* xs, const float* gpost, const float* gpre, bool write_h, bool dry) {
    unsigned char* ws = a.ws();
    for (int r = F.gw; r < M; r += 2 * F.ngw) {
        const int r1 = (r + F.ngw < M) ? r + F.ngw : r;
        if (r1 != r) post_norm_rows2(ysrc + (size_t)r * DM, ysrc + (size_t)r1 * DM, xs + (size_t)r * DM, xs + (size_t)r1 * DM, a.out() + (size_t)r * DM, a.out() + (size_t)r1 * DM, gpost, gpre,
                                     (bf16*)(ws + WS_H) + (size_t)r * DM, (bf16*)(ws + WS_H) + (size_t)r1 * DM, write_h, dry, F.lane);
        else post_norm_row(ysrc + (size_t)r * DM, xs + (size_t)r * DM, a.out() + (size_t)r * DM, gpost, gpre, (bf16*)(ws + WS_H) + (size_t)r * DM, write_h, dry, F.lane);
    }
}

__device__ __forceinline__ void launder_frame(Frame& F) {
    int z = 0; asm volatile("" : "+s"(z));
    int t = threadIdx.x; asm volatile("" : "+v"(t));
    F.tid = t; F.lane = t & 63; F.wave = __builtin_amdgcn_readfirstlane(t >> 6);
    F.G = (int)gridDim.x + z; F.bid = (int)blockIdx.x + z;
    F.gw = F.bid * NWAVES + F.wave; F.ngw = F.G * NWAVES; F.gt = F.bid * NTHREADS + F.tid; F.ngt = F.G * NTHREADS;
}
constexpr int NPH = 19;
constexpr int LDS_BYTES = 147456;
constexpr int MISC_OFF = 131072 + 320;

template <int PSEL> __global__ void __launch_bounds__(NTHREADS, 2) hybrid_fwd(Args a_unused) {
    extern __shared__ __attribute__((aligned(16))) unsigned char lds_raw[];
    Frame F;
    F.lds = (LAS unsigned char*)lds_raw;
    F.tid = threadIdx.x; F.lane = F.tid & 63; F.wave = __builtin_amdgcn_readfirstlane(F.tid >> 6);
    F.G = gridDim.x; F.bid = blockIdx.x;
    F.gw = F.bid * NWAVES + F.wave; F.ngw = F.G * NWAVES; F.gt = F.bid * NTHREADS + F.tid; F.ngt = F.G * NTHREADS;
    volatile LAS unsigned* MISC = (volatile LAS unsigned*)(F.lds + MISC_OFF);
    if (F.tid < 32) MISC[F.tid] = 0u;
    __syncthreads();
    KA a; a.refresh();
    unsigned char* ws = a.ws();
    constexpr bool one_launch = PSEL < 0;
    XcdBarrier bar; bar.bar = (unsigned*)(ws + WS_CTL) + CW_BAR; bar.x = 0; bar.st = nullptr;
    if (one_launch) bar = xcd_barrier_post((unsigned*)(ws + WS_CTL) + CW_BAR, MISC + 8);
#define IN(k) (a.refresh(), ws = a.ws(), launder_frame(F), (PSEL < 0 || PSEL == ((k) - p0)))
#define REP(k) for (int rep_ = ((PROBE_MASK >> (k)) & 1) ? a.ph_hi() : 0; rep_ >= 0; --rep_)
#define DRY (rep_ > 0)
#define SEAM(k) do { if (PSEL < 0) { xcd_barrier(bar); if (PROBE_XBAR) xcd_barrier(bar); } } while (0)
    typedef pg8::bf16_t pb;
    const int l_lo = (PSEL < 0 ? 0 : a.ph_lo()), l_hi = (PSEL < 0 ? 2 : l_lo + 1);
    for (int l = l_lo; l < l_hi; ++l) {
        const int p0 = l * NPH;
        if (l == 0) { if (IN(p0 + 0)) REP(0) { phase_conv(F, a, 0); __syncthreads(); } SEAM(p0 + 0); }
        if (IN(p0 + 1)) REP(1) {
            pg8::Gemm g{(const pb*)(ws + WS_H), (const pb*)(ws + W_A), M, NA, DM}; pg8::StaticOrder S; S.init(M, NA, F.G, F.bid);
            pg8::EpiProj E{(pb*)(ws + WS_CK), (pb*)(ws + WS_OQ), (pb*)(ws + WS_KV), M};
            pg8::gemm_phase<pg8::EpiProj, pg8::StaticOrder, true, true>(F.lds, g, S, E);
            { pg8::Gemm g2{(const pb*)(ws + WS_MEMN), (const pb*)(ws + W_MKV), MMEM, 512, DM}; pg8::StaticOrder S2; S2.init(MMEM, 512, F.G, (F.bid + F.G - 128) % F.G);
              pg8::EpiPlain E2{(pb*)(ws + WS_MEMKV), 512}; pg8::gemm_phase<pg8::EpiPlain, pg8::StaticOrder, true, true>(F.lds, g2, S2, E2); }
            phase_conv_b(F, a, l);
        }
        SEAM(p0 + 1);
        if (IN(p0 + 3)) REP(3) {
            phase_post(F, a, l, DRY);
            { pg8::Gemm g{(const pb*)(ws + WS_CK), (const pb*)(ws + W_C1K), 2048, 512, 1024}; pg8::StaticOrder S; S.init(2048, 512, F.G, F.bid);
              pg8::EpiPlain E{(pb*)(ws + WS_PK), 512}; pg8::gemm_phase<pg8::EpiPlain, pg8::StaticOrder, true, true>(F.lds, g, S, E); }
            { pg8::Gemm g{(const pb*)(ws + WS_CV), (const pb*)(ws + W_C1V), 2048, 512, 1024}; pg8::StaticOrder S; S.init(2048, 512, F.G, (F.bid + F.G - 16) % F.G);
              pg8::EpiPlain E{(pb*)(ws + WS_PV), 512}; pg8::gemm_phase<pg8::EpiPlain, pg8::StaticOrder, true, true>(F.lds, g, S, E); }
            phase_sb_mfma(F, a, l, DRY);
        }
        SEAM(p0 + 3);
        if (IN(p0 + 4)) REP(4) { phase_cmp2(F, a, l); phase_fox_mfma(F, a, DRY); }
        SEAM(p0 + 4);
        if (IN(p0 + 5)) REP(5) phase_nsa_fused(F, a, DRY);
        SEAM(p0 + 5);
        if (IN(p0 + 8)) REP(8) {
            pg8::Gemm g{(const pb*)(ws + WS_OQ), (const pb*)(ws + W_UP), 3 * M, 3072, 512}; pg8::UpOrder S; S.init(M, F.G, F.bid);
            pg8::EpiUpU E{(pb*)(ws + WS_MG)};
            pg8::gemm_phase<pg8::EpiUpU, pg8::UpOrder, true, true>(F.lds, g, S, E);
        }
        SEAM(p0 + 8);
        if (IN(p0 + 9)) REP(9) {
            pg8::Gemm g{(const pb*)(ws + WS_H), (const pb*)(ws + W_M), M, 3072, DM}; pg8::MergeOrder S; S.init(M, F.G, F.bid);
            pg8::EpiGateY2 E{(const pb*)(ws + WS_MG), (pb*)(ws + WS_OQ), DRY};
            pg8::gemm_phase<pg8::EpiGateY2, pg8::MergeOrder, true, true>(F.lds, g, S, E);
        }
        SEAM(p0 + 9);
        if (IN(p0 + 10)) REP(10) {
            pg8::Gemm g{(const pb*)(ws + WS_OQ), (const pb*)(ws + W_OUT3), M, DM, DM}; pg8::StaticOrder S; S.init(M, DM, F.G, F.bid);
            pg8::EpiPlain E{(pb*)(ws + WS_MG), DM};
            pg8::gemm_phase<pg8::EpiPlain, pg8::StaticOrder, true, true>(F.lds, g, S, E);
        }
        SEAM(p0 + 10);
        if (IN(p0 + 11)) REP(11) phase_norm(F, a, (const bf16*)(ws + WS_MG), l == 0 ? (const float*)a.in(0) : (const float*)a.out(), (const float*)a.in(4) + l * DM, (const float*)a.in(5) + l * DM, true, DRY);
        SEAM(p0 + 11);
        if (IN(p0 + 12)) REP(12) {
            for (int kq = 0; kq < 4; ++kq) {
                pg8::Gemm g{(const pb*)(ws + WS_H) + kq * 256, (const pb*)(ws + W_MQ) + kq * 256, M, 256, 256, DM, DM}; pg8::StaticOrder S; S.init(M, 256, F.G, (F.bid + F.G - 64 * kq) % F.G);
                pg8::EpiPlain E{(pb*)(ws + WS_MQ) + (size_t)kq * M * 256, 256}; pg8::gemm_phase<pg8::EpiPlain, pg8::StaticOrder, true, true>(F.lds, g, S, E);
            }
        }
        SEAM(p0 + 12);
        if (IN(p0 + 13)) REP(13) phase_mem_mfma(F, a);
        SEAM(p0 + 13);
        if (IN(p0 + 14)) REP(14) {
            pg8::Gemm g{(const pb*)(ws + WS_MO), (const pb*)(ws + W_MO), M, DM, 256}; pg8::StaticOrder S; S.init(M, DM, F.G, F.bid);
            pg8::EpiPlain E{(pb*)(ws + WS_H), DM};
            pg8::gemm_phase<pg8::EpiPlain, pg8::StaticOrder, true, true>(F.lds, g, S, E);
        }
        SEAM(p0 + 14);
        if (IN(p0 + 15)) REP(15) phase_norm(F, a, (const bf16*)(ws + WS_H), (const float*)a.out(), (const float*)a.in(7) + l * DM, (const float*)a.in(8) + l * DM, true, DRY);
        SEAM(p0 + 15);
        if (IN(p0 + 16)) REP(16) {
            pg8::Gemm g{(const pb*)(ws + WS_H), (const pb*)(ws + W_GU), M, 2 * DFF, DM}; pg8::StaticOrder S; S.init(M, 2 * DFF, F.G, F.bid);
            pg8::EpiSwiglu E{(pb*)(ws + WS_ACT), DFF};
            pg8::gemm_phase<pg8::EpiSwiglu, pg8::StaticOrder, true, true>(F.lds, g, S, E);
        }
        SEAM(p0 + 16);
        if (IN(p0 + 17)) REP(17) {
            pg8::Gemm g{(const pb*)(ws + WS_ACT), (const pb*)(ws + W_DN), M, DM, DFF}; pg8::StaticOrder S; S.init(M, DM, F.G, F.bid);
            pg8::EpiPlain E{(pb*)(ws + WS_H), DM};
            pg8::gemm_phase<pg8::EpiPlain, pg8::StaticOrder, true, true>(F.lds, g, S, E);
        }
        SEAM(p0 + 17);
        if (IN(p0 + 18)) REP(18) { phase_norm(F, a, (const bf16*)(ws + WS_H), (const float*)a.out(), (const float*)a.in(9) + l * DM, (const float*)a.in(3) + (l + 1 < 2 ? l + 1 : l) * DM, l == 0, DRY);
            if (l == 0) { phase_conv(F, a, 1); __syncthreads(); } }
        if (l == 0) SEAM(p0 + 18);
    }
#undef IN
#undef SEAM
}

template <int P> static hipError_t set_attr1() { return hipFuncSetAttribute((const void*)hybrid_fwd<P>, hipFuncAttributeMaxDynamicSharedMemorySize, LDS_BYTES); }
template <int... P> static hipError_t set_attrs_seq(std::integer_sequence<int, P...>) { hipError_t e = hipSuccess; hipError_t r[] = {set_attr1<P>()...}; for (hipError_t x : r) if (x != hipSuccess) e = x; return e; }
static hipError_t set_attrs() {
#if MK_ONE_LAUNCH
    return set_attr1<-1>();
#else
    return set_attrs_seq(std::make_integer_sequence<int, NPH>{});
#endif
}
template <int P> static int launch1(const Args& a, int grid, hipStream_t stream) { hybrid_fwd<P><<<dim3(grid), dim3(NTHREADS), LDS_BYTES, stream>>>(a); return 0; }
template <int... P> static void launch_phases(const Args& a, int grid, hipStream_t stream, std::integer_sequence<int, P...>) {
    (void)std::initializer_list<int>{launch1<P>(a, grid, stream)...};
}

extern "C" void kernel_launch(void* const* d_in, const int* in_sizes, int n_in, void* d_out, int out_size, void* d_ws, size_t ws_size, hipStream_t stream) {
    static int grid = 0;
    if (grid == 0) {
        if (n_in != 31 || out_size != M * DM || ws_size < WS_END) { fprintf(stderr, "kernel_launch: unexpected problem (n_in %d, out %d, ws %zu)\n", n_in, out_size, ws_size); grid = -1; return; }
        if (set_attrs() != hipSuccess) { fprintf(stderr, "kernel_launch: hipFuncSetAttribute failed\n"); grid = -1; return; }
        int dev = 0, cus = 0;
        if (hipGetDevice(&dev) != hipSuccess || hipDeviceGetAttribute(&cus, hipDeviceAttributeMultiprocessorCount, dev) != hipSuccess) { grid = -1; return; }
        grid = cus;
    }
    if (grid < 0) return;
    (void)hipMemsetAsync((char*)d_ws + WS_CTL, 0, CTL_ZERO_BYTES, stream);
    Args a{};
    for (int i = 0; i < 31; ++i) a.in[i] = d_in[i];
    a.out = (float*)d_out; a.ws = (unsigned char*)d_ws;
#if MK_ONE_LAUNCH
    a.ph_lo = 0; a.ph_hi = PROBE_REPS;
    launch1<-1>(a, grid, stream);
#else
    for (int l = 0; l < 2; ++l) { a.ph_lo = l; a.ph_hi = l + 1; launch_phases(a, grid, stream, std::make_integer_sequence<int, NPH>{}); }
#endif
}
```

```cpp
#include <hip/hip_runtime.h>
#include <cstdio>
#include <cstdint>
#include <cmath>
#include <utility>
#include <initializer_list>
#define MK_ONE_LAUNCH 1
#define PROBE_MASK 0u
#define PROBE_REPS 0
#define PROBE_XBAR 0
#define PROBE_XP 0
#define FA_FULL 1
#define FA_RESC 1
#define FA_VAR 0
#define FA_CORE_MEM fa::flash_core_v4
#define FA_CORE_FOX fa::flash_core_v4
#define FA_CORE_SEL fa::flash_core_v4
#define GAS __attribute__((address_space(1)))
#define LAS __attribute__((address_space(3)))
namespace pg8 {
#define PG8_LAS __attribute__((address_space(3)))
typedef unsigned short bf16_t;
typedef short bf16x8 __attribute__((ext_vector_type(8)));
typedef float f32x4 __attribute__((ext_vector_type(4)));
typedef unsigned u32x4 __attribute__((ext_vector_type(4)));
constexpr int BM = 256, BK = 64, HALF = 128, HTB = HALF * BK * 2  , STAGE_BYTES = 8 * HTB, NXCD = 8, WGM = 8;

__host__ __device__ __forceinline__ int lds_byte(int r, int c) { const int st = (r >> 4) * 2 + (c >> 5), rr = r & 15, cc = c & 31, ob = rr * 64 + cc * 2; return st * 1024 + (ob ^ (((ob >> 9) & 1) << 5)); }
__host__ __device__ __forceinline__ void stage_rc(int b, int& R, int& C) { const int st = b / 1024, sb = b % 1024, swz = sb ^ (((sb >> 9) & 1) << 5); R = (st >> 1) * 16 + swz / 64; C = (st & 1) * 32 + (swz % 64) / 2; }
__host__ __device__ __forceinline__ int perm32(int rho) { const int n = rho >> 4, i = rho & 15; return 8 * (i >> 2) + 4 * n + (i & 3); }

struct Unit { int pm, pn; };
struct Gemm { const bf16_t* A; const bf16_t* Bt; int M, N, K; int lda, ldb; };

struct StaticOrder {
    int nM, nN, nwg, G, c;
    __host__ __device__ void init(int M, int N, int G_, int c_) { nM = M / BM; nN = N / BM; nwg = nM * nN; G = G_; c = c_; }
    __host__ __device__ bool next(int i, Unit& u) const {
        const long L = (long)i * G + c; if (L >= nwg) return false;
        int wgid = (int)L; { const int q = nwg / NXCD, r = nwg % NXCD, xcd = wgid % NXCD, off = wgid / NXCD; wgid = (xcd < r ? xcd * (q + 1) : r * (q + 1) + (xcd - r) * q) + off; }
        const int nig = WGM * nN, gid = wgid / nig, fm = gid * WGM, gsz = (nM - fm) < WGM ? (nM - fm) : WGM;
        u.pm = fm + ((wgid % nig) % gsz); u.pn = (wgid % nig) / gsz; return true;
    }
    __device__ __forceinline__ void a_ready(const Unit&) const {}
    __device__ __forceinline__ void done(const Unit&) const {}
};

typedef float cvt_f32x2_t __attribute__((ext_vector_type(2))); typedef __bf16 cvt_bf16x2_t __attribute__((ext_vector_type(2)));
__device__ __forceinline__ unsigned cvt_pk_bf16(float lo, float hi) { const cvt_f32x2_t v = {lo, hi}; const cvt_bf16x2_t b = __builtin_convertvector(v, cvt_bf16x2_t); return __builtin_bit_cast(unsigned, b); }
typedef float f32x2 __attribute__((ext_vector_type(2)));
template <class Epi, class Sched, bool ALIGN_EPI = false, bool SP2 = false>
__device__ __forceinline__ void gemm_phase(PG8_LAS unsigned char* lds, const Gemm g, const Sched& S, const Epi& E) {
    int tid_ = threadIdx.x; asm volatile("" : "+v"(tid_));
    const int tid = tid_, wid = __builtin_amdgcn_readfirstlane(tid >> 6), lane = tid & 63, wr = wid >> 2, wc = wid & 3, fr = lane & 15, fq = lane >> 4;
    const int K = g.K, nt = K / BK, lda = g.lda ? g.lda : K, ldb = g.ldb ? g.ldb : K;
    unsigned voffA[2], voffB[2];
#pragma unroll
    for (int i = 0; i < 2; ++i) { int R, C; stage_rc(tid * 16 + i * 8192, R, C); const int Rb = Epi::PERM ? ((R & ~31) + perm32(R & 31)) : R;
        voffA[i] = (unsigned)(R * lda + C) * 2u; voffB[i] = (unsigned)(Rb * ldb + C) * 2u; }
    const size_t kstep = (size_t)(BK * 2);
    const size_t hstepA = (size_t)HALF * lda * 2, hstepB = (size_t)HALF * ldb * 2;
    const size_t tstepA = 2 * hstepA, tstepB = 2 * hstepB;
    const unsigned ldsw = (unsigned)wid * 1024u;
    const int aoff = lds_byte(wr * 64 + fr, fq * 8), boff = lds_byte(wc * 32 + fr, fq * 8);
#define PG8_SA(b, h) (((b) * 2 + (h)) * HTB)
#define PG8_SB(b, h) ((4 + (b) * 2 + (h)) * HTB)
#define PG8_STAGE(bufoff, gbase, voff) do { _Pragma("unroll") for (int _i = 0; _i < 2; ++_i) \
        __builtin_amdgcn_global_load_lds((const unsigned*)((const char*)(gbase) + (voff)[_i]), (PG8_LAS unsigned*)(lds + (bufoff) + ldsw + _i * 8192), 16, 0, 0); } while (0)
#define PG8_LDA(dst, b, h) do { _Pragma("unroll") for (int m = 0; m < 4; ++m) _Pragma("unroll") for (int k = 0; k < 2; ++k) dst[m][k] = *(const PG8_LAS bf16x8*)(lds + PG8_SA(b, h) + aoff + m * 2048 + k * 1024); } while (0)
#define PG8_LDB(dst, b, h) do { _Pragma("unroll") for (int n = 0; n < 2; ++n) _Pragma("unroll") for (int k = 0; k < 2; ++k) dst[n][k] = *(const PG8_LAS bf16x8*)(lds + PG8_SB(b, h) + boff + n * 2048 + k * 1024); } while (0)
#define PG8_MMA(ai, bj, At, Bt) do { __builtin_amdgcn_s_setprio(1); _Pragma("unroll") for (int m = 0; m < 4; ++m) _Pragma("unroll") for (int n = 0; n < 2; ++n) _Pragma("unroll") for (int k = 0; k < 2; ++k) \
        acc[ai][bj][m][n] = __builtin_amdgcn_mfma_f32_16x16x32_bf16(Bt[n][k], At[m][k], acc[ai][bj][m][n], 0, 0, 0); __builtin_amdgcn_s_setprio(0); } while (0)
#define PG8_WAIT_V(n) asm volatile("s_waitcnt vmcnt(" #n ")" ::: "memory")
#define PG8_WAIT_L(n) asm volatile("s_waitcnt lgkmcnt(" #n ")" ::: "memory")
#define PG8_BAR __builtin_amdgcn_s_barrier()
#define PG8_SCHED __builtin_amdgcn_sched_barrier(0)
    Unit cur, nxt; int ui = 0;
    if (!S.next(0, cur)) return;
    float zz_ = 0.f; asm volatile("" : "+v"(zz_));
    f32x4 acc[2][2][4][2];
#pragma unroll
    for (int a = 0; a < 2; ++a)
#pragma unroll
        for (int b = 0; b < 2; ++b)
#pragma unroll
            for (int m = 0; m < 4; ++m)
#pragma unroll
                for (int n = 0; n < 2; ++n) acc[a][b][m][n] = (f32x4){zz_, zz_, zz_, zz_};
    bf16x8 At[4][2], B0[2][2], B1[2][2];
    const char* cA = (const char*)g.A + (size_t)cur.pm * tstepA; const char* cB = (const char*)g.Bt + (size_t)cur.pn * tstepB;
    S.a_ready(cur);
    if constexpr (SP2) {
        PG8_STAGE(PG8_SB(0, 0), cB, voffB); PG8_STAGE(PG8_SB(0, 1), cB + hstepB, voffB); PG8_STAGE(PG8_SA(0, 0), cA, voffA); PG8_STAGE(PG8_SA(0, 1), cA + hstepA, voffA);
        if (wr == 1) PG8_BAR;
        PG8_WAIT_V(2); PG8_BAR;
        PG8_STAGE(PG8_SB(1, 0), cB + kstep, voffB); PG8_STAGE(PG8_SA(1, 0), cA + kstep, voffA); PG8_STAGE(PG8_SB(1, 1), cB + hstepB + kstep, voffB);
        PG8_WAIT_V(6); PG8_BAR;
    } else {
        PG8_STAGE(PG8_SB(0, 0), cB, voffB); PG8_STAGE(PG8_SA(0, 0), cA, voffA); PG8_STAGE(PG8_SB(0, 1), cB + hstepB, voffB); PG8_STAGE(PG8_SA(0, 1), cA + hstepA, voffA);
        if (wr == 1) PG8_BAR;
        PG8_WAIT_V(4); PG8_BAR;
        PG8_STAGE(PG8_SB(1, 0), cB + kstep, voffB); PG8_STAGE(PG8_SA(1, 0), cA + kstep, voffA); PG8_STAGE(PG8_SB(1, 1), cB + hstepB + kstep, voffB);
        PG8_WAIT_V(6); PG8_BAR;
    }
    for (;;) {
        const bool has_next = S.next(ui + 1, nxt);
        const char* nA = has_next ? (const char*)g.A + (size_t)nxt.pm * tstepA : cA; const char* nB = has_next ? (const char*)g.Bt + (size_t)nxt.pn * tstepB : cB;
        for (int t = 0; t < nt; t += 2) {
            const bool last = (t == nt - 2);
            const char* a1 = cA + (size_t)(t + 1) * kstep;
            const char* a2 = last ? nA : cA + (size_t)(t + 2) * kstep; const char* b2 = last ? nB : cB + (size_t)(t + 2) * kstep;
            const char* a3 = a2 + kstep; const char* b3 = b2 + kstep;
            if (last && has_next) S.a_ready(nxt);
            if constexpr (SP2) {
            PG8_LDB(B0, 0, 0); PG8_LDB(B1, 0, 1); PG8_SCHED; PG8_LDA(At, 0, 0); PG8_STAGE(PG8_SA(1, 1), a1 + hstepA, voffA);
            PG8_WAIT_V(8); PG8_WAIT_L(0); PG8_BAR; PG8_MMA(0, 0, At, B0); PG8_MMA(0, 1, At, B1); PG8_BAR; PG8_SCHED;
            PG8_LDA(At, 0, 1); PG8_STAGE(PG8_SB(0, 0), b2, voffB); PG8_STAGE(PG8_SB(0, 1), b2 + hstepB, voffB); PG8_STAGE(PG8_SA(0, 0), a2, voffA);
            PG8_WAIT_V(8); PG8_WAIT_L(0); PG8_BAR; PG8_MMA(1, 0, At, B0); PG8_MMA(1, 1, At, B1); PG8_BAR; PG8_SCHED;
            PG8_LDB(B0, 1, 0); PG8_LDB(B1, 1, 1); PG8_SCHED; PG8_LDA(At, 1, 0); PG8_STAGE(PG8_SA(0, 1), a2 + hstepA, voffA);
            PG8_WAIT_V(8); PG8_WAIT_L(0); PG8_BAR; PG8_MMA(0, 0, At, B0); PG8_MMA(0, 1, At, B1); PG8_BAR; PG8_SCHED;
            PG8_LDA(At, 1, 1); PG8_STAGE(PG8_SB(1, 0), b3, voffB); PG8_STAGE(PG8_SB(1, 1), b3 + hstepB, voffB); PG8_STAGE(PG8_SA(1, 0), a3, voffA);
            PG8_WAIT_V(8); PG8_WAIT_L(0); PG8_BAR; PG8_MMA(1, 0, At, B0); PG8_MMA(1, 1, At, B1); PG8_BAR; PG8_SCHED;
            } else {
            PG8_LDB(B0, 0, 0); PG8_SCHED; PG8_LDA(At, 0, 0); PG8_STAGE(PG8_SA(1, 1), a1 + hstepA, voffA);
            PG8_WAIT_L(8); PG8_BAR; PG8_WAIT_L(0); PG8_MMA(0, 0, At, B0); PG8_BAR; PG8_SCHED;
            PG8_LDB(B1, 0, 1); PG8_STAGE(PG8_SB(0, 0), b2, voffB);
            PG8_BAR; PG8_WAIT_L(0); PG8_MMA(0, 1, At, B1); PG8_BAR;
            PG8_LDA(At, 0, 1); PG8_STAGE(PG8_SA(0, 0), a2, voffA);
            PG8_BAR; PG8_WAIT_L(0); PG8_MMA(1, 0, At, B0); PG8_BAR; PG8_SCHED;
            PG8_STAGE(PG8_SB(0, 1), b2 + hstepB, voffB);
            PG8_WAIT_V(6); PG8_BAR; PG8_MMA(1, 1, At, B1); PG8_BAR;
            PG8_LDB(B0, 1, 0); PG8_SCHED; PG8_LDA(At, 1, 0); PG8_STAGE(PG8_SA(0, 1), a2 + hstepA, voffA);
            PG8_WAIT_L(8); PG8_BAR; PG8_WAIT_L(0); PG8_MMA(0, 0, At, B0); PG8_BAR; PG8_SCHED;
            PG8_LDB(B1, 1, 1); PG8_STAGE(PG8_SB(1, 0), b3, voffB);
            PG8_BAR; PG8_WAIT_L(0); PG8_MMA(0, 1, At, B1); PG8_BAR;
            PG8_LDA(At, 1, 1); PG8_STAGE(PG8_SA(1, 0), a3, voffA);
            PG8_BAR; PG8_WAIT_L(0); PG8_MMA(1, 0, At, B0); PG8_BAR; PG8_SCHED;
            PG8_STAGE(PG8_SB(1, 1), b3 + hstepB, voffB);
            PG8_WAIT_V(6); PG8_BAR; PG8_MMA(1, 1, At, B1); PG8_BAR;
            }
        }
        if constexpr (ALIGN_EPI) { if (wr == 0) PG8_BAR; }
        if constexpr (!Epi::AFTER_DRAIN) { E(acc, cur, wr, wc, fr, fq); S.done(cur); }
        if (!has_next) break;
#pragma unroll
        for (int a = 0; a < 2; ++a)
#pragma unroll
            for (int b = 0; b < 2; ++b)
#pragma unroll
                for (int m = 0; m < 4; ++m)
#pragma unroll
                    for (int n = 0; n < 2; ++n) acc[a][b][m][n] = (f32x4){zz_, zz_, zz_, zz_};
        cur = nxt; cA = nA; cB = nB; ++ui;
        if constexpr (ALIGN_EPI) { if (wr == 1) PG8_BAR; }
    }
    PG8_WAIT_V(0);
    if constexpr (!ALIGN_EPI) { if (wr == 0) PG8_BAR; }
    PG8_BAR;
    if constexpr (Epi::AFTER_DRAIN) { E.fused(acc, cur, wr, wc, fr, fq, lds, wid, lane); S.done(cur); }
#undef PG8_SA
#undef PG8_SB
#undef PG8_STAGE
#undef PG8_LDA
#undef PG8_LDB
#undef PG8_MMA
#undef PG8_WAIT_V
#undef PG8_WAIT_L
#undef PG8_BAR
#undef PG8_SCHED
}
}
#define XB_TMO      128
#define XB_XCNT(j)  (256  + 64 * (j))
#define XB_XSUB(j)  (1280 + 64 * (j))
#define XB_XGEN(j)  (2304 + 64 * (j))
#define XB_TOP      3328
#define XB_TOPGEN   3392
#define XCD_BAR_WORDS 3456
#define XB_SPIN_CAP (1u << 18)

__device__ __forceinline__ unsigned xb_ld(unsigned* p)              { return __hip_atomic_load(p, __ATOMIC_RELAXED, __HIP_MEMORY_SCOPE_AGENT); }
__device__ __forceinline__ unsigned xb_add(unsigned* p, unsigned v) { return __hip_atomic_fetch_add(p, v, __ATOMIC_RELAXED, __HIP_MEMORY_SCOPE_AGENT); }
__device__ __forceinline__ unsigned xb_xcc_id() { return (unsigned)__builtin_amdgcn_s_getreg((3 << 11) | 20) & 0xFu; }
#define XB_SPIN(cond, bar) do { unsigned _sp = 0; while (cond) { __builtin_amdgcn_s_sleep(1); \
    if ((++_sp & 255u) == 0u) { if (xb_ld(&(bar)[XB_TMO])) break; if (_sp > XB_SPIN_CAP) { atomicAdd(&(bar)[XB_TMO], 1u); break; } } } } while (0)

struct XcdBarrier {
    unsigned* bar; unsigned x;
    volatile LAS unsigned* st;
};

__device__ __forceinline__ XcdBarrier xcd_barrier_post(unsigned* bar, volatile LAS unsigned* st) {
    XcdBarrier b; b.bar = bar; b.x = xb_xcc_id(); b.st = st;
    if (threadIdx.x == 0) (void)xb_add(&bar[XB_XCNT(b.x)], 1u);
    return b;
}
__device__ __forceinline__ void xcd_barrier_complete(unsigned* bar, unsigned x, unsigned& nloc, unsigned& nx) {
    const unsigned G = gridDim.x * gridDim.y * gridDim.z;
    unsigned sum, cnt, mine, sp = 0u;
    for (;;) {
        sum = 0u; cnt = 0u; mine = 0u;
#pragma unroll
        for (unsigned j = 0; j < 16; ++j) { const unsigned c = xb_ld(&bar[XB_XCNT(j)]); sum += c; cnt += (c > 0u) ? 1u : 0u; mine = (j == x) ? c : mine; }
        if (sum == G) break;
        __builtin_amdgcn_s_sleep(1);
        if ((++sp & 255u) == 0u) { if (xb_ld(&bar[XB_TMO])) break; if (sp > XB_SPIN_CAP) { atomicAdd(&bar[XB_TMO], 1u); break; } }
    }
    nloc = mine > 0u ? mine : 1u; nx = cnt > 0u ? cnt : 1u;
}

__device__ __forceinline__ void xcd_barrier(const XcdBarrier& b) {
    asm volatile("s_waitcnt vmcnt(0)" ::: "memory");
    __syncthreads();
    if (threadIdx.x == 0) {
        unsigned* bar = b.bar;
        __builtin_amdgcn_s_waitcnt(0);
        unsigned nloc = b.st[0], nx = b.st[1];
        if (nloc == 0u) { xcd_barrier_complete(bar, b.x, nloc, nx); b.st[0] = nloc; b.st[1] = nx; }
        const unsigned old = xb_add(&bar[XB_XSUB(b.x)], 1u);
        const unsigned gen = old / nloc;
        if (old + 1u == (gen + 1u) * nloc) {
            __builtin_amdgcn_fence(__ATOMIC_RELEASE, "agent");
            asm volatile("s_waitcnt vmcnt(0)" ::: "memory");
            const unsigned og = xb_add(&bar[XB_TOP], 1u);
            const unsigned tg = og / nx;
            if (og + 1u == (tg + 1u) * nx) xb_add(&bar[XB_TOPGEN], 1u);
            else XB_SPIN(xb_ld(&bar[XB_TOPGEN]) == tg, bar);
            __builtin_amdgcn_fence(__ATOMIC_ACQUIRE, "agent");
            xb_add(&bar[XB_XGEN(b.x)], 1u);
            asm volatile("s_waitcnt vmcnt(0)" ::: "memory");
        } else {
            XB_SPIN(xb_ld(&bar[XB_XGEN(b.x)]) == gen, bar);
            __builtin_amdgcn_fence(__ATOMIC_ACQUIRE, "agent");
            asm volatile("s_waitcnt vmcnt(0)" ::: "memory");
        }
    }
    __syncthreads();
}

namespace pg8 {
typedef unsigned u32x4e __attribute__((ext_vector_type(4)));
typedef int i32x4e __attribute__((ext_vector_type(4)));
__device__ __forceinline__ __amdgpu_buffer_rsrc_t wt_rsrc(const void* base) {
    const unsigned long long b = (unsigned long long)base;
    void* ub = (void*)(((unsigned long long)(unsigned)__builtin_amdgcn_readfirstlane((int)(b >> 32)) << 32) | (unsigned)__builtin_amdgcn_readfirstlane((int)b));
    return __builtin_amdgcn_make_buffer_rsrc(ub, (short)0, (int)0x7ffffff0, 0x00020000); }
__device__ __forceinline__ void st16_wt(__amdgpu_buffer_rsrc_t r, unsigned off, u32x4e w) { __builtin_amdgcn_raw_buffer_store_b128(w, r, (int)off, 0, 16); }
struct EpiPlain {
    static constexpr bool PERM = true, AFTER_DRAIN = false;
    bf16_t* O; int ld;
    __device__ __forceinline__ void operator()(const f32x4 (&acc)[2][2][4][2], const Unit& u, int wr, int wc, int fr, int fq) const {
        bf16_t* base = O + (size_t)(u.pm * BM + wr * 64 + fr) * ld + u.pn * BM + wc * 32 + 8 * fq;
        const bf16_t* wt_base_ = O; const __amdgpu_buffer_rsrc_t wt_r_ = wt_rsrc(wt_base_);
#pragma unroll
        for (int ai = 0; ai < 2; ++ai)
#pragma unroll
            for (int m = 0; m < 4; ++m) { bf16_t* rowp = base + (size_t)(ai * HALF + m * 16) * ld;
#pragma unroll
                for (int bj = 0; bj < 2; ++bj) { const f32x4 v0 = acc[ai][bj][m][0], v1 = acc[ai][bj][m][1];
                    u32x4e w; w.x = cvt_pk_bf16(v0[0], v0[1]); w.y = cvt_pk_bf16(v0[2], v0[3]); w.z = cvt_pk_bf16(v1[0], v1[1]); w.w = cvt_pk_bf16(v1[2], v1[3]);
                    st16_wt(wt_r_, (unsigned)((const char*)(rowp + bj * HALF) - (const char*)wt_base_), w); } }
    }
};
struct EpiProj {
    static constexpr bool PERM = true, AFTER_DRAIN = false;
    bf16_t* ck;
    bf16_t* oq; bf16_t* kv;
    int Mrows;
    __device__ __forceinline__ void operator()(const f32x4 (&acc)[2][2][4][2], const Unit& u, int wr, int wc, int fr, int fq) const {
        const int pn = u.pn; const size_t MS = (size_t)Mrows * 512;
        bf16_t* dst; int ld, c0;
        if (pn < 2)       { dst = oq;            ld = 512; c0 = pn * 256; }
        else if (pn < 4)  { dst = kv;            ld = 512; c0 = (pn - 2) * 256; }
        else if (pn < 6)  { dst = kv + MS;       ld = 512; c0 = (pn - 4) * 256; }
        else if (pn < 8)  { dst = oq + MS;       ld = 512; c0 = (pn - 6) * 256; }
        else if (pn < 11) { dst = kv + 4 * MS;   ld = 768; c0 = (pn - 8) * 256; }
        else if (pn < 13) { dst = oq + 2 * MS;   ld = 512; c0 = (pn - 11) * 256; }
        else if (pn < 15) { dst = kv + 2 * MS;   ld = 512; c0 = (pn - 13) * 256; }
        else if (pn < 17) { dst = kv + 3 * MS;   ld = 512; c0 = (pn - 15) * 256; }
        else              { dst = kv + 4 * MS + (size_t)Mrows * 768; ld = 256; c0 = 0; }
        bf16_t* base = dst + (size_t)(u.pm * BM + wr * 64 + fr) * ld + c0 + wc * 32 + 8 * fq;
        size_t bjs = HALF;
        if (pn == 8) {
            base = ck + ((size_t)(wc >> 1) * Mrows + (size_t)(u.pm * BM + wr * 64 + fr)) * 64 + (wc & 1) * 32 + 8 * fq; ld = 64; bjs = (size_t)2 * Mrows * 64; }
        const bf16_t* wt_base_ = (pn == 8 ? ck : dst); const __amdgpu_buffer_rsrc_t wt_r_ = wt_rsrc(wt_base_);
#pragma unroll
        for (int ai = 0; ai < 2; ++ai)
#pragma unroll
            for (int m = 0; m < 4; ++m) { bf16_t* rowp = base + (size_t)(ai * HALF + m * 16) * ld;
#pragma unroll
                for (int bj = 0; bj < 2; ++bj) { const f32x4 v0 = acc[ai][bj][m][0], v1 = acc[ai][bj][m][1];
                    u32x4e w; w.x = cvt_pk_bf16(v0[0], v0[1]); w.y = cvt_pk_bf16(v0[2], v0[3]); w.z = cvt_pk_bf16(v1[0], v1[1]); w.w = cvt_pk_bf16(v1[2], v1[3]);
                    st16_wt(wt_r_, (unsigned)((const char*)(rowp + bj * bjs) - (const char*)wt_base_), w); } }
    }
};
__device__ __forceinline__ float sigmoidf_(float x) { return __builtin_amdgcn_rcpf(1.0f + __expf(-x)); }
struct EpiSigmoid {
    static constexpr bool PERM = true, AFTER_DRAIN = false;
    bf16_t* O; int ld;
    __device__ __forceinline__ void operator()(const f32x4 (&acc)[2][2][4][2], const Unit& u, int wr, int wc, int fr, int fq) const {
        bf16_t* base = O + (size_t)(u.pm * BM + wr * 64 + fr) * ld + u.pn * BM + wc * 32 + 8 * fq;
#pragma unroll
        for (int ai = 0; ai < 2; ++ai)
#pragma unroll
            for (int m = 0; m < 4; ++m) { bf16_t* rowp = base + (size_t)(ai * HALF + m * 16) * ld;
#pragma unroll
                for (int bj = 0; bj < 2; ++bj) { f32x4 v0 = acc[ai][bj][m][0], v1 = acc[ai][bj][m][1];
#pragma unroll
                    for (int e = 0; e < 4; ++e) { v0[e] = sigmoidf_(v0[e]); v1[e] = sigmoidf_(v1[e]); }
                    u32x4e w; w.x = cvt_pk_bf16(v0[0], v0[1]); w.y = cvt_pk_bf16(v0[2], v0[3]); w.z = cvt_pk_bf16(v1[0], v1[1]); w.w = cvt_pk_bf16(v1[2], v1[3]);
                    *(u32x4e*)(rowp + bj * HALF) = w; } }
    }
};
struct EpiGateY {
    static constexpr bool PERM = true, AFTER_DRAIN = false;
    const bf16_t* MG; bf16_t* Y; bool dry;
    __device__ __forceinline__ void operator()(const f32x4 (&acc)[2][2][4][2], const Unit& u, int wr, int wc, int fr, int fq) const {
        const int branch = u.pm >> 6, pmr = u.pm & 63, pnr = u.pn & 3;
        const size_t r0 = (size_t)(pmr * BM + wr * 64 + fr); const int c0 = pnr * BM + wc * 32 + 8 * fq;
#pragma unroll
        for (int ai = 0; ai < 2; ++ai)
#pragma unroll
            for (int m = 0; m < 4; ++m) { const size_t row = r0 + ai * HALF + m * 16;
#pragma unroll
                for (int bj = 0; bj < 2; ++bj) { const f32x4 v0 = acc[ai][bj][m][0], v1 = acc[ai][bj][m][1];
                    const u32x4e g = *(const u32x4e*)(MG + row * 3072 + branch * 1024 + c0 + bj * HALF);
                    bf16_t* yp = Y + row * 1024 + c0 + bj * HALF;
                    float y[8];
                    y[0] = v0[0] * __uint_as_float(g.x << 16); y[1] = v0[1] * __uint_as_float(g.x & 0xffff0000u); y[2] = v0[2] * __uint_as_float(g.y << 16); y[3] = v0[3] * __uint_as_float(g.y & 0xffff0000u);
                    y[4] = v1[0] * __uint_as_float(g.z << 16); y[5] = v1[1] * __uint_as_float(g.z & 0xffff0000u); y[6] = v1[2] * __uint_as_float(g.w << 16); y[7] = v1[3] * __uint_as_float(g.w & 0xffff0000u);
                    if (branch != 0) { const u32x4e p = *(const u32x4e*)yp;
                        y[0] += __uint_as_float(p.x << 16); y[1] += __uint_as_float(p.x & 0xffff0000u); y[2] += __uint_as_float(p.y << 16); y[3] += __uint_as_float(p.y & 0xffff0000u);
                        y[4] += __uint_as_float(p.z << 16); y[5] += __uint_as_float(p.z & 0xffff0000u); y[6] += __uint_as_float(p.w << 16); y[7] += __uint_as_float(p.w & 0xffff0000u); }
                    u32x4e w; w.x = cvt_pk_bf16(y[0], y[1]); w.y = cvt_pk_bf16(y[2], y[3]); w.z = cvt_pk_bf16(y[4], y[5]); w.w = cvt_pk_bf16(y[6], y[7]);
                    if (!dry) *(u32x4e*)yp = w; } }
    }
};
struct EpiUpU {
    static constexpr bool PERM = true, AFTER_DRAIN = false;
    bf16_t* U;
    __device__ __forceinline__ void operator()(const f32x4 (&acc)[2][2][4][2], const Unit& u, int wr, int wc, int fr, int fq) const {
        const int pmr = u.pm & 63;
        bf16_t* base = U + (size_t)(pmr * BM + wr * 64 + fr) * 3072 + u.pn * BM + wc * 32 + 8 * fq;
        const bf16_t* wt_base_ = U; const __amdgpu_buffer_rsrc_t wt_r_ = wt_rsrc(wt_base_);
#pragma unroll
        for (int ai = 0; ai < 2; ++ai)
#pragma unroll
            for (int m = 0; m < 4; ++m) { bf16_t* rowp = base + (size_t)(ai * HALF + m * 16) * 3072;
#pragma unroll
                for (int bj = 0; bj < 2; ++bj) { const f32x4 v0 = acc[ai][bj][m][0], v1 = acc[ai][bj][m][1];
                    u32x4e w; w.x = cvt_pk_bf16(v0[0], v0[1]); w.y = cvt_pk_bf16(v0[2], v0[3]); w.z = cvt_pk_bf16(v1[0], v1[1]); w.w = cvt_pk_bf16(v1[2], v1[3]);
                    st16_wt(wt_r_, (unsigned)((const char*)(rowp + bj * HALF) - (const char*)wt_base_), w); } }
    }
};
struct EpiGateY2 {
    static constexpr bool PERM = true, AFTER_DRAIN = false;
    const bf16_t* U; bf16_t* Y; bool dry;
    __device__ __forceinline__ void operator()(const f32x4 (&acc)[2][2][4][2], const Unit& u, int wr, int wc, int fr, int fq) const {
        const int branch = u.pn >> 2, pnr = u.pn & 3;
        const size_t r0 = (size_t)(u.pm * BM + wr * 64 + fr); const int c0 = pnr * BM + wc * 32 + 8 * fq;
        const __amdgpu_buffer_rsrc_t yr_ = wt_rsrc(Y);
#pragma unroll
        for (int ai = 0; ai < 2; ++ai)
#pragma unroll
            for (int m = 0; m < 4; ++m) { const size_t row = r0 + ai * HALF + m * 16;
#pragma unroll
                for (int bj = 0; bj < 2; ++bj) { const f32x4 v0 = acc[ai][bj][m][0], v1 = acc[ai][bj][m][1];
                    const u32x4e g = __builtin_nontemporal_load((const u32x4e*)(U + row * 3072 + branch * 1024 + c0 + bj * HALF));
                    bf16_t* yp = Y + row * 1024 + c0 + bj * HALF;
                    float y[8];
                    y[0] = sigmoidf_(v0[0]) * __uint_as_float(g.x << 16); y[1] = sigmoidf_(v0[1]) * __uint_as_float(g.x & 0xffff0000u); y[2] = sigmoidf_(v0[2]) * __uint_as_float(g.y << 16); y[3] = sigmoidf_(v0[3]) * __uint_as_float(g.y & 0xffff0000u);
                    y[4] = sigmoidf_(v1[0]) * __uint_as_float(g.z << 16); y[5] = sigmoidf_(v1[1]) * __uint_as_float(g.z & 0xffff0000u); y[6] = sigmoidf_(v1[2]) * __uint_as_float(g.w << 16); y[7] = sigmoidf_(v1[3]) * __uint_as_float(g.w & 0xffff0000u);
                    if (branch != 0) { const u32x4e p = *(const u32x4e*)yp;
                        y[0] += __uint_as_float(p.x << 16); y[1] += __uint_as_float(p.x & 0xffff0000u); y[2] += __uint_as_float(p.y << 16); y[3] += __uint_as_float(p.y & 0xffff0000u);
                        y[4] += __uint_as_float(p.z << 16); y[5] += __uint_as_float(p.z & 0xffff0000u); y[6] += __uint_as_float(p.w << 16); y[7] += __uint_as_float(p.w & 0xffff0000u); }
                    u32x4e w; w.x = cvt_pk_bf16(y[0], y[1]); w.y = cvt_pk_bf16(y[2], y[3]); w.z = cvt_pk_bf16(y[4], y[5]); w.w = cvt_pk_bf16(y[6], y[7]);
                    if (!dry) st16_wt(yr_, (unsigned)((const char*)yp - (const char*)Y), w); } }
    }
};
struct OneOrder {
    int pm, pn;
    __host__ __device__ bool next(int i, Unit& u) const { if (i > 0) return false; u.pm = pm; u.pn = pn; return true; }
    __device__ __forceinline__ void a_ready(const Unit&) const {}
    __device__ __forceinline__ void done(const Unit&) const {}
};
struct EpiUpT {
    static constexpr bool PERM = true, AFTER_DRAIN = false;
    bf16_t* T;
    __device__ __forceinline__ void operator()(const f32x4 (&acc)[2][2][4][2], const Unit& u, int wr, int wc, int fr, int fq) const {
        bf16_t* base = T + (size_t)(wr * 64 + fr) * 256 + wc * 32 + 8 * fq;
#pragma unroll
        for (int ai = 0; ai < 2; ++ai)
#pragma unroll
            for (int m = 0; m < 4; ++m) { bf16_t* rowp = base + (size_t)(ai * HALF + m * 16) * 256;
#pragma unroll
                for (int bj = 0; bj < 2; ++bj) { const f32x4 v0 = acc[ai][bj][m][0], v1 = acc[ai][bj][m][1];
                    u32x4e w; w.x = cvt_pk_bf16(v0[0], v0[1]); w.y = cvt_pk_bf16(v0[2], v0[3]); w.z = cvt_pk_bf16(v1[0], v1[1]); w.w = cvt_pk_bf16(v1[2], v1[3]);
                    *(u32x4e*)(rowp + bj * HALF) = w; } }
    }
};
struct EpiGateT {
    static constexpr bool PERM = true, AFTER_DRAIN = false;
    const bf16_t* T; bf16_t* Y; int branch; bool dry;
    __device__ __forceinline__ void operator()(const f32x4 (&acc)[2][2][4][2], const Unit& u, int wr, int wc, int fr, int fq) const {
        const int pnr = u.pn & 3;
        const size_t r0 = (size_t)(u.pm * BM + wr * 64 + fr); const int c0 = pnr * BM + wc * 32 + 8 * fq;
        const bf16_t* tb = T + (size_t)(wr * 64 + fr) * 256 + wc * 32 + 8 * fq;
        const __amdgpu_buffer_rsrc_t yr_ = wt_rsrc(Y);
#pragma unroll
        for (int ai = 0; ai < 2; ++ai) {
            u32x4e g[8], p[8];
#pragma unroll
            for (int m = 0; m < 4; ++m)
#pragma unroll
                for (int bj = 0; bj < 2; ++bj) g[2 * m + bj] = *(const u32x4e*)(tb + (size_t)(ai * HALF + m * 16) * 256 + bj * HALF);
            if (branch != 0) {
#pragma unroll
                for (int m = 0; m < 4; ++m)
#pragma unroll
                    for (int bj = 0; bj < 2; ++bj) p[2 * m + bj] = *(const u32x4e*)(Y + (r0 + ai * HALF + m * 16) * 1024 + c0 + bj * HALF);
            }
#pragma unroll
            for (int m = 0; m < 4; ++m) { const size_t row = r0 + ai * HALF + m * 16;
#pragma unroll
                for (int bj = 0; bj < 2; ++bj) { const f32x4 v0 = acc[ai][bj][m][0], v1 = acc[ai][bj][m][1];
                    const u32x4e gg = g[2 * m + bj];
                    bf16_t* yp = Y + row * 1024 + c0 + bj * HALF;
                    float y[8];
                    y[0] = sigmoidf_(v0[0]) * __uint_as_float(gg.x << 16); y[1] = sigmoidf_(v0[1]) * __uint_as_float(gg.x & 0xffff0000u); y[2] = sigmoidf_(v0[2]) * __uint_as_float(gg.y << 16); y[3] = sigmoidf_(v0[3]) * __uint_as_float(gg.y & 0xffff0000u);
                    y[4] = sigmoidf_(v1[0]) * __uint_as_float(gg.z << 16); y[5] = sigmoidf_(v1[1]) * __uint_as_float(gg.z & 0xffff0000u); y[6] = sigmoidf_(v1[2]) * __uint_as_float(gg.w << 16); y[7] = sigmoidf_(v1[3]) * __uint_as_float(gg.w & 0xffff0000u);
                    if (branch != 0) { const u32x4e pp = p[2 * m + bj];
                        y[0] += __uint_as_float(pp.x << 16); y[1] += __uint_as_float(pp.x & 0xffff0000u); y[2] += __uint_as_float(pp.y << 16); y[3] += __uint_as_float(pp.y & 0xffff0000u);
                        y[4] += __uint_as_float(pp.z << 16); y[5] += __uint_as_float(pp.z & 0xffff0000u); y[6] += __uint_as_float(pp.w << 16); y[7] += __uint_as_float(pp.w & 0xffff0000u); }
                    u32x4e w; w.x = cvt_pk_bf16(y[0], y[1]); w.y = cvt_pk_bf16(y[2], y[3]); w.z = cvt_pk_bf16(y[4], y[5]); w.w = cvt_pk_bf16(y[6], y[7]);
                    if (!dry) { if (branch == 2) st16_wt(yr_, (unsigned)((const char*)yp - (const char*)Y), w); else *(u32x4e*)yp = w; } } }
        }
    }
};
struct MergeOrder {
    StaticOrder so; int G, c;
    __host__ __device__ void init(int M_, int G_, int c_) { so.init(M_, 1024, 256, 0); G = G_; c = c_; }
    __host__ __device__ bool next(int i, Unit& u) const {
        const int tile = c + (i / 3) * G, branch = i % 3; if (tile >= 256) return false;
        StaticOrder t = so; t.c = tile; Unit v; t.next(0, v);
        u.pm = v.pm; u.pn = branch * 4 + v.pn; return true;
    }
    __device__ __forceinline__ void a_ready(const Unit&) const {}
    __device__ __forceinline__ void done(const Unit&) const {}
};
struct EpiSwiglu {
    static constexpr bool PERM = true, AFTER_DRAIN = false;
    bf16_t* O; int ld;
    __device__ __forceinline__ void operator()(const f32x4 (&acc)[2][2][4][2], const Unit& u, int wr, int wc, int fr, int fq) const {
        bf16_t* base = O + (size_t)(u.pm * BM + wr * 64 + fr) * ld + u.pn * HALF + wc * 32 + 8 * fq;
        const bf16_t* wt_base_ = O; const __amdgpu_buffer_rsrc_t wt_r_ = wt_rsrc(wt_base_);
#pragma unroll
        for (int ai = 0; ai < 2; ++ai)
#pragma unroll
            for (int m = 0; m < 4; ++m) { bf16_t* rowp = base + (size_t)(ai * HALF + m * 16) * ld;
                f32x4 v0 = acc[ai][0][m][0], v1 = acc[ai][0][m][1]; const f32x4 u0 = acc[ai][1][m][0], u1 = acc[ai][1][m][1];
#pragma unroll
                for (int e = 0; e < 4; ++e) { v0[e] = v0[e] * sigmoidf_(v0[e]) * u0[e]; v1[e] = v1[e] * sigmoidf_(v1[e]) * u1[e]; }
                u32x4e w; w.x = cvt_pk_bf16(v0[0], v0[1]); w.y = cvt_pk_bf16(v0[2], v0[3]); w.z = cvt_pk_bf16(v1[0], v1[1]); w.w = cvt_pk_bf16(v1[2], v1[3]);
                st16_wt(wt_r_, (unsigned)((const char*)rowp - (const char*)wt_base_), w); }
    }
};
struct UpOrder {
    StaticOrder so; int G, c;
    __host__ __device__ void init(int M_, int G_, int c_) { so.init(M_, 1024, 256, 0); G = G_; c = c_; }
    __host__ __device__ bool next(int i, Unit& u) const {
        const int tile = c + (i / 3) * G, branch = i % 3; if (tile >= 256) return false;
        StaticOrder t = so; t.c = tile; Unit v; t.next(0, v);
        u.pm = branch * 64 + v.pm; u.pn = branch * 4 + v.pn; return true;
    }
    __device__ __forceinline__ void a_ready(const Unit&) const {}
    __device__ __forceinline__ void done(const Unit&) const {}
};
}

constexpr int NB = 8, SEQ = 2048, DM = 1024, M = NB * SEQ;
constexpr int NMEM = 256, MMEM = NB * NMEM;
constexpr int DFF = 2816, DIN = 7456, NA = 4608;
constexpr float RMS_EPS = 1e-6f;
constexpr int NWAVES = 8, NTHREADS = 512;

constexpr size_t MiB = 1u << 20;
constexpr size_t WS_CTL = 0, CTL_ZERO_BYTES = 64 * 1024;
constexpr size_t WS_W = 1 * MiB;
constexpr size_t W_A = WS_W, W_M = W_A + (size_t)NA * 1024 * 2, W_C1K = W_M + 3072ull * 1024 * 2, W_C1V = W_C1K + 512ull * 1024 * 2,
                 W_UP = W_C1V + 512ull * 1024 * 2, W_OUT3 = W_UP + 3072ull * 512 * 2, W_MQ = W_OUT3 + 1024ull * 3072 * 2, W_MKV = W_MQ + 256ull * 1024 * 2,
                 W_MO = W_MKV + 512ull * 1024 * 2, W_GU = W_MO + 1024ull * 256 * 2, W_DN = W_GU + 5632ull * 1024 * 2, W_B1PART = W_DN + 1024ull * 2816 * 2,
                 W_END = W_B1PART + 2ull * 32 * 256 * 4;
constexpr size_t WS_H = 47 * MiB;
constexpr size_t WS_OQ = 79 * MiB;
constexpr size_t WS_KV = 127 * MiB;
constexpr size_t WS_Y = WS_KV + 32 * MiB;
constexpr size_t WS_MG = WS_KV;
constexpr size_t WS_ACT = WS_OQ;
constexpr size_t WS_MQ = WS_OQ, WS_MO = WS_OQ + 32 * MiB;
constexpr size_t WS_MISC = 223 * MiB;
constexpr size_t WS_CF = WS_MISC;
constexpr size_t WS_KCMP = WS_CF + 512 * 1024, WS_VCMP = WS_KCMP + 256 * 1024, WS_SELM = WS_VCMP + 256 * 1024;
constexpr size_t WS_MEMN = WS_MISC + 3 * MiB / 2;
constexpr size_t WS_MEMKV = WS_MEMN + 4 * MiB;
constexpr size_t WS_PSLC = WS_MEMKV + 2 * MiB;
constexpr size_t WS_OCMP = WS_PSLC + 4 * MiB;
constexpr size_t WS_CK = WS_OCMP, WS_CV = WS_CK + 4 * MiB, WS_PK = WS_CV + 4 * MiB, WS_PV = WS_PK + 2 * MiB;
constexpr size_t WS_END = WS_OCMP + 16 * MiB;
static_assert(W_END <= WS_H && WS_H + 32 * MiB == WS_OQ && WS_OQ + 48 * MiB == WS_KV && WS_KV + 96 * MiB == WS_MISC && WS_END <= 256 * MiB && WS_PV + 2 * MiB <= WS_END, "ws map");
constexpr int CW_BAR = 4096, CW_SB = 8192, CW_CVB = 8192 + 32 * 64;

typedef unsigned short bf16;
typedef float f32x4 __attribute__((ext_vector_type(4)));
typedef unsigned u32x4 __attribute__((ext_vector_type(4)));
typedef unsigned u32x2 __attribute__((ext_vector_type(2)));

__device__ __forceinline__ float bf2f(unsigned short b) { return __uint_as_float((unsigned)b << 16); }
__device__ __forceinline__ unsigned pk2(float lo, float hi) { return pg8::cvt_pk_bf16(lo, hi); }
__device__ __forceinline__ unsigned short f2bf(float f) { return (unsigned short)(pk2(f, 0.f) & 0xffffu); }
__device__ __forceinline__ float wave_sum(float v) {
#pragma unroll
    for (int o = 1; o < 64; o <<= 1) v += __shfl_xor(v, o);
    return v;
}
__device__ __forceinline__ float sigm(float x) { return __builtin_amdgcn_rcpf(1.0f + __expf(-x)); }
__device__ __forceinline__ float logsig(float x) { return fminf(x, 0.f) - log1pf(__expf(-fabsf(x))); }

struct Args { const void* in[31]; float* out; unsigned char* ws; int ph_lo, ph_hi; };

struct MapOff { int off; float s; __device__ __forceinline__ int row(int n) const { return n + off; } __device__ __forceinline__ float sc(int) const { return s; } };
struct MapA {
    __device__ __forceinline__ int row(int n) const { return n < 2816 ? n : (n < 2840 ? n + 1536 : (n < 4376 ? n - 24 : n)); }
    __device__ __forceinline__ float sc(int n) const { return (n < 512 || (n >= 1536 && n < 2048) || (n >= 2840 && n < 3352)) ? 0.125f : 1.0f; }
};
struct MapGU { int half; __device__ __forceinline__ int row(int n) const { return (n >> 7) * 256 + half * 128 + (n & 127); } __device__ __forceinline__ float sc(int) const { return 1.0f; } };

template <class Map>
__device__ __forceinline__ void conv_item(const float* W, int N, int ldw, bf16* WT, int ldt, int dk0, const Map map, LAS float* scr, int it, int lane) {
    const int nblk = N / 32, kb = it / nblk, nb = it % nblk, k0 = 64 * kb, n0 = 32 * nb;
    const float* src = W + (size_t)(k0 + (lane >> 3)) * ldw + n0 + 4 * (lane & 7);
    f32x4 v[8];
#pragma unroll
    for (int i = 0; i < 8; ++i) v[i] = *(const f32x4*)(src + (size_t)(8 * i) * ldw);
#pragma unroll
    for (int i = 0; i < 8; ++i) { LAS float* d = scr + (8 * i + (lane >> 3)) * 33 + 4 * (lane & 7); d[0] = v[i].x; d[1] = v[i].y; d[2] = v[i].z; d[3] = v[i].w; }
    asm volatile("s_waitcnt lgkmcnt(0)" ::: "memory");
    const int c = lane & 7;
#pragma unroll
    for (int j = 0; j < 4; ++j) { const int n = (lane >> 3) + 8 * j; const LAS float* s = scr + (8 * c) * 33 + n; const float sc = map.sc(n0 + n);
        u32x4 o; o.x = pk2(s[0 * 33] * sc, s[1 * 33] * sc); o.y = pk2(s[2 * 33] * sc, s[3 * 33] * sc); o.z = pk2(s[4 * 33] * sc, s[5 * 33] * sc); o.w = pk2(s[6 * 33] * sc, s[7 * 33] * sc);
        *(u32x4*)(WT + (size_t)map.row(n0 + n) * ldt + dk0 + k0 + 8 * c) = o; }
    asm volatile("s_waitcnt lgkmcnt(0)" ::: "memory");
}

__device__ __forceinline__ void norm_row_to_bf16(const float* xrow, const float* g, bf16* hrow, int lane) {
    const f32x4* xr = (const f32x4*)xrow + lane; const f32x4* gr = (const f32x4*)g + lane;
    f32x4 v[4]; float s = 0.f;
#pragma unroll
    for (int j = 0; j < 4; ++j) { v[j] = xr[64 * j]; s += (v[j].x * v[j].x + v[j].y * v[j].y) + (v[j].z * v[j].z + v[j].w * v[j].w); }
    const float rstd = __builtin_amdgcn_rsqf(wave_sum(s) * (1.f / DM) + RMS_EPS);
    u32x2* o8 = (u32x2*)hrow + lane;
#pragma unroll
    for (int j = 0; j < 4; ++j) { const f32x4 gg = gr[64 * j]; u32x2 w; w.x = pk2(v[j].x * rstd * gg.x, v[j].y * rstd * gg.y); w.y = pk2(v[j].z * rstd * gg.z, v[j].w * rstd * gg.w); o8[64 * j] = w; }
}
__device__ __forceinline__ void post_norm_row(const bf16* yrow, const float* xs, float* xd, const float* gpost, const float* gpre, bf16* hrow, bool write_h, bool dry, int lane) {
    const u32x2* yr = (const u32x2*)yrow + lane; const f32x4* xr = (const f32x4*)xs + lane;
    f32x4 y[4], x[4]; float s = 0.f;
#pragma unroll
    for (int j = 0; j < 4; ++j) { const u32x2 w = yr[64 * j]; y[j].x = __uint_as_float(w.x << 16); y[j].y = __uint_as_float(w.x & 0xffff0000u); y[j].z = __uint_as_float(w.y << 16); y[j].w = __uint_as_float(w.y & 0xffff0000u);
        x[j] = xr[64 * j]; s += (y[j].x * y[j].x + y[j].y * y[j].y) + (y[j].z * y[j].z + y[j].w * y[j].w); }
    const float rstd = __builtin_amdgcn_rsqf(wave_sum(s) * (1.f / DM) + RMS_EPS);
    float s2 = 0.f;
#pragma unroll
    for (int j = 0; j < 4; ++j) { const f32x4 gg = ((const f32x4*)gpost + lane)[64 * j];
        x[j].x += y[j].x * rstd * gg.x; x[j].y += y[j].y * rstd * gg.y; x[j].z += y[j].z * rstd * gg.z; x[j].w += y[j].w * rstd * gg.w;
        if (!dry) ((f32x4*)xd + lane)[64 * j] = x[j]; s2 += (x[j].x * x[j].x + x[j].y * x[j].y) + (x[j].z * x[j].z + x[j].w * x[j].w); }
    if (write_h && !dry) {
        const float r2 = __builtin_amdgcn_rsqf(wave_sum(s2) * (1.f / DM) + RMS_EPS);
        u32x2* o8 = (u32x2*)hrow + lane;
#pragma unroll
        for (int j = 0; j < 4; ++j) { const f32x4 gg = ((const f32x4*)gpre + lane)[64 * j]; u32x2 w; w.x = pk2(x[j].x * r2 * gg.x, x[j].y * r2 * gg.y); w.y = pk2(x[j].z * r2 * gg.z, x[j].w * r2 * gg.w); o8[64 * j] = w; }
    }
}

__device__ __forceinline__ void post_norm_rows2(const bf16* y0, const bf16* y1, const float* xs0, const float* xs1, float* xd0, float* xd1, const float* gpost, const float* gpre, bf16* h0, bf16* h1, bool write_h, bool dry, int lane) {
    f32x4 y[2][4], x[2][4], gp[4]; u32x2 w[2][4];
#pragma unroll
    for (int j = 0; j < 4; ++j) { w[0][j] = __builtin_nontemporal_load((const u32x2*)y0 + lane + 64 * j); w[1][j] = __builtin_nontemporal_load((const u32x2*)y1 + lane + 64 * j); }
#pragma unroll
    for (int j = 0; j < 4; ++j) { x[0][j] = __builtin_nontemporal_load((const f32x4*)xs0 + lane + 64 * j); x[1][j] = __builtin_nontemporal_load((const f32x4*)xs1 + lane + 64 * j); gp[j] = ((const f32x4*)gpost + lane)[64 * j]; }
    float s[2] = {0.f, 0.f};
#pragma unroll
    for (int q = 0; q < 2; ++q)
#pragma unroll
        for (int j = 0; j < 4; ++j) { y[q][j].x = __uint_as_float(w[q][j].x << 16); y[q][j].y = __uint_as_float(w[q][j].x & 0xffff0000u); y[q][j].z = __uint_as_float(w[q][j].y << 16); y[q][j].w = __uint_as_float(w[q][j].y & 0xffff0000u);
            s[q] += (y[q][j].x * y[q][j].x + y[q][j].y * y[q][j].y) + (y[q][j].z * y[q][j].z + y[q][j].w * y[q][j].w); }
#pragma unroll
    for (int o = 1; o < 64; o <<= 1) { s[0] += __shfl_xor(s[0], o); s[1] += __shfl_xor(s[1], o); }
    float s2[2] = {0.f, 0.f};
#pragma unroll
    for (int q = 0; q < 2; ++q) { const float rstd = __builtin_amdgcn_rsqf(s[q] * (1.f / DM) + RMS_EPS); float* xd = q ? xd1 : xd0;
#pragma unroll
        for (int j = 0; j < 4; ++j) {
            x[q][j].x += y[q][j].x * rstd * gp[j].x; x[q][j].y += y[q][j].y * rstd * gp[j].y; x[q][j].z += y[q][j].z * rstd * gp[j].z; x[q][j].w += y[q][j].w * rstd * gp[j].w;
            if (!dry) __builtin_nontemporal_store(x[q][j], (f32x4*)xd + lane + 64 * j); s2[q] += (x[q][j].x * x[q][j].x + x[q][j].y * x[q][j].y) + (x[q][j].z * x[q][j].z + x[q][j].w * x[q][j].w); } }
    if (write_h && !dry) {
#pragma unroll
        for (int o = 1; o < 64; o <<= 1) { s2[0] += __shfl_xor(s2[0], o); s2[1] += __shfl_xor(s2[1], o); }
#pragma unroll
        for (int j = 0; j < 4; ++j) gp[j] = ((const f32x4*)gpre + lane)[64 * j];
#pragma unroll
        for (int q = 0; q < 2; ++q) { const float r2 = __builtin_amdgcn_rsqf(s2[q] * (1.f / DM) + RMS_EPS); const __amdgpu_buffer_rsrc_t hr_ = pg8::wt_rsrc(q ? h1 : h0);
#pragma unroll
            for (int j = 0; j < 4; ++j) { u32x2 ww; ww.x = pk2(x[q][j].x * r2 * gp[j].x, x[q][j].y * r2 * gp[j].y); ww.y = pk2(x[q][j].z * r2 * gp[j].z, x[q][j].w * r2 * gp[j].w); __builtin_amdgcn_raw_buffer_store_b64(ww, hr_, (lane + 64 * j) * 8, 0, 16); } }
    }
}

__device__ __forceinline__ void rope_cs(int pos, int i, float& c, float& s) {
    float hi, lo;
    switch (i) { case 0: hi = 0.1591796875f; lo = -2.474440771038644e-05f; break; case 1: hi = 0.0308685302734375f; lo = -4.76686864203657e-06f; break;
                 case 2: hi = 0.005985260009765625f; lo = -7.429704851347196e-08f; break; case 3: hi = 0.0011606216430664062f; lo = 4.1998173827551e-08f; break;
                 case 4: hi = 0.000225067138671875f; lo = 1.1940367805607366e-08f; break; case 5: hi = 4.366040229797363e-05f; lo = -1.2449505426559426e-08f; break;
                 case 6: hi = 8.463859558105469e-06f; lo = 4.712501500137023e-10f; break; default: hi = 1.6409903764724731e-06f; lo = 4.3588632703261965e-10f; break; }
    const float fp = (float)pos, p = fp * hi, fr = (p - rintf(p)) + fp * lo;
    c = __builtin_amdgcn_cosf(fr); s = __builtin_amdgcn_sinf(fr);
}

typedef __attribute__((address_space(4))) const unsigned char* kptr_t;
struct KA {
    kptr_t kp;
    __device__ __forceinline__ void refresh() { kp = (kptr_t)__builtin_amdgcn_kernarg_segment_ptr(); asm volatile("" : "+s"(kp)); }
    __device__ __forceinline__ const void* in(int i) const { return (const void*)(const GAS void*)(*(const __attribute__((address_space(4))) unsigned long long*)(kp + 8 * i)); }
    __device__ __forceinline__ float* out() const { return (float*)(GAS float*)(*(const __attribute__((address_space(4))) unsigned long long*)(kp + 8 * 31)); }
    __device__ __forceinline__ unsigned char* ws() const { return (unsigned char*)(GAS unsigned char*)(*(const __attribute__((address_space(4))) unsigned long long*)(kp + 8 * 32)); }
    __device__ __forceinline__ int ph_lo() const { return *(const __attribute__((address_space(4))) int*)(kp + 8 * 33); }
    __device__ __forceinline__ int ph_hi() const { return *(const __attribute__((address_space(4))) int*)(kp + 8 * 33 + 4); }
};
struct Frame {
    LAS unsigned char* lds;
    int tid, lane, wave, G, bid;
    int gw, ngw;
    int gt, ngt;
};

struct ConvDesc { const float* src; int ldw; bf16* dst; int ldt; int kd; int n0; int kind; int par; float sc; };
#define CVD(Wp, K_, N_, LDW_, DST_, LDT_, DK0_, KIND_, PAR_, SC_) { constexpr int n_ = ((N_) / 32) * ((K_) / 64); if (it < n_) { const int nblk = (N_) / 32, kb = it / nblk, nb = it % nblk; \
    d.src = (Wp) + (size_t)(64 * kb + (lane >> 3)) * (LDW_) + 32 * nb + 4 * (lane & 7); d.ldw = (LDW_); d.dst = (DST_); d.ldt = (LDT_); d.kd = (DK0_) + 64 * kb; d.n0 = 32 * nb; d.kind = (KIND_); d.par = (PAR_); d.sc = (SC_); return; } it -= n_; }
constexpr int N_CONV = 2192 + 1536 + 4 * 128 + 3 * 256 + 512 + 128 + 2 * 128 + 128 + 2 * 1408 + 1408;
__device__ __forceinline__ void conv_decode(ConvDesc& d, const KA& a, unsigned char* ws, int l, int it, int lane) {
    CVD((const float*)a.in(10) + (size_t)l * DM * DIN, DM, 4384, DIN, (bf16*)(ws + W_A), DM, 0, 1, 0, 1.0f)
    CVD((const float*)a.in(10) + (size_t)l * DM * DIN + 4384, DM, 3072, DIN, (bf16*)(ws + W_M), DM, 0, 0, 0, 1.0f)
    CVD((const float*)a.in(13) + (size_t)l * 2048 * 256, 1024, 256, 256, (bf16*)(ws + W_C1K), 1024, 0, 0, 0, 1.0f)
    CVD((const float*)a.in(13) + (size_t)l * 2048 * 256 + 1024 * 256, 1024, 256, 256, (bf16*)(ws + W_C1K), 1024, 0, 0, 256, 1.0f)
    CVD((const float*)a.in(17) + (size_t)l * 2048 * 256, 1024, 256, 256, (bf16*)(ws + W_C1V), 1024, 0, 0, 0, 1.0f)
    CVD((const float*)a.in(17) + (size_t)l * 2048 * 256 + 1024 * 256, 1024, 256, 256, (bf16*)(ws + W_C1V), 1024, 0, 0, 256, 1.0f)
    CVD((const float*)a.in(20) + (size_t)l * 512 * DM, 512, DM, DM, (bf16*)(ws + W_UP), 512, 0, 0, 0, 1.0f)
    CVD((const float*)a.in(21) + (size_t)l * 512 * DM, 512, DM, DM, (bf16*)(ws + W_UP), 512, 0, 0, 1024, 1.0f)
    CVD((const float*)a.in(22) + (size_t)l * 512 * DM, 512, DM, DM, (bf16*)(ws + W_UP), 512, 0, 0, 2048, 1.0f)
    CVD((const float*)a.in(23) + (size_t)l * DM * DM, DM, DM, DM, (bf16*)(ws + W_OUT3), DM, 0, 0, 0, 1.0f)
    CVD((const float*)a.in(24) + (size_t)l * DM * 256, DM, 256, 256, (bf16*)(ws + W_MQ), DM, 0, 0, 0, 0.125f)
    CVD((const float*)a.in(25) + (size_t)l * DM * 256, DM, 256, 256, (bf16*)(ws + W_MKV), DM, 0, 0, 0, 1.0f)
    CVD((const float*)a.in(26) + (size_t)l * DM * 256, DM, 256, 256, (bf16*)(ws + W_MKV), DM, 0, 0, 256, 1.0f)
    CVD((const float*)a.in(27) + (size_t)l * 256 * DM, 256, DM, DM, (bf16*)(ws + W_MO), 256, 0, 0, 0, 1.0f)
    CVD((const float*)a.in(28) + (size_t)l * DM * DFF, DM, DFF, DFF, (bf16*)(ws + W_GU), DM, 0, 2, 0, 1.0f)
    CVD((const float*)a.in(29) + (size_t)l * DM * DFF, DM, DFF, DFF, (bf16*)(ws + W_GU), DM, 0, 2, 1, 1.0f)
    CVD((const float*)a.in(30) + (size_t)l * DFF * DM, DFF, DM, DM, (bf16*)(ws + W_DN), DFF, 0, 0, 0, 1.0f)
}
#undef CVD
__device__ __forceinline__ void conv_load(const ConvDesc& d, f32x4 (&v)[8]) {
#pragma unroll
    for (int i = 0; i < 8; ++i) v[i] = __builtin_nontemporal_load((const f32x4*)(d.src + (size_t)(8 * i) * d.ldw));
}
__device__ __forceinline__ void conv_finish(const ConvDesc& d, const f32x4 (&v)[8], LAS float* scr, int lane) {
#pragma unroll
    for (int i = 0; i < 8; ++i) { LAS float* p = scr + (8 * i + (lane >> 3)) * 33 + 4 * (lane & 7); p[0] = v[i].x; p[1] = v[i].y; p[2] = v[i].z; p[3] = v[i].w; }
    asm volatile("s_waitcnt lgkmcnt(0)" ::: "memory");
    const int c = lane & 7;
#pragma unroll
    for (int j = 0; j < 4; ++j) { const int n = (lane >> 3) + 8 * j, gn = d.n0 + n; const LAS float* s = scr + (8 * c) * 33 + n;
        const int row = d.kind == 0 ? gn + d.par : (d.kind == 1 ? MapA{}.row(gn) : MapGU{d.par}.row(gn));
        const float sc = d.kind == 1 ? MapA{}.sc(gn) : d.sc;
        u32x4 o; o.x = pk2(s[0 * 33] * sc, s[1 * 33] * sc); o.y = pk2(s[2 * 33] * sc, s[3 * 33] * sc); o.z = pk2(s[4 * 33] * sc, s[5 * 33] * sc); o.w = pk2(s[6 * 33] * sc, s[7 * 33] * sc);
        *(u32x4*)(d.dst + (size_t)row * d.ldt + d.kd + 8 * c) = o; }
    asm volatile("s_waitcnt lgkmcnt(0)" ::: "memory");
}
__device__ __forceinline__ void norm_rows4_to_bf16(const float* x0, const float* g, bf16* h0, int lane) {
    f32x4 v[4][4], gg[4]; float s[4] = {0.f, 0.f, 0.f, 0.f};
#pragma unroll
    for (int q = 0; q < 4; ++q)
#pragma unroll
        for (int j = 0; j < 4; ++j) v[q][j] = __builtin_nontemporal_load((const f32x4*)(x0 + (size_t)q * DM) + lane + 64 * j);
#pragma unroll
    for (int j = 0; j < 4; ++j) gg[j] = ((const f32x4*)g + lane)[64 * j];
#pragma unroll
    for (int q = 0; q < 4; ++q)
#pragma unroll
        for (int j = 0; j < 4; ++j) s[q] += (v[q][j].x * v[q][j].x + v[q][j].y * v[q][j].y) + (v[q][j].z * v[q][j].z + v[q][j].w * v[q][j].w);
#pragma unroll
    for (int o = 1; o < 64; o <<= 1) { s[0] += __shfl_xor(s[0], o); s[1] += __shfl_xor(s[1], o); s[2] += __shfl_xor(s[2], o); s[3] += __shfl_xor(s[3], o); }
#pragma unroll
    for (int q = 0; q < 4; ++q) { const float rstd = __builtin_amdgcn_rsqf(s[q] * (1.f / DM) + RMS_EPS); u32x2* o8 = (u32x2*)(h0 + (size_t)q * DM) + lane;
#pragma unroll
        for (int j = 0; j < 4; ++j) { u32x2 w; w.x = pk2(v[q][j].x * rstd * gg[j].x, v[q][j].y * rstd * gg[j].y); w.y = pk2(v[q][j].z * rstd * gg[j].z, v[q][j].w * rstd * gg[j].w); o8[64 * j] = w; } }
}
struct ConvB { const float* src; int ldw; bf16* dst; int ldt; int kd; int n0; int kind; int par; float sc; };
#define CVB(Wp, K_, N_, LDW_, DST_, LDT_, DK0_, KIND_, PAR_, SC_) { constexpr int nb_ = (N_) / 256, n_ = nb_ * ((K_) / 64); if (it < n_) { const int kb = it / nb_, nb = it % nb_; \
    d.src = (Wp) + (size_t)(64 * kb) * (LDW_) + 256 * nb; d.ldw = (LDW_); d.dst = (DST_); d.ldt = (LDT_); d.kd = (DK0_) + 64 * kb; d.n0 = 256 * nb; d.kind = (KIND_); d.par = (PAR_); d.sc = (SC_); return; } it -= n_; }
constexpr int N_CONVB = 16 * 17 + 16 * 12 + 4 * 16 + 3 * 32 + 64 + 16 + 2 * 16 + 16 + 2 * 176 + 176;
constexpr int N_CONVA = N_CONVB - (2 * 176 + 176);
__device__ __forceinline__ void convb_decode(ConvB& d, const KA& a, unsigned char* ws, int l, int it) {
    CVB((const float*)a.in(10) + (size_t)l * DM * DIN, DM, 4352, DIN, (bf16*)(ws + W_A), DM, 0, 1, 0, 1.0f)
    CVB((const float*)a.in(10) + (size_t)l * DM * DIN + 4384, DM, 3072, DIN, (bf16*)(ws + W_M), DM, 0, 0, 0, 1.0f)
    CVB((const float*)a.in(13) + (size_t)l * 2048 * 256, 1024, 256, 256, (bf16*)(ws + W_C1K), 1024, 0, 0, 0, 1.0f)
    CVB((const float*)a.in(13) + (size_t)l * 2048 * 256 + 1024 * 256, 1024, 256, 256, (bf16*)(ws + W_C1K), 1024, 0, 0, 256, 1.0f)
    CVB((const float*)a.in(17) + (size_t)l * 2048 * 256, 1024, 256, 256, (bf16*)(ws + W_C1V), 1024, 0, 0, 0, 1.0f)
    CVB((const float*)a.in(17) + (size_t)l * 2048 * 256 + 1024 * 256, 1024, 256, 256, (bf16*)(ws + W_C1V), 1024, 0, 0, 256, 1.0f)
    CVB((const float*)a.in(20) + (size_t)l * 512 * DM, 512, DM, DM, (bf16*)(ws + W_UP), 512, 0, 0, 0, 1.0f)
    CVB((const float*)a.in(21) + (size_t)l * 512 * DM, 512, DM, DM, (bf16*)(ws + W_UP), 512, 0, 0, 1024, 1.0f)
    CVB((const float*)a.in(22) + (size_t)l * 512 * DM, 512, DM, DM, (bf16*)(ws + W_UP), 512, 0, 0, 2048, 1.0f)
    CVB((const float*)a.in(23) + (size_t)l * DM * DM, DM, DM, DM, (bf16*)(ws + W_OUT3), DM, 0, 0, 0, 1.0f)
    CVB((const float*)a.in(24) + (size_t)l * DM * 256, DM, 256, 256, (bf16*)(ws + W_MQ), DM, 0, 0, 0, 0.125f)
    CVB((const float*)a.in(25) + (size_t)l * DM * 256, DM, 256, 256, (bf16*)(ws + W_MKV), DM, 0, 0, 0, 1.0f)
    CVB((const float*)a.in(26) + (size_t)l * DM * 256, DM, 256, 256, (bf16*)(ws + W_MKV), DM, 0, 0, 256, 1.0f)
    CVB((const float*)a.in(27) + (size_t)l * 256 * DM, 256, DM, DM, (bf16*)(ws + W_MO), 256, 0, 0, 0, 1.0f)
    CVB((const float*)a.in(28) + (size_t)l * DM * DFF, DM, DFF, DFF, (bf16*)(ws + W_GU), DM, 0, 2, 0, 1.0f)
    CVB((const float*)a.in(29) + (size_t)l * DM * DFF, DM, DFF, DFF, (bf16*)(ws + W_GU), DM, 0, 2, 1, 1.0f)
    CVB((const float*)a.in(30) + (size_t)l * DFF * DM, DFF, DM, DM, (bf16*)(ws + W_DN), DFF, 0, 0, 0, 1.0f)
}
#undef CVB
__device__ __forceinline__ void convb_load(const ConvB& d, f32x4 (&v)[8], int wave, int lane) {
#pragma unroll
    for (int i = 0; i < 8; ++i) v[i] = __builtin_nontemporal_load((const f32x4*)(d.src + (size_t)(8 * wave + i) * d.ldw + 4 * lane));
}
__device__ __forceinline__ void convb_finish(const ConvB& d, const f32x4 (&v)[8], LAS float* scr, int tid, int wave, int lane) {
#pragma unroll
    for (int i = 0; i < 8; ++i) { LAS float* p = scr + (8 * wave + i) * 257 + 4 * lane; p[0] = v[i].x; p[1] = v[i].y; p[2] = v[i].z; p[3] = v[i].w; }
    __syncthreads();
#pragma unroll
    for (int j = 0; j < 4; ++j) { const int pc = tid + 512 * j, n = pc >> 3, c = pc & 7, gn = d.n0 + n; const LAS float* s = scr + (8 * c) * 257 + n;
        const int row = d.kind == 0 ? gn + d.par : (d.kind == 1 ? MapA{}.row(gn) : MapGU{d.par}.row(gn));
        const float sc = d.kind == 1 ? MapA{}.sc(gn) : d.sc;
        u32x4 o; o.x = pk2(s[0 * 257] * sc, s[1 * 257] * sc); o.y = pk2(s[2 * 257] * sc, s[3 * 257] * sc); o.z = pk2(s[4 * 257] * sc, s[5 * 257] * sc); o.w = pk2(s[6 * 257] * sc, s[7 * 257] * sc);
        *(u32x4*)(d.dst + (size_t)row * d.ldt + d.kd + 8 * c) = o; }
    __syncthreads();
}
__device__ __forceinline__ void phase_conv(const Frame& F, const KA& a, int l) {
    unsigned char* ws = a.ws();
    const int gw = F.gw, ngw = F.ngw, lane = F.lane;
    {
        LAS float* scr = (LAS float*)F.lds;
        ConvB da, db; f32x4 va[8], vb[8];
        int i0 = F.bid;
        if (i0 < N_CONVA) { convb_decode(da, a, ws, l, i0); convb_load(da, va, F.wave, lane); }
        for (; i0 < N_CONVA; i0 += 2 * F.G) {
            const int i1 = i0 + F.G, i2 = i1 + F.G; const bool h1 = i1 < N_CONVA, h2 = i2 < N_CONVA;
            if (h1) { convb_decode(db, a, ws, l, i1); convb_load(db, vb, F.wave, lane); }
            convb_finish(da, va, scr, F.tid, F.wave, lane);
            if (h2) { convb_decode(da, a, ws, l, i2); convb_load(da, va, F.wave, lane); }
            if (h1) convb_finish(db, vb, scr, F.tid, F.wave, lane);
        }
    }
    {
        LAS float* scr = (LAS float*)(F.lds + F.wave * 16384);
        for (int it = ngw - 1 - gw; it < 16; it += ngw) { ConvDesc d; f32x4 v[8];
            d.src = (const float*)a.in(10) + (size_t)l * DM * DIN + (size_t)(64 * it + (lane >> 3)) * DIN + 4352 + 4 * (lane & 7); d.ldw = DIN; d.dst = (bf16*)(ws + W_A); d.ldt = DM; d.kd = 64 * it; d.n0 = 4352; d.kind = 1; d.par = 0; d.sc = 1.0f;
            conv_load(d, v); conv_finish(d, v, scr, lane); }
    }
    __syncthreads();
    const int n_other = 14 + 64 + 512 + (l == 0 ? 4096 : 0);
    for (int it0 = ngw - 1 - gw; it0 < n_other; it0 += ngw) {
        int it = it0;
        if (it < 14) {
            u32x4* z = (u32x4*)(ws + W_A + (4384ull + 16 * it) * DM * 2) + lane; unsigned zz = 0u; asm volatile("" : "+v"(zz));
#pragma unroll 8
            for (int i = 0; i < 32; ++i) z[64 * i] = (u32x4){zz, zz, zz, zz};
            continue; }
        it -= 14;
        if (it < 64) {
            const int m = it >> 5, s = it & 31;
            const float* pe = (m ? (const float*)a.in(16) : (const float*)a.in(12)) + (size_t)l * 2048 + s * 64;
            const float* w1 = (m ? (const float*)a.in(17) : (const float*)a.in(13)) + (size_t)l * 2048 * 256 + (size_t)(s * 64) * 256;
            const unsigned pev = __float_as_uint(pe[lane]);
            f32x4 acc = (f32x4){0.f, 0.f, 0.f, 0.f}, acc2 = (f32x4){0.f, 0.f, 0.f, 0.f};
#pragma unroll 1
            for (int kb = 0; kb < 64; kb += 16) {
                f32x4 w[16];
#pragma unroll
                for (int i = 0; i < 16; ++i) w[i] = __builtin_nontemporal_load((const f32x4*)(w1 + (size_t)(kb + i) * 256) + lane);
#pragma unroll
                for (int i = 0; i < 16; i += 2) { const float p = __uint_as_float(__builtin_amdgcn_readlane(pev, kb + i)), p2 = __uint_as_float(__builtin_amdgcn_readlane(pev, kb + i + 1));
                    acc.x += p * w[i].x; acc.y += p * w[i].y; acc.z += p * w[i].z; acc.w += p * w[i].w; acc2.x += p2 * w[i + 1].x; acc2.y += p2 * w[i + 1].y; acc2.z += p2 * w[i + 1].z; acc2.w += p2 * w[i + 1].w; }
            }
            acc.x += acc2.x; acc.y += acc2.y; acc.z += acc2.z; acc.w += acc2.w;
            ((f32x4*)((float*)(ws + W_B1PART) + (size_t)(m * 32 + s) * 256))[lane] = acc;
            continue; }
        it -= 64;
        if (it < 512) { norm_rows4_to_bf16((const float*)a.in(1) + (size_t)(4 * it) * DM, (const float*)a.in(6) + (size_t)l * DM, (bf16*)(ws + WS_MEMN) + (size_t)(4 * it) * DM, lane); continue; }
        it -= 512;
        norm_rows4_to_bf16((const float*)a.in(0) + (size_t)(4 * it) * DM, (const float*)a.in(3), (bf16*)(ws + WS_H) + (size_t)(4 * it) * DM, lane);
    }
}

__device__ __forceinline__ void phase_conv_b(const Frame& F, const KA& a, int l) {
    unsigned char* ws = a.ws();
    LAS float* scr = (LAS float*)F.lds;
    LAS unsigned* qslot = (LAS unsigned*)(F.lds + 66048);
    unsigned* ctr = (unsigned*)(ws + WS_CTL) + CW_CVB + 64 * (unsigned)l;
    for (;;) {
        if (F.tid == 0) *qslot = __hip_atomic_fetch_add(ctr, 1u, __ATOMIC_RELAXED, __HIP_MEMORY_SCOPE_AGENT);
        __syncthreads();
        const unsigned k_ = *qslot;
        __syncthreads();
        if (k_ >= (unsigned)(N_CONVB - N_CONVA)) break;
        ConvB d; f32x4 v[8];
        convb_decode(d, a, ws, l, N_CONVA + (int)k_); convb_load(d, v, F.wave, F.lane);
        convb_finish(d, v, scr, F.tid, F.wave, F.lane);
    }
}

__device__ __forceinline__ void phase_post(const Frame& F, const KA& a, int l, bool dry) {
    unsigned char* ws = a.ws();
    bf16* nsakv = (bf16*)(ws + WS_KV + 64 * MiB);
    const bf16* small = (const bf16*)(ws + WS_KV + 88 * MiB);
    const int* pos = (const int*)a.in(2);
    for (int it = F.gt; it < M * 32; it += F.ngt) {
        const int tok = it >> 5, r = it & 31, which = r >> 4, g = (r >> 3) & 1, i = r & 7;
        bf16* p = nsakv + (size_t)tok * 768 + 256 + which * 256 + g * 64 + i;
        float c, s; rope_cs(pos[tok], i, c, s);
        const float x1 = bf2f(p[0]), x2 = bf2f(p[8]);
        if (!dry) { p[0] = f2bf(x1 * c - x2 * s); p[8] = f2bf(x2 * c + x1 * s); }
    }
    if (F.bid >= 64 && F.bid < 128) {
        const int it = F.bid - 64, b = it >> 3, h = it & 7; const float bias = ((const float*)a.in(11))[l * 8 + h];
        const bf16* fp = small + ((size_t)b * SEQ + 4 * F.tid) * 256 + 24 + h;
        float v0 = logsig(bf2f(fp[0]) + bias), v1 = logsig(bf2f(fp[256]) + bias), v2 = logsig(bf2f(fp[512]) + bias), v3 = logsig(bf2f(fp[768]) + bias);
        v1 += v0; v2 += v1; v3 += v2;
        float inc = v3;
#pragma unroll
        for (int o = 1; o < 64; o <<= 1) { const float t = __shfl_up(inc, o); if (F.lane >= o) inc += t; }
        LAS float* wtot = (LAS float*)F.lds;
        if (F.lane == 63) wtot[F.wave] = inc;
        __syncthreads();
        float base = inc - v3;
        for (int w = 0; w < F.wave; ++w) base += wtot[w];
        *(f32x4*)((float*)(ws + WS_CF) + ((size_t)b * 8 + h) * SEQ + 4 * F.tid) = (f32x4){base + v0, base + v1, base + v2, base + v3};
        __syncthreads();
    }
}

__device__ __forceinline__ void phase_cmp2(const Frame& F, const KA& a, int l) {
    unsigned char* ws = a.ws();
    LAS float* b1p = (LAS float*)F.lds;
    LAS float* hid = (LAS float*)(F.lds + 4096) + F.wave * 512;
    {
        const int m = F.tid >> 8, j = F.tid & 255;
        const float* part = (const float*)(ws + W_B1PART) + (size_t)m * 32 * 256 + j;
        float pv[32];
#pragma unroll
        for (int i = 0; i < 32; ++i) pv[i] = part[i * 256];
        float s = (m ? (const float*)a.in(18) : (const float*)a.in(14))[l * 256 + j];
#pragma unroll
        for (int i = 0; i < 32; ++i) s += pv[i];
        b1p[m * 256 + j] = s;
    }
    __syncthreads();
    for (int it = 2 * F.gw; it < 4096; it += 2 * F.ngw) {
        const int m = it >> 11, r = it & 2047, b = r >> 8, c = (r >> 1) & 127;
        bf16* out = (bf16*)(ws + (m ? WS_VCMP : WS_KCMP)) + (((size_t)b * 2 + 0) * 128 + c) * 64;
        if (c == 127) { out[F.lane] = 0; out[128 * 64 + F.lane] = 0; continue; }
#pragma unroll
        for (int g = 0; g < 2; ++g) {
            const bf16* P = (const bf16*)(ws + (m ? WS_PV : WS_PK)) + ((size_t)g * 1024 + b * 128 + c) * 512;
            const u32x2 p1 = *(const u32x2*)(P + 4 * F.lane), p2 = *(const u32x2*)(P + 512 + 256 + 4 * F.lane);
            float hv[4];
            hv[0] = __uint_as_float(p1.x << 16) + __uint_as_float(p2.x << 16); hv[1] = __uint_as_float(p1.x & 0xffff0000u) + __uint_as_float(p2.x & 0xffff0000u);
            hv[2] = __uint_as_float(p1.y << 16) + __uint_as_float(p2.y << 16); hv[3] = __uint_as_float(p1.y & 0xffff0000u) + __uint_as_float(p2.y & 0xffff0000u);
            f32x4 hx;
#pragma unroll
            for (int e = 0; e < 4; ++e) { const float x = hv[e] + b1p[m * 256 + 4 * F.lane + e]; hx[e] = x * sigm(x); }
            *(LAS f32x4*)(hid + g * 256 + 4 * F.lane) = hx;
        }
        asm volatile("s_waitcnt lgkmcnt(0)" ::: "memory");
        const float* w2 = (m ? (const float*)a.in(19) : (const float*)a.in(15)) + (size_t)l * 256 * 64 + F.lane;
        float acc0 = 0.f, acc1 = 0.f;
#pragma unroll 1
        for (int jb = 0; jb < 256; jb += 64) {
            float w[64];
#pragma unroll
            for (int i = 0; i < 64; ++i) w[i] = w2[(jb + i) * 64];
#pragma unroll
            for (int i = 0; i < 64; i += 4) { const f32x4 h0 = *(const LAS f32x4*)(hid + jb + i), h1 = *(const LAS f32x4*)(hid + 256 + jb + i);
                acc0 += h0.x * w[i] + h0.y * w[i + 1] + h0.z * w[i + 2] + h0.w * w[i + 3]; acc1 += h1.x * w[i] + h1.y * w[i + 1] + h1.z * w[i + 2] + h1.w * w[i + 3]; }
        }
        out[F.lane] = f2bf(acc0); out[128 * 64 + F.lane] = f2bf(acc1);
        asm volatile("s_waitcnt lgkmcnt(0)" ::: "memory");
    }
    __syncthreads();
}


namespace fa {
typedef short bf16x8 __attribute__((ext_vector_type(8)));
typedef short s16x4 __attribute__((ext_vector_type(4)));
typedef float f32x16 __attribute__((ext_vector_type(16)));
constexpr int KROW = 144;
constexpr int VROW = 192;
constexpr int TILE_B = 64 * KROW;
constexpr int VTILE_B = 64 * VROW;
constexpr int BIAS_OFF = TILE_B + VTILE_B;
constexpr int BUF_B = BIAS_OFF + 256;
constexpr float LOG2E = 1.4426950408889634f;
enum { MODE_NONE = 0, MODE_CAUSAL = 1, MODE_WINDOW = 2, MODE_SELECT = 3 };

__device__ __forceinline__ int crow(int r, int hi) { return (r & 3) + 8 * (r >> 2) + 4 * hi; }
__device__ __forceinline__ float xmax(float v) {
    auto rr = __builtin_amdgcn_permlane32_swap(__float_as_uint(v), __float_as_uint(v), false, false);
    return fmaxf(__uint_as_float(rr[0]), __uint_as_float(rr[1]));
}
typedef float f32x2 __attribute__((ext_vector_type(2)));
__device__ __forceinline__ float max3f(float a, float b, float c) { float r; asm("v_max3_f32 %0, %1, %2, %3" : "=v"(r) : "v"(a), "v"(b), "v"(c)); return r; }
__device__ __forceinline__ float xsum(float v) {
    auto rr = __builtin_amdgcn_permlane32_swap(__float_as_uint(v), __float_as_uint(v), false, false);
    return __uint_as_float(rr[0]) + __uint_as_float(rr[1]);
}
__device__ __forceinline__ s16x4 vtr(const LAS unsigned char* p) {
    typedef short v4i16_t __attribute__((ext_vector_type(4)));
    return __builtin_bit_cast(s16x4, __builtin_amdgcn_ds_read_tr16_b64_v4i16((LAS v4i16_t*)p));
}
__device__ __forceinline__ bf16x8 pack8(const f32x16& p, int b) {
    u32x4 w; w.x = pk2(p[b], p[b + 1]); w.y = pk2(p[b + 2], p[b + 3]); w.z = pk2(p[b + 4], p[b + 5]); w.w = pk2(p[b + 6], p[b + 7]);
    return __builtin_bit_cast(bf16x8, w);
}
__device__ __forceinline__ void load_q(bf16x8 (&qf)[4], const bf16* qrow, int hi) {
#pragma unroll
    for (int d0 = 0; d0 < 4; ++d0) qf[d0] = __builtin_bit_cast(bf16x8, *(const u32x4*)(qrow + 16 * d0 + 8 * hi));
}
__device__ __forceinline__ void rope_q(bf16x8& q0, int pos, int hi) {
    const u32x4 own = __builtin_bit_cast(u32x4, q0); u32x4 oth;
    oth.x = __shfl_xor(own.x, 32); oth.y = __shfl_xor(own.y, 32); oth.z = __shfl_xor(own.z, 32); oth.w = __shfl_xor(own.w, 32);
    float a[8], b[8];
    a[0] = __uint_as_float(own.x << 16); a[1] = __uint_as_float(own.x & 0xffff0000u); a[2] = __uint_as_float(own.y << 16); a[3] = __uint_as_float(own.y & 0xffff0000u);
    a[4] = __uint_as_float(own.z << 16); a[5] = __uint_as_float(own.z & 0xffff0000u); a[6] = __uint_as_float(own.w << 16); a[7] = __uint_as_float(own.w & 0xffff0000u);
    b[0] = __uint_as_float(oth.x << 16); b[1] = __uint_as_float(oth.x & 0xffff0000u); b[2] = __uint_as_float(oth.y << 16); b[3] = __uint_as_float(oth.y & 0xffff0000u);
    b[4] = __uint_as_float(oth.z << 16); b[5] = __uint_as_float(oth.z & 0xffff0000u); b[6] = __uint_as_float(oth.w << 16); b[7] = __uint_as_float(oth.w & 0xffff0000u);
    const float sg = hi ? 1.0f : -1.0f;
#pragma unroll
    for (int i = 0; i < 8; ++i) { float c, s; rope_cs(pos, i, c, s); a[i] = a[i] * c + sg * b[i] * s; }
    u32x4 w; w.x = pk2(a[0], a[1]); w.y = pk2(a[2], a[3]); w.z = pk2(a[4], a[5]); w.w = pk2(a[6], a[7]);
    q0 = __builtin_bit_cast(bf16x8, w);
}

struct KV { const bf16* K; const bf16* V; int ldk, ldv; const float* cb; };

struct Stage { u32x4 k, v; float b; };
template <bool BIAS> __device__ __forceinline__ void stage_load(Stage& s, const KV& P, int t, int tid) {
    const int row = 64 * t + (tid >> 3), ch = tid & 7;
    s.k = *(const u32x4*)(P.K + (size_t)row * P.ldk + ch * 8); s.v = *(const u32x4*)(P.V + (size_t)row * P.ldv + ch * 8);
    if (BIAS) { if (tid < 64) s.b = P.cb[64 * t + tid]; }
}
template <bool BIAS> __device__ __forceinline__ void stage_store(const Stage& s, LAS unsigned char* buf, int tid) {
    const int off = (tid >> 3) * KROW + (tid & 7) * 16, offv = (tid >> 3) * VROW + (tid & 7) * 16;
    *(LAS u32x4*)(buf + off) = s.k; *(LAS u32x4*)(buf + TILE_B + offv) = s.v;
    if (BIAS) { if (tid < 64) *(LAS float*)(buf + BIAS_OFF + tid * 4) = -s.b; }
}

template <int MODE> __device__ __forceinline__ bool tile_work(int t, int tq0, unsigned sel) {
    bool w = true;
    if (MODE == MODE_CAUSAL || MODE == MODE_WINDOW || MODE == MODE_SELECT) w = (64 * t <= tq0 + 31);
    if (MODE == MODE_WINDOW) w = w && (64 * t + 63 >= tq0 - 511);
    if (MODE == MODE_SELECT) w = w && (__ballot((sel >> t) & 1u) != 0ull);
    return w;
}
template <int MODE> __device__ __forceinline__ bool tile_full(int t, int tq0, unsigned sel) {
    bool f = true;
    if (MODE == MODE_CAUSAL || MODE == MODE_WINDOW || MODE == MODE_SELECT) f = (64 * t + 63 <= tq0);
    if (MODE == MODE_WINDOW) f = f && (tq0 + 31 - 64 * t < 512);
    if (MODE == MODE_SELECT) f = f && (__ballot((sel >> t) & 1u) == ~0ull);
    return f;
}

template <int MODE, bool BIAS, int XP = 0>
__device__ __forceinline__ void flash_tile(const LAS unsigned char* buf, int t, const bf16x8 (&qf)[4], int tq, int tq0, unsigned sel, int koff, int voff, int hi, f32x16 (&o)[2], float& m, float& l) {
    if (tile_work<MODE>(t, tq0, sel)) {
        bf16x8 kf[8];
#pragma unroll
        for (int d0 = 0; d0 < 4; ++d0) { kf[2 * d0] = *(const LAS bf16x8*)(buf + koff + d0 * 32); kf[2 * d0 + 1] = *(const LAS bf16x8*)(buf + koff + 32 * KROW + d0 * 32); }
        f32x16 s0, s1;
        if (BIAS) {
#pragma unroll
            for (int u = 0; u < 4; ++u) { const f32x4 b0 = *(const LAS f32x4*)(buf + BIAS_OFF + (8 * u + 4 * hi) * 4), b1 = *(const LAS f32x4*)(buf + BIAS_OFF + (32 + 8 * u + 4 * hi) * 4);
                s0[4 * u] = b0.x; s0[4 * u + 1] = b0.y; s0[4 * u + 2] = b0.z; s0[4 * u + 3] = b0.w; s1[4 * u] = b1.x; s1[4 * u + 1] = b1.y; s1[4 * u + 2] = b1.z; s1[4 * u + 3] = b1.w; }
        } else { s0 = f32x16{}; s1 = f32x16{}; }
        asm volatile("s_waitcnt lgkmcnt(0)" ::: "memory");
#pragma unroll
        for (int d0 = 0; d0 < 4; ++d0) { if (XP == 2) { asm volatile("" :: "v"(kf[2 * d0]), "v"(kf[2 * d0 + 1])); } else { s0 = __builtin_amdgcn_mfma_f32_32x32x16_bf16(kf[2 * d0], qf[d0], s0, 0, 0, 0); s1 = __builtin_amdgcn_mfma_f32_32x32x16_bf16(kf[2 * d0 + 1], qf[d0], s1, 0, 0, 0); } }
        s16x4 vlo[8], vhh[8];
#pragma unroll
        for (int j = 0; j < 2; ++j)
#pragma unroll
            for (int s = 0; s < 2; ++s)
#pragma unroll
                for (int d0 = 0; d0 < 2; ++d0) { const LAS unsigned char* vp = buf + voff + (32 * j + 16 * s) * VROW + d0 * 64; vlo[4 * j + 2 * s + d0] = vtr(vp); vhh[4 * j + 2 * s + d0] = vtr(vp + 8 * VROW); }
        asm volatile("" ::: "memory");
        asm volatile("s_nop 15\n\ts_nop 7" : "+v"(s0), "+v"(s1));
        if (MODE != MODE_NONE) {
            if (!tile_full<MODE>(t, tq0, sel)) {
                const int d = tq - (64 * t + 4 * hi);
                const bool selt = (MODE == MODE_SELECT) ? (((sel >> t) & 1u) != 0u) : true;
#pragma unroll
                for (int r = 0; r < 16; ++r) {
                    const int ca = (r & 3) + 8 * (r >> 2), cb = ca + 32;
                    bool va = selt && (ca <= d), vb = selt && (cb <= d);
                    if (MODE == MODE_WINDOW) { va = va && (ca > d - 512); vb = vb && (cb > d - 512); }
                    s0[r] = va ? s0[r] : -INFINITY; s1[r] = vb ? s1[r] : -INFINITY;
                }
            }
        }
        float mx0 = max3f(s0[0], s1[0], s0[1]), mx1 = max3f(s1[1], s0[2], s1[2]);
#pragma unroll
        for (int r = 3; r < 15; r += 2) { mx0 = max3f(mx0, s0[r], s1[r]); mx1 = max3f(mx1, s0[r + 1], s1[r + 1]); }
        const float mx = xmax(max3f(mx0, mx1, max3f(s0[15], s1[15], mx0)));
        const float mn = fmaxf(m, mx * LOG2E), ms = (mn == -INFINITY) ? 0.f : mn;
        const float alpha = __builtin_amdgcn_exp2f(m - ms);
        const bool resc = (mn != m);
        m = mn;
        f32x2 ps = (f32x2){0.f, 0.f};
#pragma unroll
        for (int r = 0; r < 16; r += 2) {
            const f32x2 ta = (f32x2){s0[r], s0[r + 1]} * LOG2E - ms, tb = (f32x2){s1[r], s1[r + 1]} * LOG2E - ms;
            if (XP == 1) { s0[r] = ta.x; s0[r + 1] = ta.y; s1[r] = tb.x; s1[r + 1] = tb.y; } else { s0[r] = __builtin_amdgcn_exp2f(ta.x); s0[r + 1] = __builtin_amdgcn_exp2f(ta.y); s1[r] = __builtin_amdgcn_exp2f(tb.x); s1[r + 1] = __builtin_amdgcn_exp2f(tb.y); }
            ps += (f32x2){s0[r], s0[r + 1]}; ps += (f32x2){s1[r], s1[r + 1]};
        }
        l = l * alpha + (ps.x + ps.y);
        if (__any(resc)) {
#pragma unroll
            for (int r = 0; r < 16; ++r) { o[0][r] *= alpha; o[1][r] *= alpha; }
        }
#pragma unroll
        for (int j = 0; j < 2; ++j)
#pragma unroll
            for (int s = 0; s < 2; ++s) {
                const bf16x8 pb = pack8(j ? s1 : s0, 8 * s);
#pragma unroll
                for (int d0 = 0; d0 < 2; ++d0) { const s16x4 lo = vlo[4 * j + 2 * s + d0], hh = vhh[4 * j + 2 * s + d0];
                    const bf16x8 vf = (bf16x8){lo[0], lo[1], lo[2], lo[3], hh[0], hh[1], hh[2], hh[3]};
                    if (XP == 2) { asm volatile("" :: "v"(vf), "v"(pb)); } else o[d0] = __builtin_amdgcn_mfma_f32_32x32x16_bf16(vf, pb, o[d0], 0, 0, 0); }
            }
    }
}
template <int MODE, bool BIAS, int XP = 0>
__device__ __forceinline__ void flash_core_v4(LAS unsigned char* lds, const KV& P, int t_lo, int t_hi, const bf16x8 (&qf)[4], int tq, int tq0, unsigned sel, f32x16 (&o)[2], float& l_out) {
    int tid_ = threadIdx.x; asm volatile("" : "+v"(tid_));
    const int tid = tid_, lane = tid & 63, r32 = lane & 31, hi = lane >> 5;
    o[0] = f32x16{}; o[1] = f32x16{};
    float m = -INFINITY, l = 0.f;
    const int koff = r32 * KROW + hi * 16;
    const int voff = TILE_B + (4 * hi + ((lane & 15) >> 2)) * VROW + (((lane >> 4) & 1) * 16 + (lane & 3) * 4) * 2;
    Stage sa, sb;
    stage_load<BIAS>(sa, P, t_lo, tid); stage_store<BIAS>(sa, lds, tid);
    if (t_lo + 1 < t_hi) stage_load<BIAS>(sa, P, t_lo + 1, tid);
    __syncthreads();
    for (int t = t_lo; t < t_hi; t += 2) {
        if (XP < 3 && t + 2 < t_hi) stage_load<BIAS>(sb, P, t + 2, tid);
        flash_tile<MODE, BIAS, XP>(lds, t, qf, tq, tq0, sel, koff, voff, hi, o, m, l);
        if (XP < 3 && t + 1 < t_hi) stage_store<BIAS>(sa, lds + BUF_B, tid);
        if (XP < 4) __syncthreads();
        if (t + 1 >= t_hi) break;
        if (XP < 3 && t + 3 < t_hi) stage_load<BIAS>(sa, P, t + 3, tid);
        flash_tile<MODE, BIAS, XP>(lds + BUF_B, t + 1, qf, tq, tq0, sel, koff, voff, hi, o, m, l);
        if (XP < 3 && t + 2 < t_hi) stage_store<BIAS>(sb, lds, tid);
        if (XP < 4) __syncthreads();
    }
    l_out = xsum(l);
}
__device__ __forceinline__ void store_o(bf16* orow, const f32x16 (&o)[2], float a, int hi) {
#pragma unroll
    for (int d0 = 0; d0 < 2; ++d0)
#pragma unroll
        for (int u = 0; u < 4; ++u) { u32x2 w; w.x = pk2(o[d0][4 * u] * a, o[d0][4 * u + 1] * a); w.y = pk2(o[d0][4 * u + 2] * a, o[d0][4 * u + 3] * a);
            *(u32x2*)(orow + 32 * d0 + 8 * u + 4 * hi) = w; }
}
}

__device__ __forceinline__ void phase_mem_mfma(const Frame& F, const KA& a) {
    unsigned char* ws = a.ws();
    const int vcu = (F.G % 8 == 0) ? (F.bid % 8) * (F.G / 8) + F.bid / 8 : F.bid;
    for (int u = vcu; u < 256; u += F.G) {
        const int b = u >> 5, h = (u >> 3) & 3, qb = u & 7;
        const int hi = F.lane >> 5, r32 = F.lane & 31, tq0 = 256 * qb + 32 * F.wave;
        const size_t tok = (size_t)b * SEQ + tq0 + r32;
        fa::bf16x8 qf[4];
#pragma unroll
        for (int d0 = 0; d0 < 4; ++d0) {
            float qa[8];
#pragma unroll
            for (int e = 0; e < 8; ++e) qa[e] = 0.f;
#pragma unroll
            for (int kq = 0; kq < 4; ++kq) { const u32x4 v = *(const u32x4*)((const bf16*)(ws + WS_MQ) + ((size_t)kq * M + tok) * 256 + h * 64 + 16 * d0 + 8 * hi);
                qa[0] += __uint_as_float(v.x << 16); qa[1] += __uint_as_float(v.x & 0xffff0000u); qa[2] += __uint_as_float(v.y << 16); qa[3] += __uint_as_float(v.y & 0xffff0000u);
                qa[4] += __uint_as_float(v.z << 16); qa[5] += __uint_as_float(v.z & 0xffff0000u); qa[6] += __uint_as_float(v.w << 16); qa[7] += __uint_as_float(v.w & 0xffff0000u); }
            u32x4 w; w.x = pk2(qa[0], qa[1]); w.y = pk2(qa[2], qa[3]); w.z = pk2(qa[4], qa[5]); w.w = pk2(qa[6], qa[7]);
            qf[d0] = __builtin_bit_cast(fa::bf16x8, w);
        }
        fa::KV P{(const bf16*)(ws + WS_MEMKV) + (size_t)b * NMEM * 512 + h * 64, (const bf16*)(ws + WS_MEMKV) + (size_t)b * NMEM * 512 + 256 + h * 64, 512, 512, nullptr};
        fa::f32x16 o[2]; float l;
        int nt_ = 4; asm volatile("" : "+s"(nt_));
        FA_CORE_MEM<fa::MODE_NONE, false>(F.lds, P, 0, nt_, qf, tq0 + r32, tq0, 0u, o, l);
        fa::store_o((bf16*)(ws + WS_MO) + tok * 256 + h * 64, o, 1.0f / l, hi);
    }
}
__device__ __forceinline__ void phase_fox_mfma(const Frame& F, const KA& a, bool dry) {
    unsigned char* ws = a.ws();
    const int vcu = (F.G % 8 == 0) ? (F.bid % 8) * (F.G / 8) + F.bid / 8 : F.bid;
    for (int u = vcu; u < 256; u += F.G) {
        const int bh = u >> 2, b = bh >> 3, h = bh & 7, s4 = u & 3;
        for (int half = 0; half < 2; ++half) {
            const int qb = half ? 7 - s4 : s4;
            const int hi = F.lane >> 5, r32 = F.lane & 31, tq0 = 256 * qb + 32 * F.wave;
            const size_t row0 = (size_t)b * SEQ, tok = row0 + tq0 + r32;
            bf16* Q = (bf16*)(ws + WS_OQ + 32 * MiB);
            fa::bf16x8 qf[4]; fa::load_q(qf, Q + tok * 512 + h * 64, hi);
            fa::KV P{(const bf16*)(ws + WS_KV + 32 * MiB) + row0 * 512 + h * 64, (const bf16*)(ws + WS_KV + 48 * MiB) + row0 * 512 + h * 64, 512, 512, (const float*)(ws + WS_CF) + (size_t)bh * SEQ};
            fa::f32x16 o[2]; float l;
            if (dry && PROBE_XP) fa::flash_core_v4<fa::MODE_CAUSAL, true, PROBE_XP>(F.lds, P, 0, 4 * (qb + 1), qf, tq0 + r32, tq0, 0u, o, l);
            else FA_CORE_FOX<fa::MODE_CAUSAL, true>(F.lds, P, 0, 4 * (qb + 1), qf, tq0 + r32, tq0, 0u, o, l);
            if (!dry) fa::store_o(Q + tok * 512 + h * 64, o, 1.0f / l, hi);
        }
    }
}

__device__ __forceinline__ void phase_nsa_fused(const Frame& F, const KA& a, bool dry) {
    using namespace fa;
    unsigned char* ws = a.ws();
    const int vcu = (F.G % 8 == 0) ? (F.bid % 8) * (F.G / 8) + F.bid / 8 : F.bid;
    const int* pos = (const int*)a.in(2);
    const int lane = F.lane, r32 = lane & 31, hi = lane >> 5, tid = F.tid, wave = F.wave;
    LAS unsigned char* lds = F.lds;
    constexpr int CT = 128 * KROW, SC_OFF = 45056, MK_OFF = SC_OFF + 8 * 32 * 32 * 4;
    for (int u = vcu; u < 256; u += F.G) {
        const int bg = u >> 4, b = bg >> 1, g = bg & 1, s16 = u & 15;
        for (int half = 0; half < 2; ++half) {
            const int qb = half ? 31 - s16 : s16;
            const int h = 4 * g + (wave >> 1), tq0 = 64 * qb + 32 * (wave & 1), tq = tq0 + r32;
            const size_t row0 = (size_t)b * SEQ, tok = row0 + tq;
            bf16* Q = (bf16*)(ws + WS_OQ + 16 * MiB);
            const bf16* kv = (const bf16*)(ws + WS_KV + 64 * MiB) + row0 * 768 + g * 64;
            const bf16* small = (const bf16*)(ws + WS_KV + 88 * MiB) + tok * 256 + h * 3;
            const float g0 = sigm(bf2f(small[0])), g1 = sigm(bf2f(small[1])), g2 = sigm(bf2f(small[2]));
            bf16x8 qf[4]; load_q(qf, Q + tok * 512 + h * 64, hi);
            {   const bf16* Kc = (const bf16*)(ws + WS_KCMP) + (size_t)bg * 128 * 64; const bf16* Vc = (const bf16*)(ws + WS_VCMP) + (size_t)bg * 128 * 64;
#pragma unroll
                for (int i = 0; i < 2; ++i) { const int pc = tid + 512 * i, row = pc >> 3, ch = pc & 7;
                    *(LAS u32x4*)(lds + row * KROW + ch * 16) = *(const u32x4*)(Kc + row * 64 + ch * 8);
                    *(LAS u32x4*)(lds + CT + row * VROW + ch * 16) = *(const u32x4*)(Vc + row * 64 + ch * 8); } }
            __syncthreads();
            {
                f32x16 acc[2];
                const int koff = r32 * KROW + hi * 16;
                const int voff = CT + (4 * hi + ((lane & 15) >> 2)) * VROW + (((lane >> 4) & 1) * 16 + (lane & 3) * 4) * 2;
                const int ncmax = tq0 >= 0 ? min(127, (tq0 + 31 - 31) / 16 + 1) : 0, nsub = (ncmax + 31) >> 5;
                f32x16 s[4];
#pragma unroll
                for (int j = 0; j < 4; ++j) s[j] = f32x16{};
#pragma unroll
                for (int j = 0; j < 4; ++j) if (j < nsub) {
#pragma unroll
                    for (int d0 = 0; d0 < 4; ++d0) { const bf16x8 kf = *(const LAS bf16x8*)(lds + koff + 32 * j * KROW + d0 * 32); s[j] = __builtin_amdgcn_mfma_f32_32x32x16_bf16(kf, qf[d0], s[j], 0, 0, 0); } }
                float mx = -INFINITY;
#pragma unroll
                for (int j = 0; j < 4; ++j)
#pragma unroll
                    for (int rr = 0; rr < 16; ++rr) { const int c = 32 * j + crow(rr, hi); const bool v = (16 * c + 31 <= tq) && (c < 127) && (j < nsub); s[j][rr] = v ? s[j][rr] : -INFINITY; mx = fmaxf(mx, s[j][rr]); }
                mx = xmax(mx);
                const float ms = (mx == -INFINITY) ? 0.f : mx * LOG2E;
                float ps = 0.f;
#pragma unroll
                for (int j = 0; j < 4; ++j)
#pragma unroll
                    for (int rr = 0; rr < 16; ++rr) { s[j][rr] = __builtin_amdgcn_exp2f(s[j][rr] * LOG2E - ms); ps += s[j][rr]; }
                ps = xsum(ps);
                const float inv = ps > 0.f ? 1.0f / ps : 0.f;
#pragma unroll
                for (int j = 0; j < 4; ++j)
#pragma unroll
                    for (int rr = 0; rr < 16; ++rr) s[j][rr] *= inv;
                LAS float* sc_out = (LAS float*)(lds + SC_OFF) + (wave * 32 + r32) * 32;
                float prev = 0.f;
#pragma unroll
                for (int idx = 0; idx < 16; ++idx) { const int j = idx >> 2, uu = idx & 3;
                    const float G = (s[j][4 * uu] + s[j][4 * uu + 1]) + (s[j][4 * uu + 2] + s[j][4 * uu + 3]), L = s[j][4 * uu + 3];
                    const float recv = __shfl_xor(L, 32);
                    sc_out[2 * idx + hi] = G + (hi ? recv : prev);
                    prev = recv; }
                acc[0] = f32x16{}; acc[1] = f32x16{};
#pragma unroll
                for (int j = 0; j < 4; ++j) if (j < nsub) {
#pragma unroll
                    for (int ss = 0; ss < 2; ++ss) {
                        const bf16x8 pb = pack8(s[j], 8 * ss);
#pragma unroll
                        for (int d0 = 0; d0 < 2; ++d0) {
                            const LAS unsigned char* vp = lds + voff + (32 * j + 16 * ss) * VROW + d0 * 64;
                            const s16x4 lo = vtr(vp), hh = vtr(vp + 8 * VROW);
                            const bf16x8 vf = (bf16x8){lo[0], lo[1], lo[2], lo[3], hh[0], hh[1], hh[2], hh[3]};
                            acc[d0] = __builtin_amdgcn_mfma_f32_32x32x16_bf16(vf, pb, acc[d0], 0, 0, 0);
                        }
                    } }
                store_o((bf16*)(ws + WS_OCMP) + tok * 512 + h * 64, acc, g0, hi);
            }
            __syncthreads();
            if (tid < 64) {
                const int t = 64 * qb + tid, sub = tid >> 5, rr = tid & 31;
                float sc[32];
#pragma unroll
                for (int n = 0; n < 32; ++n) sc[n] = 0.f;
#pragma unroll
                for (int r = 0; r < 4; ++r) { const LAS f32x4* p = (const LAS f32x4*)(lds + SC_OFF) + ((2 * r + sub) * 32 + rr) * 8;
#pragma unroll
                    for (int i = 0; i < 8; ++i) { const f32x4 v = p[i]; sc[4 * i] += v.x; sc[4 * i + 1] += v.y; sc[4 * i + 2] += v.z; sc[4 * i + 3] += v.w; } }
                const int cur = t >> 6;
#pragma unroll
                for (int n = 0; n < 32; ++n) sc[n] = (n == 0 || n == cur) ? 1e4f : ((64 * n <= t) ? sc[n] : -1.0f);
                unsigned mask = 0u;
#pragma unroll
                for (int k = 0; k < 8; ++k) {
                    float best = sc[0]; int bi = 0;
#pragma unroll
                    for (int n = 1; n < 32; ++n) { const bool take = sc[n] > best; best = take ? sc[n] : best; bi = take ? n : bi; }
                    mask |= 1u << bi;
#pragma unroll
                    for (int n = 0; n < 32; ++n) sc[n] = (n == bi) ? -INFINITY : sc[n];
                }
                ((LAS unsigned*)(lds + MK_OFF))[tid] = mask;
            }
            __syncthreads();
            const unsigned sel = ((const LAS unsigned*)(lds + MK_OFF))[32 * (wave & 1) + r32];
            rope_q(qf[0], pos[tok], hi);
            f32x16 o[2]; float l;
            { KV P{kv + 256, kv + 384, 768, 768, nullptr};
              FA_CORE_SEL<MODE_SELECT, false>(lds, P, 0, qb + 1, qf, tq, tq0, sel, o, l); }
            f32x16 acc[2];
            { const float sc = l > 0.f ? g1 / l : 0.f;
#pragma unroll
              for (int r = 0; r < 16; ++r) { acc[0][r] = o[0][r] * sc; acc[1][r] = o[1][r] * sc; } }
            { KV P{kv + 512, kv + 640, 768, 768, nullptr};
              FA_CORE_SEL<MODE_WINDOW, false>(lds, P, qb > 8 ? qb - 8 : 0, qb + 1, qf, tq, tq0, 0u, o, l); }
            { const float sc = l > 0.f ? g2 / l : 0.f;
              const bf16* oc = (const bf16*)(ws + WS_OCMP) + tok * 512 + h * 64;
#pragma unroll
              for (int d0 = 0; d0 < 2; ++d0)
#pragma unroll
                  for (int uu = 0; uu < 4; ++uu) { const u32x2 w = *(const u32x2*)(oc + 32 * d0 + 8 * uu + 4 * hi);
                      acc[d0][4 * uu] += o[d0][4 * uu] * sc + __uint_as_float(w.x << 16); acc[d0][4 * uu + 1] += o[d0][4 * uu + 1] * sc + __uint_as_float(w.x & 0xffff0000u);
                      acc[d0][4 * uu + 2] += o[d0][4 * uu + 2] * sc + __uint_as_float(w.y << 16); acc[d0][4 * uu + 3] += o[d0][4 * uu + 3] * sc + __uint_as_float(w.y & 0xffff0000u); } }
            if (!dry) store_o(Q + tok * 512 + h * 64, acc, 1.0f, hi);
        }
    }
}


__device__ __forceinline__ void phase_sb_mfma(const Frame& F, const KA& a, int l, bool dry) {
    using namespace fa;
    unsigned char* ws = a.ws();
    const int lane = F.lane, r32 = lane & 31, hi = lane >> 5;
    LAS unsigned char* lds = F.lds + F.wave * (32 * KROW + 32 * VROW);
    constexpr int SUB_B = 32 * KROW;
    const int koff = r32 * KROW + hi * 16;
    const int voff = SUB_B + (4 * hi + ((lane & 15) >> 2)) * VROW + (((lane >> 4) & 1) * 16 + (lane & 3) * 4) * 2;
    const unsigned shard = (unsigned)F.bid & 7u;
    unsigned* ctr = (unsigned*)(ws + WS_CTL) + CW_SB + 64 * (shard + 8 * (unsigned)l);
    for (;;) {
        unsigned k_ = 0u;
        if (lane == 0) k_ = __hip_atomic_fetch_add(ctr, 1u, __ATOMIC_RELAXED, __HIP_MEMORY_SCOPE_AGENT);
        k_ = (unsigned)__builtin_amdgcn_readfirstlane((int)k_);
        if (k_ >= 512u) break;
        const int u = (int)(shard * 512u + (511u - k_));
        const int bh = u >> 6, b = bh >> 3, h = bh & 7, rb = u & 63;
        const int tq0 = 32 * rb, tq = tq0 + r32;
        const size_t row0 = (size_t)b * SEQ, tok = row0 + tq;
        bf16* Q = (bf16*)(ws + WS_OQ);
        const bf16* Kg = (const bf16*)(ws + WS_KV) + row0 * 512 + h * 64; const bf16* Vg = (const bf16*)(ws + WS_KV + 16 * MiB) + row0 * 512 + h * 64;
        bf16x8 qf[4]; load_q(qf, Q + tok * 512 + h * 64, hi);
        f32x16 o[2]; o[0] = f32x16{}; o[1] = f32x16{};
        float carry = 1.0f;
        u32x4 ak[4], av[4], bk[4], bv[4];
#define SB_LOAD(K_, V_, j_) do { _Pragma("unroll") for (int i = 0; i < 4; ++i) { const int pc = lane + 64 * i, row = 32 * (j_) + (pc >> 3), ch = pc & 7; \
            K_[i] = *(const u32x4*)(Kg + (size_t)row * 512 + ch * 8); V_[i] = *(const u32x4*)(Vg + (size_t)row * 512 + ch * 8); } } while (0)
#define SB_STORE(K_, V_) do { _Pragma("unroll") for (int i = 0; i < 4; ++i) { const int pc = lane + 64 * i, off = (pc >> 3) * KROW + (pc & 7) * 16, offv = (pc >> 3) * VROW + (pc & 7) * 16; \
            *(LAS u32x4*)(lds + off) = K_[i]; *(LAS u32x4*)(lds + SUB_B + offv) = V_[i]; } } while (0)
#define SB_COMPUTE(jj_) do { const int jsub_ = (jj_); \
            f32x16 s = f32x16{}; \
_Pragma("unroll") \
            for (int d0 = 0; d0 < 4; ++d0) { const bf16x8 kf = *(const LAS bf16x8*)(lds + koff + d0 * 32); s = __builtin_amdgcn_mfma_f32_32x32x16_bf16(kf, qf[d0], s, 0, 0, 0); } \
            const int dd = tq - (32 * jsub_ + 4 * hi); \
            float keep[16]; \
_Pragma("unroll") \
            for (int r = 0; r < 16; ++r) { \
                const bool v = ((r & 3) + 8 * (r >> 2)) < dd; const float z = s[r]; \
                const float ea = __expf(-fabsf(z)), rr = __builtin_amdgcn_rcpf(1.0f + ea), sm = ea * rr; \
                const float beta = z >= 0.f ? rr : sm, kp = z >= 0.f ? sm : rr; \
                keep[r] = v ? kp : 1.0f; s[r] = v ? beta : 0.f; \
            } \
            float Go[4], Gp[4]; \
_Pragma("unroll") \
            for (int uu = 0; uu < 4; ++uu) { Go[uu] = (keep[4 * uu] * keep[4 * uu + 1]) * (keep[4 * uu + 2] * keep[4 * uu + 3]); Gp[uu] = __shfl_xor(Go[uu], 32); } \
            float above = carry; \
_Pragma("unroll") \
            for (int uu = 3; uu >= 0; --uu) { \
                const float e3 = above * (hi ? 1.0f : Gp[uu]); \
                const float e2 = e3 * keep[4 * uu + 3], e1 = e2 * keep[4 * uu + 2], e0 = e1 * keep[4 * uu + 1]; \
                s[4 * uu + 3] *= e3; s[4 * uu + 2] *= e2; s[4 * uu + 1] *= e1; s[4 * uu] *= e0; \
                above *= Go[uu] * Gp[uu]; \
            } \
            carry = above; \
_Pragma("unroll") \
            for (int ss = 0; ss < 2; ++ss) { \
                const bf16x8 pb = pack8(s, 8 * ss); \
_Pragma("unroll") \
                for (int d0 = 0; d0 < 2; ++d0) { \
                    const LAS unsigned char* vp = lds + voff + (16 * ss) * VROW + d0 * 64; \
                    const s16x4 lo = vtr(vp), hh = vtr(vp + 8 * VROW); \
                    const bf16x8 vf = (bf16x8){lo[0], lo[1], lo[2], lo[3], hh[0], hh[1], hh[2], hh[3]}; \
                    o[d0] = __builtin_amdgcn_mfma_f32_32x32x16_bf16(vf, pb, o[d0], 0, 0, 0); \
                } \
            } \
        } while (0)
        SB_LOAD(ak, av, rb);
        if (rb > 0) SB_LOAD(bk, bv, rb - 1);
        for (int j = rb; j >= 0; j -= 2) {
            SB_STORE(ak, av);
            if (j >= 2) SB_LOAD(ak, av, j - 2);
            SB_COMPUTE(j);
            if (__ballot(carry != 0.f) == 0ull) break;
            if (j == 0) break;
            SB_STORE(bk, bv);
            if (j >= 3) SB_LOAD(bk, bv, j - 3);
            SB_COMPUTE(j - 1);
            if (__ballot(carry != 0.f) == 0ull) break;
        }
#undef SB_LOAD
#undef SB_STORE
#undef SB_COMPUTE
        if (!dry) store_o(Q + tok * 512 + h * 64, o, 1.0f, hi);
    }
    __syncthreads();
}

__device__ __forceinline__ void phase_norm(const Frame& F, const KA& a, const bf16* ysrc, const float* xs, const float* gpost, const float* gpre, bool write_h, bool dry) {
    unsigned char* ws = a.ws();
    for (int r = F.gw; r < M; r += 2 * F.ngw) {
        const int r1 = (r + F.ngw < M) ? r + F.ngw : r;
        if (r1 != r) post_norm_rows2(ysrc + (size_t)r * DM, ysrc + (size_t)r1 * DM, xs + (size_t)r * DM, xs + (size_t)r1 * DM, a.out() + (size_t)r * DM, a.out() + (size_t)r1 * DM, gpost, gpre,
                                     (bf16*)(ws + WS_H) + (size_t)r * DM, (bf16*)(ws + WS_H) + (size_t)r1 * DM, write_h, dry, F.lane);
        else post_norm_row(ysrc + (size_t)r * DM, xs + (size_t)r * DM, a.out() + (size_t)r * DM, gpost, gpre, (bf16*)(ws + WS_H) + (size_t)r * DM, write_h, dry, F.lane);
    }
}

__device__ __forceinline__ void launder_frame(Frame& F) {
    int z = 0; asm volatile("" : "+s"(z));
    int t = threadIdx.x; asm volatile("" : "+v"(t));
    F.tid = t; F.lane = t & 63; F.wave = __builtin_amdgcn_readfirstlane(t >> 6);
    F.G = (int)gridDim.x + z; F.bid = (int)blockIdx.x + z;
    F.gw = F.bid * NWAVES + F.wave; F.ngw = F.G * NWAVES; F.gt = F.bid * NTHREADS + F.tid; F.ngt = F.G * NTHREADS;
}
constexpr int NPH = 19;
constexpr int LDS_BYTES = 147456;
constexpr int MISC_OFF = 131072 + 320;

template <int PSEL> __global__ void __launch_bounds__(NTHREADS, 2) hybrid_fwd(Args a_unused) {
    extern __shared__ __attribute__((aligned(16))) unsigned char lds_raw[];
    Frame F;
    F.lds = (LAS unsigned char*)lds_raw;
    F.tid = threadIdx.x; F.lane = F.tid & 63; F.wave = __builtin_amdgcn_readfirstlane(F.tid >> 6);
    F.G = gridDim.x; F.bid = blockIdx.x;
    F.gw = F.bid * NWAVES + F.wave; F.ngw = F.G * NWAVES; F.gt = F.bid * NTHREADS + F.tid; F.ngt = F.G * NTHREADS;
    volatile LAS unsigned* MISC = (volatile LAS unsigned*)(F.lds + MISC_OFF);
    if (F.tid < 32) MISC[F.tid] = 0u;
    __syncthreads();
    KA a; a.refresh();
    unsigned char* ws = a.ws();
    constexpr bool one_launch = PSEL < 0;
    XcdBarrier bar; bar.bar = (unsigned*)(ws + WS_CTL) + CW_BAR; bar.x = 0; bar.st = nullptr;
    if (one_launch) bar = xcd_barrier_post((unsigned*)(ws + WS_CTL) + CW_BAR, MISC + 8);
#define IN(k) (a.refresh(), ws = a.ws(), launder_frame(F), (PSEL < 0 || PSEL == ((k) - p0)))
#define REP(k) for (int rep_ = ((PROBE_MASK >> (k)) & 1) ? a.ph_hi() : 0; rep_ >= 0; --rep_)
#define DRY (rep_ > 0)
#define SEAM(k) do { if (PSEL < 0) { xcd_barrier(bar); if (PROBE_XBAR) xcd_barrier(bar); } } while (0)
    typedef pg8::bf16_t pb;
    const int l_lo = (PSEL < 0 ? 0 : a.ph_lo()), l_hi = (PSEL < 0 ? 2 : l_lo + 1);
    for (int l = l_lo; l < l_hi; ++l) {
        const int p0 = l * NPH;
        if (l == 0) { if (IN(p0 + 0)) REP(0) { phase_conv(F, a, 0); __syncthreads(); } SEAM(p0 + 0); }
        if (IN(p0 + 1)) REP(1) {
            pg8::Gemm g{(const pb*)(ws + WS_H), (const pb*)(ws + W_A), M, NA, DM}; pg8::StaticOrder S; S.init(M, NA, F.G, F.bid);
            pg8::EpiProj E{(pb*)(ws + WS_CK), (pb*)(ws + WS_OQ), (pb*)(ws + WS_KV), M};
            pg8::gemm_phase<pg8::EpiProj, pg8::StaticOrder, true, true>(F.lds, g, S, E);
            { pg8::Gemm g2{(const pb*)(ws + WS_MEMN), (const pb*)(ws + W_MKV), MMEM, 512, DM}; pg8::StaticOrder S2; S2.init(MMEM, 512, F.G, (F.bid + F.G - 128) % F.G);
              pg8::EpiPlain E2{(pb*)(ws + WS_MEMKV), 512}; pg8::gemm_phase<pg8::EpiPlain, pg8::StaticOrder, true, true>(F.lds, g2, S2, E2); }
            phase_conv_b(F, a, l);
        }
        SEAM(p0 + 1);
        if (IN(p0 + 3)) REP(3) {
            phase_post(F, a, l, DRY);
            { pg8::Gemm g{(const pb*)(ws + WS_CK), (const pb*)(ws + W_C1K), 2048, 512, 1024}; pg8::StaticOrder S; S.init(2048, 512, F.G, F.bid);
              pg8::EpiPlain E{(pb*)(ws + WS_PK), 512}; pg8::gemm_phase<pg8::EpiPlain, pg8::StaticOrder, true, true>(F.lds, g, S, E); }
            { pg8::Gemm g{(const pb*)(ws + WS_CV), (const pb*)(ws + W_C1V), 2048, 512, 1024}; pg8::StaticOrder S; S.init(2048, 512, F.G, (F.bid + F.G - 16) % F.G);
              pg8::EpiPlain E{(pb*)(ws + WS_PV), 512}; pg8::gemm_phase<pg8::EpiPlain, pg8::StaticOrder, true, true>(F.lds, g, S, E); }
            phase_sb_mfma(F, a, l, DRY);
        }
        SEAM(p0 + 3);
        if (IN(p0 + 4)) REP(4) { phase_cmp2(F, a, l); phase_fox_mfma(F, a, DRY); }
        SEAM(p0 + 4);
        if (IN(p0 + 5)) REP(5) phase_nsa_fused(F, a, DRY);
        SEAM(p0 + 5);
        if (IN(p0 + 8)) REP(8) {
            pb* T = (pb*)(ws + WS_MG) + (size_t)F.bid * 65536;
            for (int tile = F.bid; tile < 256; tile += F.G) {
                pg8::Unit v; v.pm = 8 * (tile & 7) + ((tile >> 3) & 7); v.pn = tile >> 6;
                for (int br = 0; br < 3; ++br) {
                    { pg8::Gemm g{(const pb*)(ws + WS_OQ), (const pb*)(ws + W_UP), 3 * M, 3072, 512}; pg8::OneOrder S{br * 64 + v.pm, br * 4 + v.pn};
                      pg8::EpiUpT E{T}; pg8::gemm_phase<pg8::EpiUpT, pg8::OneOrder, true, true>(F.lds, g, S, E); }
                    { pg8::Gemm g{(const pb*)(ws + WS_H), (const pb*)(ws + W_M), M, 3072, DM}; pg8::OneOrder S{v.pm, br * 4 + v.pn};
                      pg8::EpiGateT E{T, (pb*)(ws + WS_Y), br, DRY}; pg8::gemm_phase<pg8::EpiGateT, pg8::OneOrder, true, true>(F.lds, g, S, E); }
                }
            }
        }
        SEAM(p0 + 9);
        if (IN(p0 + 10)) REP(10) {
            pg8::Gemm g{(const pb*)(ws + WS_Y), (const pb*)(ws + W_OUT3), M, DM, DM}; pg8::StaticOrder S; S.init(M, DM, F.G, F.bid);
            pg8::EpiPlain E{(pb*)(ws + WS_MG), DM};
            pg8::gemm_phase<pg8::EpiPlain, pg8::StaticOrder, true, true>(F.lds, g, S, E);
        }
        SEAM(p0 + 10);
        if (IN(p0 + 11)) REP(11) phase_norm(F, a, (const bf16*)(ws + WS_MG), l == 0 ? (const float*)a.in(0) : (const float*)a.out(), (const float*)a.in(4) + l * DM, (const float*)a.in(5) + l * DM, true, DRY);
        SEAM(p0 + 11);
        if (IN(p0 + 12)) REP(12) {
            for (int kq = 0; kq < 4; ++kq) {
                pg8::Gemm g{(const pb*)(ws + WS_H) + kq * 256, (const pb*)(ws + W_MQ) + kq * 256, M, 256, 256, DM, DM}; pg8::StaticOrder S; S.init(M, 256, F.G, (F.bid + F.G - 64 * kq) % F.G);
                pg8::EpiPlain E{(pb*)(ws + WS_MQ) + (size_t)kq * M * 256, 256}; pg8::gemm_phase<pg8::EpiPlain, pg8::StaticOrder, true, true>(F.lds, g, S, E);
            }
        }
        SEAM(p0 + 12);
        if (IN(p0 + 13)) REP(13) phase_mem_mfma(F, a);
        SEAM(p0 + 13);
        if (IN(p0 + 14)) REP(14) {
            pg8::Gemm g{(const pb*)(ws + WS_MO), (const pb*)(ws + W_MO), M, DM, 256}; pg8::StaticOrder S; S.init(M, DM, F.G, F.bid);
            pg8::EpiPlain E{(pb*)(ws + WS_H), DM};
            pg8::gemm_phase<pg8::EpiPlain, pg8::StaticOrder, true, true>(F.lds, g, S, E);
        }
        SEAM(p0 + 14);
        if (IN(p0 + 15)) REP(15) phase_norm(F, a, (const bf16*)(ws + WS_H), (const float*)a.out(), (const float*)a.in(7) + l * DM, (const float*)a.in(8) + l * DM, true, DRY);
        SEAM(p0 + 15);
        if (IN(p0 + 16)) REP(16) {
            pg8::Gemm g{(const pb*)(ws + WS_H), (const pb*)(ws + W_GU), M, 2 * DFF, DM}; pg8::StaticOrder S; S.init(M, 2 * DFF, F.G, F.bid);
            pg8::EpiSwiglu E{(pb*)(ws + WS_ACT), DFF};
            pg8::gemm_phase<pg8::EpiSwiglu, pg8::StaticOrder, true, true>(F.lds, g, S, E);
        }
        SEAM(p0 + 16);
        if (IN(p0 + 17)) REP(17) {
            pg8::Gemm g{(const pb*)(ws + WS_ACT), (const pb*)(ws + W_DN), M, DM, DFF}; pg8::StaticOrder S; S.init(M, DM, F.G, F.bid);
            pg8::EpiPlain E{(pb*)(ws + WS_H), DM};
            pg8::gemm_phase<pg8::EpiPlain, pg8::StaticOrder, true, true>(F.lds, g, S, E);
        }
        SEAM(p0 + 17);
        if (IN(p0 + 18)) REP(18) { phase_norm(F, a, (const bf16*)(ws + WS_H), (const float*)a.out(), (const float*)a.in(9) + l * DM, (const float*)a.in(3) + (l + 1 < 2 ? l + 1 : l) * DM, l == 0, DRY);
            if (l == 0) { phase_conv(F, a, 1); __syncthreads(); } }
        if (l == 0) SEAM(p0 + 18);
    }
#undef IN
#undef SEAM
}

template <int P> static hipError_t set_attr1() { return hipFuncSetAttribute((const void*)hybrid_fwd<P>, hipFuncAttributeMaxDynamicSharedMemorySize, LDS_BYTES); }
template <int... P> static hipError_t set_attrs_seq(std::integer_sequence<int, P...>) { hipError_t e = hipSuccess; hipError_t r[] = {set_attr1<P>()...}; for (hipError_t x : r) if (x != hipSuccess) e = x; return e; }
static hipError_t set_attrs() {
#if MK_ONE_LAUNCH
    return set_attr1<-1>();
#else
    return set_attrs_seq(std::make_integer_sequence<int, NPH>{});
#endif
}
template <int P> static int launch1(const Args& a, int grid, hipStream_t stream) { hybrid_fwd<P><<<dim3(grid), dim3(NTHREADS), LDS_BYTES, stream>>>(a); return 0; }
template <int... P> static void launch_phases(const Args& a, int grid, hipStream_t stream, std::integer_sequence<int, P...>) {
    (void)std::initializer_list<int>{launch1<P>(a, grid, stream)...};
}

extern "C" void kernel_launch(void* const* d_in, const int* in_sizes, int n_in, void* d_out, int out_size, void* d_ws, size_t ws_size, hipStream_t stream) {
    static int grid = 0;
    if (grid == 0) {
        if (n_in != 31 || out_size != M * DM || ws_size < WS_END) { fprintf(stderr, "kernel_launch: unexpected problem (n_in %d, out %d, ws %zu)\n", n_in, out_size, ws_size); grid = -1; return; }
        if (set_attrs() != hipSuccess) { fprintf(stderr, "kernel_launch: hipFuncSetAttribute failed\n"); grid = -1; return; }
        int dev = 0, cus = 0;
        if (hipGetDevice(&dev) != hipSuccess || hipDeviceGetAttribute(&cus, hipDeviceAttributeMultiprocessorCount, dev) != hipSuccess) { grid = -1; return; }
        grid = cus;
    }
    if (grid < 0) return;
    (void)hipMemsetAsync((char*)d_ws + WS_CTL, 0, CTL_ZERO_BYTES, stream);
    Args a{};
    for (int i = 0; i < 31; ++i) a.in[i] = d_in[i];
    a.out = (float*)d_out; a.ws = (unsigned char*)d_ws;
#if MK_ONE_LAUNCH
    a.ph_lo = 0; a.ph_hi = PROBE_REPS;
    launch1<-1>(a, grid, stream);
#else
    for (int l = 0; l < 2; ++l) { a.ph_lo = l; a.ph_hi = l + 1; launch_phases(a, grid, stream, std::make_integer_sequence<int, NPH>{}); }
#endif
}
```

```cpp
#include <hip/hip_runtime.h>
#include <cstdio>
#include <cstdint>
#include <cmath>
#include <utility>
#include <initializer_list>
#define MK_ONE_LAUNCH 1
#define CONV1_EARLY 752
#define PROBE_MASK 0u
#define PROBE_REPS 0
#define PROBE_XBAR 0
#define PROBE_XP 0
#define FA_FULL 1
#define FA_RESC 1
#define FA_VAR 0
#define FA_CORE_MEM fa::flash_core_v4
#define FA_CORE_FOX fa::flash_core_v4
#define FA_CORE_SEL fa::flash_core_v4
#define GAS __attribute__((address_space(1)))
#define LAS __attribute__((address_space(3)))
namespace pg8 {
#define PG8_LAS __attribute__((address_space(3)))
typedef unsigned short bf16_t;
typedef short bf16x8 __attribute__((ext_vector_type(8)));
typedef float f32x4 __attribute__((ext_vector_type(4)));
typedef unsigned u32x4 __attribute__((ext_vector_type(4)));
constexpr int BM = 256, BK = 64, HALF = 128, HTB = HALF * BK * 2  , STAGE_BYTES = 8 * HTB, NXCD = 8, WGM = 8;

__host__ __device__ __forceinline__ int lds_byte(int r, int c) { const int st = (r >> 4) * 2 + (c >> 5), rr = r & 15, cc = c & 31, ob = rr * 64 + cc * 2; return st * 1024 + (ob ^ (((ob >> 9) & 1) << 5)); }
__host__ __device__ __forceinline__ void stage_rc(int b, int& R, int& C) { const int st = b / 1024, sb = b % 1024, swz = sb ^ (((sb >> 9) & 1) << 5); R = (st >> 1) * 16 + swz / 64; C = (st & 1) * 32 + (swz % 64) / 2; }
__host__ __device__ __forceinline__ int perm32(int rho) { const int n = rho >> 4, i = rho & 15; return 8 * (i >> 2) + 4 * n + (i & 3); }

struct Unit { int pm, pn; };
struct Gemm { const bf16_t* A; const bf16_t* Bt; int M, N, K; int lda, ldb; };

struct StaticOrder {
    int nM, nN, nwg, G, c;
    __host__ __device__ void init(int M, int N, int G_, int c_) { nM = M / BM; nN = N / BM; nwg = nM * nN; G = G_; c = c_; }
    __host__ __device__ bool next(int i, Unit& u) const {
        const long L = (long)i * G + c; if (L >= nwg) return false;
        int wgid = (int)L; { const int q = nwg / NXCD, r = nwg % NXCD, xcd = wgid % NXCD, off = wgid / NXCD; wgid = (xcd < r ? xcd * (q + 1) : r * (q + 1) + (xcd - r) * q) + off; }
        const int nig = WGM * nN, gid = wgid / nig, fm = gid * WGM, gsz = (nM - fm) < WGM ? (nM - fm) : WGM;
        u.pm = fm + ((wgid % nig) % gsz); u.pn = (wgid % nig) / gsz; return true;
    }
    __device__ __forceinline__ void a_ready(const Unit&) const {}
    __device__ __forceinline__ void done(const Unit&) const {}
};

typedef float cvt_f32x2_t __attribute__((ext_vector_type(2))); typedef __bf16 cvt_bf16x2_t __attribute__((ext_vector_type(2)));
__device__ __forceinline__ unsigned cvt_pk_bf16(float lo, float hi) { const cvt_f32x2_t v = {lo, hi}; const cvt_bf16x2_t b = __builtin_convertvector(v, cvt_bf16x2_t); return __builtin_bit_cast(unsigned, b); }
typedef float f32x2 __attribute__((ext_vector_type(2)));
template <class E, class = void> struct RsLds { static constexpr bool value = false; };
template <class E> struct RsLds<E, decltype((void)E::RS_LDS)> { static constexpr bool value = true; };
constexpr int RS_LDS_OFF = 133120;
__device__ __forceinline__ void rs_dma(const float* rs, int pm, PG8_LAS unsigned char* lds, int slot, int tid) {
    if (rs && tid < 256) { const int wv = __builtin_amdgcn_readfirstlane(tid >> 6);
        __builtin_amdgcn_global_load_lds((const unsigned*)(rs + (size_t)pm * BM + tid), (PG8_LAS unsigned*)(lds + RS_LDS_OFF + slot * 1024 + wv * 256), 4, 0, 0); }
}
template <class Epi, class Sched, bool ALIGN_EPI = false, bool SP2 = false>
__device__ __forceinline__ void gemm_phase(PG8_LAS unsigned char* lds, const Gemm g, const Sched& S, const Epi& E) {
    int tid_ = threadIdx.x; asm volatile("" : "+v"(tid_));
    const int tid = tid_, wid = __builtin_amdgcn_readfirstlane(tid >> 6), lane = tid & 63, wr = wid >> 2, wc = wid & 3, fr = lane & 15, fq = lane >> 4;
    const int K = g.K, nt = K / BK, lda = g.lda ? g.lda : K, ldb = g.ldb ? g.ldb : K;
    unsigned voffA[2], voffB[2];
#pragma unroll
    for (int i = 0; i < 2; ++i) { int R, C; stage_rc(tid * 16 + i * 8192, R, C); const int Rb = Epi::PERM ? ((R & ~31) + perm32(R & 31)) : R;
        voffA[i] = (unsigned)(R * lda + C) * 2u; voffB[i] = (unsigned)(Rb * ldb + C) * 2u; }
    const size_t kstep = (size_t)(BK * 2);
    const size_t hstepA = (size_t)HALF * lda * 2, hstepB = (size_t)HALF * ldb * 2;
    const size_t tstepA = 2 * hstepA, tstepB = 2 * hstepB;
    const unsigned ldsw = (unsigned)wid * 1024u;
    const int aoff = lds_byte(wr * 64 + fr, fq * 8), boff = lds_byte(wc * 32 + fr, fq * 8);
#define PG8_SA(b, h) (((b) * 2 + (h)) * HTB)
#define PG8_SB(b, h) ((4 + (b) * 2 + (h)) * HTB)
#define PG8_STAGE(bufoff, gbase, voff) do { _Pragma("unroll") for (int _i = 0; _i < 2; ++_i) \
        __builtin_amdgcn_global_load_lds((const unsigned*)((const char*)(gbase) + (voff)[_i]), (PG8_LAS unsigned*)(lds + (bufoff) + ldsw + _i * 8192), 16, 0, 0); } while (0)
#define PG8_LDA(dst, b, h) do { _Pragma("unroll") for (int m = 0; m < 4; ++m) _Pragma("unroll") for (int k = 0; k < 2; ++k) dst[m][k] = *(const PG8_LAS bf16x8*)(lds + PG8_SA(b, h) + aoff + m * 2048 + k * 1024); } while (0)
#define PG8_LDB(dst, b, h) do { _Pragma("unroll") for (int n = 0; n < 2; ++n) _Pragma("unroll") for (int k = 0; k < 2; ++k) dst[n][k] = *(const PG8_LAS bf16x8*)(lds + PG8_SB(b, h) + boff + n * 2048 + k * 1024); } while (0)
#define PG8_MMA(ai, bj, At, Bt) do { __builtin_amdgcn_s_setprio(1); _Pragma("unroll") for (int m = 0; m < 4; ++m) _Pragma("unroll") for (int n = 0; n < 2; ++n) _Pragma("unroll") for (int k = 0; k < 2; ++k) \
        acc[ai][bj][m][n] = __builtin_amdgcn_mfma_f32_16x16x32_bf16(Bt[n][k], At[m][k], acc[ai][bj][m][n], 0, 0, 0); __builtin_amdgcn_s_setprio(0); } while (0)
#define PG8_WAIT_V(n) asm volatile("s_waitcnt vmcnt(" #n ")" ::: "memory")
#define PG8_WAIT_L(n) asm volatile("s_waitcnt lgkmcnt(" #n ")" ::: "memory")
#define PG8_BAR __builtin_amdgcn_s_barrier()
#define PG8_SCHED __builtin_amdgcn_sched_barrier(0)
    Unit cur, nxt; int ui = 0;
    if (!S.next(0, cur)) return;
    float zz_ = 0.f; asm volatile("" : "+v"(zz_));
    f32x4 acc[2][2][4][2];
#pragma unroll
    for (int a = 0; a < 2; ++a)
#pragma unroll
        for (int b = 0; b < 2; ++b)
#pragma unroll
            for (int m = 0; m < 4; ++m)
#pragma unroll
                for (int n = 0; n < 2; ++n) acc[a][b][m][n] = (f32x4){zz_, zz_, zz_, zz_};
    bf16x8 At[4][2], B0[2][2], B1[2][2];
    const char* cA = (const char*)g.A + (size_t)cur.pm * tstepA; const char* cB = (const char*)g.Bt + (size_t)cur.pn * tstepB;
    S.a_ready(cur);
    if constexpr (RsLds<Epi>::value) rs_dma(E.rs, cur.pm, lds, 0, tid);
    if constexpr (SP2) {
        PG8_STAGE(PG8_SB(0, 0), cB, voffB); PG8_STAGE(PG8_SB(0, 1), cB + hstepB, voffB); PG8_STAGE(PG8_SA(0, 0), cA, voffA); PG8_STAGE(PG8_SA(0, 1), cA + hstepA, voffA);
        if (wr == 1) PG8_BAR;
        PG8_WAIT_V(2); PG8_BAR;
        PG8_STAGE(PG8_SB(1, 0), cB + kstep, voffB); PG8_STAGE(PG8_SA(1, 0), cA + kstep, voffA); PG8_STAGE(PG8_SB(1, 1), cB + hstepB + kstep, voffB);
        PG8_WAIT_V(6); PG8_BAR;
    } else {
        PG8_STAGE(PG8_SB(0, 0), cB, voffB); PG8_STAGE(PG8_SA(0, 0), cA, voffA); PG8_STAGE(PG8_SB(0, 1), cB + hstepB, voffB); PG8_STAGE(PG8_SA(0, 1), cA + hstepA, voffA);
        if (wr == 1) PG8_BAR;
        PG8_WAIT_V(4); PG8_BAR;
        PG8_STAGE(PG8_SB(1, 0), cB + kstep, voffB); PG8_STAGE(PG8_SA(1, 0), cA + kstep, voffA); PG8_STAGE(PG8_SB(1, 1), cB + hstepB + kstep, voffB);
        PG8_WAIT_V(6); PG8_BAR;
    }
    for (;;) {
        const bool has_next = S.next(ui + 1, nxt);
        const char* nA = has_next ? (const char*)g.A + (size_t)nxt.pm * tstepA : cA; const char* nB = has_next ? (const char*)g.Bt + (size_t)nxt.pn * tstepB : cB;
        for (int t = 0; t < nt; t += 2) {
            const bool last = (t == nt - 2);
            const char* a1 = cA + (size_t)(t + 1) * kstep;
            const char* a2 = last ? nA : cA + (size_t)(t + 2) * kstep; const char* b2 = last ? nB : cB + (size_t)(t + 2) * kstep;
            const char* a3 = a2 + kstep; const char* b3 = b2 + kstep;
            if (last && has_next) S.a_ready(nxt);
            if constexpr (SP2) {
            PG8_LDB(B0, 0, 0); PG8_LDB(B1, 0, 1); PG8_SCHED; PG8_LDA(At, 0, 0); PG8_STAGE(PG8_SA(1, 1), a1 + hstepA, voffA);
            PG8_WAIT_V(8); PG8_WAIT_L(0); PG8_BAR; PG8_MMA(0, 0, At, B0); PG8_MMA(0, 1, At, B1); PG8_BAR; PG8_SCHED;
            PG8_LDA(At, 0, 1); PG8_STAGE(PG8_SB(0, 0), b2, voffB); PG8_STAGE(PG8_SB(0, 1), b2 + hstepB, voffB); PG8_STAGE(PG8_SA(0, 0), a2, voffA);
            PG8_WAIT_V(8); PG8_WAIT_L(0); PG8_BAR; PG8_MMA(1, 0, At, B0); PG8_MMA(1, 1, At, B1); PG8_BAR; PG8_SCHED;
            PG8_LDB(B0, 1, 0); PG8_LDB(B1, 1, 1); PG8_SCHED; PG8_LDA(At, 1, 0); PG8_STAGE(PG8_SA(0, 1), a2 + hstepA, voffA);
            PG8_WAIT_V(8); PG8_WAIT_L(0); PG8_BAR; PG8_MMA(0, 0, At, B0); PG8_MMA(0, 1, At, B1); PG8_BAR; PG8_SCHED;
            PG8_LDA(At, 1, 1); PG8_STAGE(PG8_SB(1, 0), b3, voffB); PG8_STAGE(PG8_SB(1, 1), b3 + hstepB, voffB); PG8_STAGE(PG8_SA(1, 0), a3, voffA);
            PG8_WAIT_V(8); PG8_WAIT_L(0); PG8_BAR; PG8_MMA(1, 0, At, B0); PG8_MMA(1, 1, At, B1); PG8_BAR; PG8_SCHED;
            } else {
            PG8_LDB(B0, 0, 0); PG8_SCHED; PG8_LDA(At, 0, 0); PG8_STAGE(PG8_SA(1, 1), a1 + hstepA, voffA);
            PG8_WAIT_L(8); PG8_BAR; PG8_WAIT_L(0); PG8_MMA(0, 0, At, B0); PG8_BAR; PG8_SCHED;
            PG8_LDB(B1, 0, 1); PG8_STAGE(PG8_SB(0, 0), b2, voffB);
            PG8_BAR; PG8_WAIT_L(0); PG8_MMA(0, 1, At, B1); PG8_BAR;
            PG8_LDA(At, 0, 1); PG8_STAGE(PG8_SA(0, 0), a2, voffA);
            PG8_BAR; PG8_WAIT_L(0); PG8_MMA(1, 0, At, B0); PG8_BAR; PG8_SCHED;
            PG8_STAGE(PG8_SB(0, 1), b2 + hstepB, voffB);
            PG8_WAIT_V(6); PG8_BAR; PG8_MMA(1, 1, At, B1); PG8_BAR;
            PG8_LDB(B0, 1, 0); PG8_SCHED; PG8_LDA(At, 1, 0); PG8_STAGE(PG8_SA(0, 1), a2 + hstepA, voffA);
            PG8_WAIT_L(8); PG8_BAR; PG8_WAIT_L(0); PG8_MMA(0, 0, At, B0); PG8_BAR; PG8_SCHED;
            PG8_LDB(B1, 1, 1); PG8_STAGE(PG8_SB(1, 0), b3, voffB);
            PG8_BAR; PG8_WAIT_L(0); PG8_MMA(0, 1, At, B1); PG8_BAR;
            PG8_LDA(At, 1, 1); PG8_STAGE(PG8_SA(1, 0), a3, voffA);
            PG8_BAR; PG8_WAIT_L(0); PG8_MMA(1, 0, At, B0); PG8_BAR; PG8_SCHED;
            PG8_STAGE(PG8_SB(1, 1), b3 + hstepB, voffB);
            PG8_WAIT_V(6); PG8_BAR; PG8_MMA(1, 1, At, B1); PG8_BAR;
            }
        }
        if constexpr (ALIGN_EPI) { if (wr == 0) PG8_BAR; }
        if constexpr (!Epi::AFTER_DRAIN) { if constexpr (RsLds<Epi>::value) E.with_rs(acc, cur, wr, wc, fr, fq, (const PG8_LAS float*)(lds + RS_LDS_OFF + (ui & 1) * 1024)); else E(acc, cur, wr, wc, fr, fq); S.done(cur); }
        if (!has_next) break;
#pragma unroll
        for (int a = 0; a < 2; ++a)
#pragma unroll
            for (int b = 0; b < 2; ++b)
#pragma unroll
                for (int m = 0; m < 4; ++m)
#pragma unroll
                    for (int n = 0; n < 2; ++n) acc[a][b][m][n] = (f32x4){zz_, zz_, zz_, zz_};
        cur = nxt; cA = nA; cB = nB; ++ui;
        if constexpr (RsLds<Epi>::value) rs_dma(E.rs, cur.pm, lds, ui & 1, tid);
        if constexpr (ALIGN_EPI) { if (wr == 1) PG8_BAR; }
    }
    PG8_WAIT_V(0);
    if constexpr (!ALIGN_EPI) { if (wr == 0) PG8_BAR; }
    PG8_BAR;
    if constexpr (Epi::AFTER_DRAIN) { E.fused(acc, cur, wr, wc, fr, fq, lds, wid, lane); S.done(cur); }
#undef PG8_SA
#undef PG8_SB
#undef PG8_STAGE
#undef PG8_LDA
#undef PG8_LDB
#undef PG8_MMA
#undef PG8_WAIT_V
#undef PG8_WAIT_L
#undef PG8_BAR
#undef PG8_SCHED
}
}
#define XB_TMO      128
#define XB_XCNT(j)  (256  + 64 * (j))
#define XB_XSUB(j)  (1280 + 64 * (j))
#define XB_XGEN(j)  (2304 + 64 * (j))
#define XB_TOP      3328
#define XB_TOPGEN   3392
#define XCD_BAR_WORDS 3456
#define XB_SPIN_CAP (1u << 18)

__device__ __forceinline__ unsigned xb_ld(unsigned* p)              { return __hip_atomic_load(p, __ATOMIC_RELAXED, __HIP_MEMORY_SCOPE_AGENT); }
__device__ __forceinline__ unsigned xb_add(unsigned* p, unsigned v) { return __hip_atomic_fetch_add(p, v, __ATOMIC_RELAXED, __HIP_MEMORY_SCOPE_AGENT); }
__device__ __forceinline__ unsigned xb_xcc_id() { return (unsigned)__builtin_amdgcn_s_getreg((3 << 11) | 20) & 0xFu; }
#define XB_SPIN(cond, bar) do { unsigned _sp = 0; while (cond) { __builtin_amdgcn_s_sleep(1); \
    if ((++_sp & 255u) == 0u) { if (xb_ld(&(bar)[XB_TMO])) break; if (_sp > XB_SPIN_CAP) { atomicAdd(&(bar)[XB_TMO], 1u); break; } } } } while (0)

struct XcdBarrier {
    unsigned* bar; unsigned x;
    volatile LAS unsigned* st;
};

__device__ __forceinline__ XcdBarrier xcd_barrier_post(unsigned* bar, volatile LAS unsigned* st) {
    XcdBarrier b; b.bar = bar; b.x = xb_xcc_id(); b.st = st;
    if (threadIdx.x == 0) (void)xb_add(&bar[XB_XCNT(b.x)], 1u);
    return b;
}
__device__ __forceinline__ void xcd_barrier_complete(unsigned* bar, unsigned x, unsigned& nloc, unsigned& nx) {
    const unsigned G = gridDim.x * gridDim.y * gridDim.z;
    unsigned sum, cnt, mine, sp = 0u;
    for (;;) {
        sum = 0u; cnt = 0u; mine = 0u;
#pragma unroll
        for (unsigned j = 0; j < 16; ++j) { const unsigned c = xb_ld(&bar[XB_XCNT(j)]); sum += c; cnt += (c > 0u) ? 1u : 0u; mine = (j == x) ? c : mine; }
        if (sum == G) break;
        __builtin_amdgcn_s_sleep(1);
        if ((++sp & 255u) == 0u) { if (xb_ld(&bar[XB_TMO])) break; if (sp > XB_SPIN_CAP) { atomicAdd(&bar[XB_TMO], 1u); break; } }
    }
    nloc = mine > 0u ? mine : 1u; nx = cnt > 0u ? cnt : 1u;
}

__device__ __forceinline__ void xcd_barrier(const XcdBarrier& b) {
    asm volatile("s_waitcnt vmcnt(0)" ::: "memory");
    __syncthreads();
    if (threadIdx.x == 0) {
        unsigned* bar = b.bar;
        __builtin_amdgcn_s_waitcnt(0);
        unsigned nloc = b.st[0], nx = b.st[1];
        if (nloc == 0u) { xcd_barrier_complete(bar, b.x, nloc, nx); b.st[0] = nloc; b.st[1] = nx; }
        const unsigned old = xb_add(&bar[XB_XSUB(b.x)], 1u);
        const unsigned gen = old / nloc;
        if (old + 1u == (gen + 1u) * nloc) {
            __builtin_amdgcn_fence(__ATOMIC_RELEASE, "agent");
            asm volatile("s_waitcnt vmcnt(0)" ::: "memory");
            const unsigned og = xb_add(&bar[XB_TOP], 1u);
            const unsigned tg = og / nx;
            if (og + 1u == (tg + 1u) * nx) xb_add(&bar[XB_TOPGEN], 1u);
            else XB_SPIN(xb_ld(&bar[XB_TOPGEN]) == tg, bar);
            __builtin_amdgcn_fence(__ATOMIC_ACQUIRE, "agent");
            xb_add(&bar[XB_XGEN(b.x)], 1u);
            asm volatile("s_waitcnt vmcnt(0)" ::: "memory");
        } else {
            XB_SPIN(xb_ld(&bar[XB_XGEN(b.x)]) == gen, bar);
            __builtin_amdgcn_fence(__ATOMIC_ACQUIRE, "agent");
            asm volatile("s_waitcnt vmcnt(0)" ::: "memory");
        }
    }
    __syncthreads();
}

namespace pg8 {
typedef unsigned u32x4e __attribute__((ext_vector_type(4)));
typedef int i32x4e __attribute__((ext_vector_type(4)));
__device__ __forceinline__ __amdgpu_buffer_rsrc_t wt_rsrc(const void* base) {
    const unsigned long long b = (unsigned long long)base;
    void* ub = (void*)(((unsigned long long)(unsigned)__builtin_amdgcn_readfirstlane((int)(b >> 32)) << 32) | (unsigned)__builtin_amdgcn_readfirstlane((int)b));
    return __builtin_amdgcn_make_buffer_rsrc(ub, (short)0, (int)0x7ffffff0, 0x00020000); }
__device__ __forceinline__ void st16_wt(__amdgpu_buffer_rsrc_t r, unsigned off, u32x4e w) { __builtin_amdgcn_raw_buffer_store_b128(w, r, (int)off, 0, 16); }
struct EpiPlain {
    static constexpr bool PERM = true, AFTER_DRAIN = false;
    bf16_t* O; int ld;
    __device__ __forceinline__ void operator()(const f32x4 (&acc)[2][2][4][2], const Unit& u, int wr, int wc, int fr, int fq) const {
        bf16_t* base = O + (size_t)(u.pm * BM + wr * 64 + fr) * ld + u.pn * BM + wc * 32 + 8 * fq;
        const bf16_t* wt_base_ = O; const __amdgpu_buffer_rsrc_t wt_r_ = wt_rsrc(wt_base_);
#pragma unroll
        for (int ai = 0; ai < 2; ++ai)
#pragma unroll
            for (int m = 0; m < 4; ++m) { bf16_t* rowp = base + (size_t)(ai * HALF + m * 16) * ld;
#pragma unroll
                for (int bj = 0; bj < 2; ++bj) { const f32x4 v0 = acc[ai][bj][m][0], v1 = acc[ai][bj][m][1];
                    u32x4e w; w.x = cvt_pk_bf16(v0[0], v0[1]); w.y = cvt_pk_bf16(v0[2], v0[3]); w.z = cvt_pk_bf16(v1[0], v1[1]); w.w = cvt_pk_bf16(v1[2], v1[3]);
                    st16_wt(wt_r_, (unsigned)((const char*)(rowp + bj * HALF) - (const char*)wt_base_), w); } }
    }
};
struct EpiProj {
    static constexpr bool PERM = true, AFTER_DRAIN = false, RS_LDS = true;
    bf16_t* ck;
    bf16_t* oq; bf16_t* kv;
    int Mrows; const float* rs;
    __device__ __forceinline__ void with_rs(const f32x4 (&acc)[2][2][4][2], const Unit& u, int wr, int wc, int fr, int fq, const PG8_LAS float* rsl) const {
        const int pn = u.pn; const size_t MS = (size_t)Mrows * 512;
        bf16_t* dst; int ld, c0;
        if (pn < 2)       { dst = oq;            ld = 512; c0 = pn * 256; }
        else if (pn < 4)  { dst = kv;            ld = 512; c0 = (pn - 2) * 256; }
        else if (pn < 6)  { dst = kv + MS;       ld = 512; c0 = (pn - 4) * 256; }
        else if (pn < 8)  { dst = oq + MS;       ld = 512; c0 = (pn - 6) * 256; }
        else if (pn < 11) { dst = kv + 4 * MS;   ld = 768; c0 = (pn - 8) * 256; }
        else if (pn < 13) { dst = oq + 2 * MS;   ld = 512; c0 = (pn - 11) * 256; }
        else if (pn < 15) { dst = kv + 2 * MS;   ld = 512; c0 = (pn - 13) * 256; }
        else if (pn < 17) { dst = kv + 3 * MS;   ld = 512; c0 = (pn - 15) * 256; }
        else              { dst = kv + 4 * MS + (size_t)Mrows * 768; ld = 256; c0 = 0; }
        bf16_t* base = dst + (size_t)(u.pm * BM + wr * 64 + fr) * ld + c0 + wc * 32 + 8 * fq;
        size_t bjs = HALF;
        if (pn == 8) {
            base = ck + ((size_t)(wc >> 1) * Mrows + (size_t)(u.pm * BM + wr * 64 + fr)) * 64 + (wc & 1) * 32 + 8 * fq; ld = 64; bjs = (size_t)2 * Mrows * 64; }
        const bf16_t* wt_base_ = (pn == 8 ? ck : dst); const __amdgpu_buffer_rsrc_t wt_r_ = wt_rsrc(wt_base_);
        float rsr[2][4];
#pragma unroll
        for (int ai = 0; ai < 2; ++ai)
#pragma unroll
            for (int m = 0; m < 4; ++m) rsr[ai][m] = rs ? rsl[wr * 64 + fr + ai * HALF + m * 16] : 1.0f;
#pragma unroll
        for (int ai = 0; ai < 2; ++ai)
#pragma unroll
            for (int m = 0; m < 4; ++m) { bf16_t* rowp = base + (size_t)(ai * HALF + m * 16) * ld; const float rsv = rsr[ai][m];
#pragma unroll
                for (int bj = 0; bj < 2; ++bj) { const f32x4 v0 = acc[ai][bj][m][0] * rsv, v1 = acc[ai][bj][m][1] * rsv;
                    u32x4e w; w.x = cvt_pk_bf16(v0[0], v0[1]); w.y = cvt_pk_bf16(v0[2], v0[3]); w.z = cvt_pk_bf16(v1[0], v1[1]); w.w = cvt_pk_bf16(v1[2], v1[3]);
                    st16_wt(wt_r_, (unsigned)((const char*)(rowp + bj * bjs) - (const char*)wt_base_), w); } }
    }
};
__device__ __forceinline__ float sigmoidf_(float x) { return __builtin_amdgcn_rcpf(1.0f + __expf(-x)); }
struct EpiUpT {
    static constexpr bool PERM = true, AFTER_DRAIN = false;
    bf16_t* T;
    __device__ __forceinline__ void operator()(const f32x4 (&acc)[2][2][4][2], const Unit& u, int wr, int wc, int fr, int fq) const {
        bf16_t* base = T + (size_t)(wr * 64 + fr) * 256 + wc * 32 + 8 * fq;
#pragma unroll
        for (int ai = 0; ai < 2; ++ai)
#pragma unroll
            for (int m = 0; m < 4; ++m) { bf16_t* rowp = base + (size_t)(ai * HALF + m * 16) * 256;
#pragma unroll
                for (int bj = 0; bj < 2; ++bj) { const f32x4 v0 = acc[ai][bj][m][0], v1 = acc[ai][bj][m][1];
                    u32x4e w; w.x = cvt_pk_bf16(v0[0], v0[1]); w.y = cvt_pk_bf16(v0[2], v0[3]); w.z = cvt_pk_bf16(v1[0], v1[1]); w.w = cvt_pk_bf16(v1[2], v1[3]);
                    *(u32x4e*)(rowp + bj * HALF) = w; } }
    }
};
struct EpiGateT {
    static constexpr bool PERM = true, AFTER_DRAIN = false;
    const bf16_t* T; bf16_t* Y; int branch; bool dry; const float* rs; const PG8_LAS float* rsl;
    __device__ __forceinline__ void operator()(const f32x4 (&acc)[2][2][4][2], const Unit& u, int wr, int wc, int fr, int fq) const {
        const int pnr = u.pn & 3;
        const size_t r0 = (size_t)(u.pm * BM + wr * 64 + fr); const int c0 = pnr * BM + wc * 32 + 8 * fq;
        const bf16_t* tb = T + (size_t)(wr * 64 + fr) * 256 + wc * 32 + 8 * fq;
        const __amdgpu_buffer_rsrc_t yr_ = wt_rsrc(Y);
        float rsr[2][4];
#pragma unroll
        for (int ai = 0; ai < 2; ++ai)
#pragma unroll
            for (int m = 0; m < 4; ++m) rsr[ai][m] = rs ? rsl[wr * 64 + fr + ai * HALF + m * 16] : 1.0f;
#pragma unroll
        for (int aih = 0; aih < 4; ++aih) { const int ai = aih >> 1, m0 = (aih & 1) * 2;
            u32x4e g[8], p[8];
#pragma unroll
            for (int m = m0; m < m0 + 2; ++m)
#pragma unroll
                for (int bj = 0; bj < 2; ++bj) g[2 * m + bj] = *(const u32x4e*)(tb + (size_t)(ai * HALF + m * 16) * 256 + bj * HALF);
            if (branch != 0) {
#pragma unroll
                for (int m = m0; m < m0 + 2; ++m)
#pragma unroll
                    for (int bj = 0; bj < 2; ++bj) p[2 * m + bj] = *(const u32x4e*)(Y + (r0 + ai * HALF + m * 16) * 1024 + c0 + bj * HALF);
            }
#pragma unroll
            for (int m = m0; m < m0 + 2; ++m) { const size_t row = r0 + ai * HALF + m * 16; const float rsv = rsr[ai][m];
#pragma unroll
                for (int bj = 0; bj < 2; ++bj) { const f32x4 v0 = acc[ai][bj][m][0] * rsv, v1 = acc[ai][bj][m][1] * rsv;
                    const u32x4e gg = g[2 * m + bj];
                    bf16_t* yp = Y + row * 1024 + c0 + bj * HALF;
                    float y[8];
                    y[0] = sigmoidf_(v0[0]) * __uint_as_float(gg.x << 16); y[1] = sigmoidf_(v0[1]) * __uint_as_float(gg.x & 0xffff0000u); y[2] = sigmoidf_(v0[2]) * __uint_as_float(gg.y << 16); y[3] = sigmoidf_(v0[3]) * __uint_as_float(gg.y & 0xffff0000u);
                    y[4] = sigmoidf_(v1[0]) * __uint_as_float(gg.z << 16); y[5] = sigmoidf_(v1[1]) * __uint_as_float(gg.z & 0xffff0000u); y[6] = sigmoidf_(v1[2]) * __uint_as_float(gg.w << 16); y[7] = sigmoidf_(v1[3]) * __uint_as_float(gg.w & 0xffff0000u);
                    if (branch != 0) { const u32x4e pp = p[2 * m + bj];
                        y[0] += __uint_as_float(pp.x << 16); y[1] += __uint_as_float(pp.x & 0xffff0000u); y[2] += __uint_as_float(pp.y << 16); y[3] += __uint_as_float(pp.y & 0xffff0000u);
                        y[4] += __uint_as_float(pp.z << 16); y[5] += __uint_as_float(pp.z & 0xffff0000u); y[6] += __uint_as_float(pp.w << 16); y[7] += __uint_as_float(pp.w & 0xffff0000u); }
                    u32x4e w; w.x = cvt_pk_bf16(y[0], y[1]); w.y = cvt_pk_bf16(y[2], y[3]); w.z = cvt_pk_bf16(y[4], y[5]); w.w = cvt_pk_bf16(y[6], y[7]);
                    if (!dry) { if (branch == 2) st16_wt(yr_, (unsigned)((const char*)yp - (const char*)Y), w); else *(u32x4e*)yp = w; } } }
        }
    }
};
struct Gemm2 { const bf16_t* A0; const bf16_t* B0; const bf16_t* A1; const bf16_t* B1; };
struct SixOrder {
    int pmv, pnv;
    __host__ __device__ bool next(int i, Unit& u) const { const int br = i >> 1, gs = i & 1; u.pm = pmv + (gs ? 0 : br * 64); u.pn = (br * 4 + pnv) | (gs << 16); return i < 6; }
};
struct EpiUpGate {
    static constexpr bool PERM = true, AFTER_DRAIN = false;
    bf16_t* T; bf16_t* Y; bool dry; const float* rs;
    __device__ __forceinline__ void with_rs(const f32x4 (&acc)[2][2][4][2], const Unit& u, int wr, int wc, int fr, int fq, const PG8_LAS float* rsl) const {
        Unit v; v.pm = u.pm; v.pn = u.pn & 0xffff;
        unsigned long long t_ = (unsigned long long)T, y_ = (unsigned long long)Y; asm volatile("" : "+s"(t_), "+s"(y_));
        int z_ = 0; asm volatile("" : "+v"(z_));
        bf16_t* Tl = (bf16_t*)(__attribute__((address_space(1))) bf16_t*)t_; bf16_t* Yl = (bf16_t*)(__attribute__((address_space(1))) bf16_t*)y_;
        if ((u.pn >> 16) & 1) { EpiGateT e{Tl, Yl, v.pn >> 2, dry, rs, rsl}; e(acc, v, wr, wc, fr + z_, fq + z_); }
        else { EpiUpT e{Tl}; e(acc, v, wr, wc, fr + z_, fq + z_); }
    }
};
template <class Epi, class Sched>
__device__ __forceinline__ void gemm_phase_mg(PG8_LAS unsigned char* lds, const Gemm2 g, const Sched& S, const Epi& E) {
    int tid_ = threadIdx.x; asm volatile("" : "+v"(tid_));
    const int tid = tid_, wid = __builtin_amdgcn_readfirstlane(tid >> 6), lane = tid & 63, wr = wid >> 2, wc = wid & 3, fr = lane & 15, fq = lane >> 4;
    unsigned voffA[2], voffB[2];
#pragma unroll
    for (int i = 0; i < 2; ++i) { int R, C; stage_rc(tid * 16 + i * 8192, R, C); const int Rb = Epi::PERM ? ((R & ~31) + perm32(R & 31)) : R;
        voffA[i] = (unsigned)(R * 512 + C) * 2u; voffB[i] = (unsigned)(Rb * 512 + C) * 2u; }
    const size_t kstep = (size_t)(BK * 2);
    const unsigned ldsw = (unsigned)wid * 1024u;
    const int aoff = lds_byte(wr * 64 + fr, fq * 8), boff = lds_byte(wc * 32 + fr, fq * 8);
#define MG_SA(b, h) (((b) * 2 + (h)) * HTB)
#define MG_SB(b, h) ((4 + (b) * 2 + (h)) * HTB)
#define MG_STAGE(bufoff, gbase, voff, msk) do { _Pragma("unroll") for (int _i = 0; _i < 2; ++_i) \
        __builtin_amdgcn_global_load_lds((const unsigned*)((const char*)(gbase) + ((voff)[_i] + ((voff)[_i] & (msk)))), (PG8_LAS unsigned*)(lds + (bufoff) + ldsw + _i * 8192), 16, 0, 0); } while (0)
#define MG_LDA(dst, b, h) do { _Pragma("unroll") for (int m = 0; m < 4; ++m) _Pragma("unroll") for (int k = 0; k < 2; ++k) dst[m][k] = *(const PG8_LAS bf16x8*)(lds + MG_SA(b, h) + aoff + m * 2048 + k * 1024); } while (0)
#define MG_LDB(dst, b, h) do { _Pragma("unroll") for (int n = 0; n < 2; ++n) _Pragma("unroll") for (int k = 0; k < 2; ++k) dst[n][k] = *(const PG8_LAS bf16x8*)(lds + MG_SB(b, h) + boff + n * 2048 + k * 1024); } while (0)
#define MG_MMA(ai, bj, At, Bt) do { __builtin_amdgcn_s_setprio(1); _Pragma("unroll") for (int m = 0; m < 4; ++m) _Pragma("unroll") for (int n = 0; n < 2; ++n) _Pragma("unroll") for (int k = 0; k < 2; ++k) \
        acc[ai][bj][m][n] = __builtin_amdgcn_mfma_f32_16x16x32_bf16(Bt[n][k], At[m][k], acc[ai][bj][m][n], 0, 0, 0); __builtin_amdgcn_s_setprio(0); } while (0)
#define MG_WAIT_V(n) asm volatile("s_waitcnt vmcnt(" #n ")" ::: "memory")
#define MG_WAIT_L(n) asm volatile("s_waitcnt lgkmcnt(" #n ")" ::: "memory")
#define MG_BAR __builtin_amdgcn_s_barrier()
#define MG_SCHED __builtin_amdgcn_sched_barrier(0)
#define MG_DECODE(u, pA, pB, n_, m_, h_) do { const int gs_ = ((u).pn >> 16) & 1; h_ = (unsigned)(HALF * 512 * 2) << gs_; n_ = 8 << gs_; m_ = gs_ ? 0xfffffc00u : 0u; \
        pA = (const char*)(gs_ ? g.A1 : g.A0) + (size_t)(u).pm * (size_t)(2u * h_); pB = (const char*)(gs_ ? g.B1 : g.B0) + (size_t)((u).pn & 0xffff) * (size_t)(2u * h_); } while (0)
    Unit cur, nxt; int ui = 0;
    if (!S.next(0, cur)) return;
    rs_dma(E.rs, S.pmv, lds, 0, tid);
    float zz_ = 0.f; asm volatile("" : "+v"(zz_));
    f32x4 acc[2][2][4][2];
#pragma unroll
    for (int a = 0; a < 2; ++a)
#pragma unroll
        for (int b = 0; b < 2; ++b)
#pragma unroll
            for (int m = 0; m < 4; ++m)
#pragma unroll
                for (int n = 0; n < 2; ++n) acc[a][b][m][n] = (f32x4){zz_, zz_, zz_, zz_};
    bf16x8 At[4][2], B0[2][2], B1[2][2];
    const char* cA; const char* cB; int ntc; unsigned mskc; unsigned hstc;
    MG_DECODE(cur, cA, cB, ntc, mskc, hstc);
    MG_STAGE(MG_SB(0, 0), cB, voffB, mskc); MG_STAGE(MG_SB(0, 1), cB + hstc, voffB, mskc); MG_STAGE(MG_SA(0, 0), cA, voffA, mskc); MG_STAGE(MG_SA(0, 1), cA + hstc, voffA, mskc);
    if (wr == 1) MG_BAR;
    MG_WAIT_V(2); MG_BAR;
    MG_STAGE(MG_SB(1, 0), cB + kstep, voffB, mskc); MG_STAGE(MG_SA(1, 0), cA + kstep, voffA, mskc); MG_STAGE(MG_SB(1, 1), cB + hstc + kstep, voffB, mskc);
    MG_WAIT_V(6); MG_BAR;
    for (;;) {
        const bool has_next = S.next(ui + 1, nxt);
        const char* nA = cA; const char* nB = cB; int ntn = ntc; unsigned mskn = mskc; unsigned hstn = hstc;
        if (has_next) MG_DECODE(nxt, nA, nB, ntn, mskn, hstn);
        for (int t = 0; t < ntc; t += 2) {
            const bool last = (t == ntc - 2);
            const char* a1 = cA + (size_t)(t + 1) * kstep;
            const char* a2 = last ? nA : cA + (size_t)(t + 2) * kstep; const char* b2 = last ? nB : cB + (size_t)(t + 2) * kstep;
            const char* a3 = a2 + kstep; const char* b3 = b2 + kstep;
            const unsigned mskx = last ? mskn : mskc; const unsigned hstx = last ? hstn : hstc;
            MG_LDB(B0, 0, 0); MG_LDB(B1, 0, 1); MG_SCHED; MG_LDA(At, 0, 0); MG_STAGE(MG_SA(1, 1), a1 + hstc, voffA, mskc);
            MG_WAIT_V(8); MG_WAIT_L(0); MG_BAR; MG_MMA(0, 0, At, B0); MG_MMA(0, 1, At, B1); MG_BAR; MG_SCHED;
            MG_LDA(At, 0, 1); MG_STAGE(MG_SB(0, 0), b2, voffB, mskx); MG_STAGE(MG_SB(0, 1), b2 + hstx, voffB, mskx); MG_STAGE(MG_SA(0, 0), a2, voffA, mskx);
            MG_WAIT_V(8); MG_WAIT_L(0); MG_BAR; MG_MMA(1, 0, At, B0); MG_MMA(1, 1, At, B1); MG_BAR; MG_SCHED;
            MG_LDB(B0, 1, 0); MG_LDB(B1, 1, 1); MG_SCHED; MG_LDA(At, 1, 0); MG_STAGE(MG_SA(0, 1), a2 + hstx, voffA, mskx);
            MG_WAIT_V(8); MG_WAIT_L(0); MG_BAR; MG_MMA(0, 0, At, B0); MG_MMA(0, 1, At, B1); MG_BAR; MG_SCHED;
            MG_LDA(At, 1, 1); MG_STAGE(MG_SB(1, 0), b3, voffB, mskx); MG_STAGE(MG_SB(1, 1), b3 + hstx, voffB, mskx); MG_STAGE(MG_SA(1, 0), a3, voffA, mskx);
            MG_WAIT_V(8); MG_WAIT_L(0); MG_BAR; MG_MMA(1, 0, At, B0); MG_MMA(1, 1, At, B1); MG_BAR; MG_SCHED;
        }
        if (wr == 0) MG_BAR;
        E.with_rs(acc, cur, wr, wc, fr, fq, (const PG8_LAS float*)(lds + RS_LDS_OFF));
        if (!has_next) break;
#pragma unroll
        for (int a = 0; a < 2; ++a)
#pragma unroll
            for (int b = 0; b < 2; ++b)
#pragma unroll
                for (int m = 0; m < 4; ++m)
#pragma unroll
                    for (int n = 0; n < 2; ++n) acc[a][b][m][n] = (f32x4){zz_, zz_, zz_, zz_};
        cur = nxt; cA = nA; cB = nB; ntc = ntn; mskc = mskn; hstc = hstn; ++ui;
        if (wr == 1) MG_BAR;
    }
    MG_WAIT_V(0);
    MG_BAR;
#undef MG_SA
#undef MG_SB
#undef MG_STAGE
#undef MG_LDA
#undef MG_LDB
#undef MG_MMA
#undef MG_WAIT_V
#undef MG_WAIT_L
#undef MG_BAR
#undef MG_SCHED
#undef MG_DECODE
}
struct EpiSwiglu {
    static constexpr bool PERM = true, AFTER_DRAIN = false, RS_LDS = true;
    bf16_t* O; int ld; const float* rs;
    __device__ __forceinline__ void with_rs(const f32x4 (&acc)[2][2][4][2], const Unit& u, int wr, int wc, int fr, int fq, const PG8_LAS float* rsl) const {
        bf16_t* base = O + (size_t)(u.pm * BM + wr * 64 + fr) * ld + u.pn * HALF + wc * 32 + 8 * fq;
        const bf16_t* wt_base_ = O; const __amdgpu_buffer_rsrc_t wt_r_ = wt_rsrc(wt_base_);
        float rsr[2][4];
#pragma unroll
        for (int ai = 0; ai < 2; ++ai)
#pragma unroll
            for (int m = 0; m < 4; ++m) rsr[ai][m] = rs ? rsl[wr * 64 + fr + ai * HALF + m * 16] : 1.0f;
#pragma unroll
        for (int ai = 0; ai < 2; ++ai)
#pragma unroll
            for (int m = 0; m < 4; ++m) { bf16_t* rowp = base + (size_t)(ai * HALF + m * 16) * ld;
                const float rsv = rsr[ai][m];
                f32x4 v0 = acc[ai][0][m][0] * rsv, v1 = acc[ai][0][m][1] * rsv; const f32x4 u0 = acc[ai][1][m][0] * rsv, u1 = acc[ai][1][m][1] * rsv;
#pragma unroll
                for (int e = 0; e < 4; ++e) { v0[e] = v0[e] * sigmoidf_(v0[e]) * u0[e]; v1[e] = v1[e] * sigmoidf_(v1[e]) * u1[e]; }
                u32x4e w; w.x = cvt_pk_bf16(v0[0], v0[1]); w.y = cvt_pk_bf16(v0[2], v0[3]); w.z = cvt_pk_bf16(v1[0], v1[1]); w.w = cvt_pk_bf16(v1[2], v1[3]);
                st16_wt(wt_r_, (unsigned)((const char*)rowp - (const char*)wt_base_), w); }
    }
};
}

constexpr int NB = 8, SEQ = 2048, DM = 1024, M = NB * SEQ;
constexpr int NMEM = 256, MMEM = NB * NMEM;
constexpr int DFF = 2816, DIN = 7456, NA = 4608;
constexpr float RMS_EPS = 1e-6f;
constexpr int NWAVES = 8, NTHREADS = 512;

constexpr size_t MiB = 1u << 20;
constexpr size_t WS_CTL = 0, CTL_ZERO_BYTES = 64 * 1024;
constexpr size_t WS_W = 1 * MiB;
constexpr size_t W_A = WS_W, W_M = W_A + (size_t)NA * 1024 * 2, W_C1K = W_M + 3072ull * 1024 * 2, W_C1V = W_C1K + 512ull * 1024 * 2,
                 W_UP = W_C1V + 512ull * 1024 * 2, W_OUT3 = W_UP + 3072ull * 512 * 2, W_MQ = W_OUT3 + 1024ull * 3072 * 2, W_MKV = W_MQ + 256ull * 1024 * 2,
                 W_MO = W_MKV + 512ull * 1024 * 2, W_GU = W_MO + 1024ull * 256 * 2, W_DN = W_GU + 5632ull * 1024 * 2, W_B1PART = W_DN + 1024ull * 2816 * 2,
                 W_END = W_B1PART + 2ull * 32 * 256 * 4;
constexpr size_t WS_H = 47 * MiB;
constexpr size_t WS_OQ = 79 * MiB;
constexpr size_t WS_KV = 127 * MiB;
constexpr size_t WS_Y = WS_KV + 32 * MiB;
constexpr size_t WS_MG = WS_KV;
constexpr size_t WS_ACT = WS_OQ;
constexpr size_t WS_MQ = WS_OQ, WS_MO = WS_OQ + 32 * MiB;
constexpr size_t WS_MISC = 223 * MiB;
constexpr size_t WS_CF = WS_MISC;
constexpr size_t WS_KCMP = WS_CF + 512 * 1024, WS_VCMP = WS_KCMP + 256 * 1024, WS_SELM = WS_VCMP + 256 * 1024;
constexpr size_t WS_MEMN = WS_MISC + 3 * MiB / 2;
constexpr size_t WS_MEMKV = WS_MEMN + 4 * MiB;
constexpr size_t WS_PSLC = WS_MEMKV + 2 * MiB;
constexpr size_t WS_OCMP = WS_PSLC + 4 * MiB;
constexpr size_t WS_CK = WS_OCMP, WS_CV = WS_CK + 4 * MiB, WS_PK = WS_CV + 4 * MiB, WS_PV = WS_PK + 2 * MiB;
constexpr size_t WS_END = WS_OCMP + 16 * MiB;
constexpr size_t WS_XSTAT = WS_END;
static_assert(W_END <= WS_H && WS_H + 32 * MiB == WS_OQ && WS_OQ + 48 * MiB == WS_KV && WS_KV + 96 * MiB == WS_MISC && WS_END + 64 * 1024 <= 256 * MiB && WS_PV + 2 * MiB <= WS_END, "ws map");
constexpr int CW_BAR = 4096, CW_SB = 8192, CW_CVB = 8192 + 32 * 64;

typedef unsigned short bf16;
typedef float f32x4 __attribute__((ext_vector_type(4)));
typedef unsigned u32x4 __attribute__((ext_vector_type(4)));
typedef unsigned u32x2 __attribute__((ext_vector_type(2)));

__device__ __forceinline__ float bf2f(unsigned short b) { return __uint_as_float((unsigned)b << 16); }
__device__ __forceinline__ unsigned pk2(float lo, float hi) { return pg8::cvt_pk_bf16(lo, hi); }
__device__ __forceinline__ unsigned short f2bf(float f) { return (unsigned short)(pk2(f, 0.f) & 0xffffu); }
__device__ __forceinline__ float wave_sum(float v) {
#pragma unroll
    for (int o = 1; o < 64; o <<= 1) v += __shfl_xor(v, o);
    return v;
}
__device__ __forceinline__ float sigm(float x) { return __builtin_amdgcn_rcpf(1.0f + __expf(-x)); }
__device__ __forceinline__ float logsig(float x) { return fminf(x, 0.f) - log1pf(__expf(-fabsf(x))); }

struct Args { const void* in[31]; float* out; unsigned char* ws; int ph_lo, ph_hi; };

struct MapOff { int off; float s; __device__ __forceinline__ int row(int n) const { return n + off; } __device__ __forceinline__ float sc(int) const { return s; } };
struct MapA {
    __device__ __forceinline__ int row(int n) const { return n < 2816 ? n : (n < 2840 ? n + 1536 : (n < 4376 ? n - 24 : n)); }
    __device__ __forceinline__ float sc(int n) const { return (n < 512 || (n >= 1536 && n < 2048) || (n >= 2840 && n < 3352)) ? 0.125f : 1.0f; }
};
struct MapGU { int half; __device__ __forceinline__ int row(int n) const { return (n >> 7) * 256 + half * 128 + (n & 127); } __device__ __forceinline__ float sc(int) const { return 1.0f; } };

template <class Map>
__device__ __forceinline__ void conv_item(const float* W, int N, int ldw, bf16* WT, int ldt, int dk0, const Map map, LAS float* scr, int it, int lane) {
    const int nblk = N / 32, kb = it / nblk, nb = it % nblk, k0 = 64 * kb, n0 = 32 * nb;
    const float* src = W + (size_t)(k0 + (lane >> 3)) * ldw + n0 + 4 * (lane & 7);
    f32x4 v[8];
#pragma unroll
    for (int i = 0; i < 8; ++i) v[i] = *(const f32x4*)(src + (size_t)(8 * i) * ldw);
#pragma unroll
    for (int i = 0; i < 8; ++i) { LAS float* d = scr + (8 * i + (lane >> 3)) * 33 + 4 * (lane & 7); d[0] = v[i].x; d[1] = v[i].y; d[2] = v[i].z; d[3] = v[i].w; }
    asm volatile("s_waitcnt lgkmcnt(0)" ::: "memory");
    const int c = lane & 7;
#pragma unroll
    for (int j = 0; j < 4; ++j) { const int n = (lane >> 3) + 8 * j; const LAS float* s = scr + (8 * c) * 33 + n; const float sc = map.sc(n0 + n);
        u32x4 o; o.x = pk2(s[0 * 33] * sc, s[1 * 33] * sc); o.y = pk2(s[2 * 33] * sc, s[3 * 33] * sc); o.z = pk2(s[4 * 33] * sc, s[5 * 33] * sc); o.w = pk2(s[6 * 33] * sc, s[7 * 33] * sc);
        *(u32x4*)(WT + (size_t)map.row(n0 + n) * ldt + dk0 + k0 + 8 * c) = o; }
    asm volatile("s_waitcnt lgkmcnt(0)" ::: "memory");
}

__device__ __forceinline__ void norm_row_to_bf16(const float* xrow, const float* g, bf16* hrow, int lane) {
    const f32x4* xr = (const f32x4*)xrow + lane; const f32x4* gr = (const f32x4*)g + lane;
    f32x4 v[4]; float s = 0.f;
#pragma unroll
    for (int j = 0; j < 4; ++j) { v[j] = xr[64 * j]; s += (v[j].x * v[j].x + v[j].y * v[j].y) + (v[j].z * v[j].z + v[j].w * v[j].w); }
    const float rstd = __builtin_amdgcn_rsqf(wave_sum(s) * (1.f / DM) + RMS_EPS);
    u32x2* o8 = (u32x2*)hrow + lane;
#pragma unroll
    for (int j = 0; j < 4; ++j) { const f32x4 gg = gr[64 * j]; u32x2 w; w.x = pk2(v[j].x * rstd * gg.x, v[j].y * rstd * gg.y); w.y = pk2(v[j].z * rstd * gg.z, v[j].w * rstd * gg.w); o8[64 * j] = w; }
}
__device__ __forceinline__ void post_norm_row(const bf16* yrow, const float* xs, float* xd, const float* gpost, const float* gpre, bf16* hrow, bool write_h, bool dry, int lane) {
    const u32x2* yr = (const u32x2*)yrow + lane; const f32x4* xr = (const f32x4*)xs + lane;
    f32x4 y[4], x[4]; float s = 0.f;
#pragma unroll
    for (int j = 0; j < 4; ++j) { const u32x2 w = yr[64 * j]; y[j].x = __uint_as_float(w.x << 16); y[j].y = __uint_as_float(w.x & 0xffff0000u); y[j].z = __uint_as_float(w.y << 16); y[j].w = __uint_as_float(w.y & 0xffff0000u);
        x[j] = xr[64 * j]; s += (y[j].x * y[j].x + y[j].y * y[j].y) + (y[j].z * y[j].z + y[j].w * y[j].w); }
    const float rstd = __builtin_amdgcn_rsqf(wave_sum(s) * (1.f / DM) + RMS_EPS);
    float s2 = 0.f;
#pragma unroll
    for (int j = 0; j < 4; ++j) { const f32x4 gg = ((const f32x4*)gpost + lane)[64 * j];
        x[j].x += y[j].x * rstd * gg.x; x[j].y += y[j].y * rstd * gg.y; x[j].z += y[j].z * rstd * gg.z; x[j].w += y[j].w * rstd * gg.w;
        if (!dry) ((f32x4*)xd + lane)[64 * j] = x[j]; s2 += (x[j].x * x[j].x + x[j].y * x[j].y) + (x[j].z * x[j].z + x[j].w * x[j].w); }
    if (write_h && !dry) {
        const float r2 = __builtin_amdgcn_rsqf(wave_sum(s2) * (1.f / DM) + RMS_EPS);
        u32x2* o8 = (u32x2*)hrow + lane;
#pragma unroll
        for (int j = 0; j < 4; ++j) { const f32x4 gg = ((const f32x4*)gpre + lane)[64 * j]; u32x2 w; w.x = pk2(x[j].x * r2 * gg.x, x[j].y * r2 * gg.y); w.y = pk2(x[j].z * r2 * gg.z, x[j].w * r2 * gg.w); o8[64 * j] = w; }
    }
}

__device__ __forceinline__ void post_norm_rows2(const bf16* y0, const bf16* y1, const float* xs0, const float* xs1, float* xd0, float* xd1, const float* gpost, const float* gpre, bf16* h0, bf16* h1, bool write_h, bool dry, int lane) {
    f32x4 y[2][4], x[2][4], gp[4]; u32x2 w[2][4];
#pragma unroll
    for (int j = 0; j < 4; ++j) { w[0][j] = __builtin_nontemporal_load((const u32x2*)y0 + lane + 64 * j); w[1][j] = __builtin_nontemporal_load((const u32x2*)y1 + lane + 64 * j); }
#pragma unroll
    for (int j = 0; j < 4; ++j) { x[0][j] = __builtin_nontemporal_load((const f32x4*)xs0 + lane + 64 * j); x[1][j] = __builtin_nontemporal_load((const f32x4*)xs1 + lane + 64 * j); gp[j] = ((const f32x4*)gpost + lane)[64 * j]; }
    float s[2] = {0.f, 0.f};
#pragma unroll
    for (int q = 0; q < 2; ++q)
#pragma unroll
        for (int j = 0; j < 4; ++j) { y[q][j].x = __uint_as_float(w[q][j].x << 16); y[q][j].y = __uint_as_float(w[q][j].x & 0xffff0000u); y[q][j].z = __uint_as_float(w[q][j].y << 16); y[q][j].w = __uint_as_float(w[q][j].y & 0xffff0000u);
            s[q] += (y[q][j].x * y[q][j].x + y[q][j].y * y[q][j].y) + (y[q][j].z * y[q][j].z + y[q][j].w * y[q][j].w); }
#pragma unroll
    for (int o = 1; o < 64; o <<= 1) { s[0] += __shfl_xor(s[0], o); s[1] += __shfl_xor(s[1], o); }
    float s2[2] = {0.f, 0.f};
#pragma unroll
    for (int q = 0; q < 2; ++q) { const float rstd = __builtin_amdgcn_rsqf(s[q] * (1.f / DM) + RMS_EPS); float* xd = q ? xd1 : xd0;
#pragma unroll
        for (int j = 0; j < 4; ++j) {
            x[q][j].x += y[q][j].x * rstd * gp[j].x; x[q][j].y += y[q][j].y * rstd * gp[j].y; x[q][j].z += y[q][j].z * rstd * gp[j].z; x[q][j].w += y[q][j].w * rstd * gp[j].w;
            if (!dry) __builtin_nontemporal_store(x[q][j], (f32x4*)xd + lane + 64 * j); s2[q] += (x[q][j].x * x[q][j].x + x[q][j].y * x[q][j].y) + (x[q][j].z * x[q][j].z + x[q][j].w * x[q][j].w); } }
    if (write_h && !dry) {
#pragma unroll
        for (int o = 1; o < 64; o <<= 1) { s2[0] += __shfl_xor(s2[0], o); s2[1] += __shfl_xor(s2[1], o); }
#pragma unroll
        for (int j = 0; j < 4; ++j) gp[j] = ((const f32x4*)gpre + lane)[64 * j];
#pragma unroll
        for (int q = 0; q < 2; ++q) { const float r2 = __builtin_amdgcn_rsqf(s2[q] * (1.f / DM) + RMS_EPS); const __amdgpu_buffer_rsrc_t hr_ = pg8::wt_rsrc(q ? h1 : h0);
#pragma unroll
            for (int j = 0; j < 4; ++j) { u32x2 ww; ww.x = pk2(x[q][j].x * r2 * gp[j].x, x[q][j].y * r2 * gp[j].y); ww.y = pk2(x[q][j].z * r2 * gp[j].z, x[q][j].w * r2 * gp[j].w); __builtin_amdgcn_raw_buffer_store_b64(ww, hr_, (lane + 64 * j) * 8, 0, 16); } }
    }
}

__device__ __forceinline__ void rope_cs(int pos, int i, float& c, float& s) {
    float hi, lo;
    switch (i) { case 0: hi = 0.1591796875f; lo = -2.474440771038644e-05f; break; case 1: hi = 0.0308685302734375f; lo = -4.76686864203657e-06f; break;
                 case 2: hi = 0.005985260009765625f; lo = -7.429704851347196e-08f; break; case 3: hi = 0.0011606216430664062f; lo = 4.1998173827551e-08f; break;
                 case 4: hi = 0.000225067138671875f; lo = 1.1940367805607366e-08f; break; case 5: hi = 4.366040229797363e-05f; lo = -1.2449505426559426e-08f; break;
                 case 6: hi = 8.463859558105469e-06f; lo = 4.712501500137023e-10f; break; default: hi = 1.6409903764724731e-06f; lo = 4.3588632703261965e-10f; break; }
    const float fp = (float)pos, p = fp * hi, fr = (p - rintf(p)) + fp * lo;
    c = __builtin_amdgcn_cosf(fr); s = __builtin_amdgcn_sinf(fr);
}

typedef __attribute__((address_space(4))) const unsigned char* kptr_t;
struct KA {
    kptr_t kp;
    __device__ __forceinline__ void refresh() { kp = (kptr_t)__builtin_amdgcn_kernarg_segment_ptr(); asm volatile("" : "+s"(kp)); }
    __device__ __forceinline__ const void* in(int i) const { return (const void*)(const GAS void*)(*(const __attribute__((address_space(4))) unsigned long long*)(kp + 8 * i)); }
    __device__ __forceinline__ float* out() const { return (float*)(GAS float*)(*(const __attribute__((address_space(4))) unsigned long long*)(kp + 8 * 31)); }
    __device__ __forceinline__ unsigned char* ws() const { return (unsigned char*)(GAS unsigned char*)(*(const __attribute__((address_space(4))) unsigned long long*)(kp + 8 * 32)); }
    __device__ __forceinline__ int ph_lo() const { return *(const __attribute__((address_space(4))) int*)(kp + 8 * 33); }
    __device__ __forceinline__ int ph_hi() const { return *(const __attribute__((address_space(4))) int*)(kp + 8 * 33 + 4); }
};
struct Frame {
    LAS unsigned char* lds;
    int tid, lane, wave, G, bid;
    int gw, ngw;
    int gt, ngt;
};

struct ConvDesc { const float* src; int ldw; bf16* dst; int ldt; int kd; int n0; int kind; int par; float sc; const float* gk; };
#define CVD(Wp, K_, N_, LDW_, DST_, LDT_, DK0_, KIND_, PAR_, SC_) { constexpr int n_ = ((N_) / 32) * ((K_) / 64); if (it < n_) { const int nblk = (N_) / 32, kb = it / nblk, nb = it % nblk; \
    d.src = (Wp) + (size_t)(64 * kb + (lane >> 3)) * (LDW_) + 32 * nb + 4 * (lane & 7); d.ldw = (LDW_); d.dst = (DST_); d.ldt = (LDT_); d.kd = (DK0_) + 64 * kb; d.n0 = 32 * nb; d.kind = (KIND_); d.par = (PAR_); d.sc = (SC_); return; } it -= n_; }
constexpr int N_CONV = 2192 + 1536 + 4 * 128 + 3 * 256 + 512 + 128 + 2 * 128 + 128 + 2 * 1408 + 1408;
__device__ __forceinline__ void conv_decode(ConvDesc& d, const KA& a, unsigned char* ws, int l, int it, int lane) {
    CVD((const float*)a.in(10) + (size_t)l * DM * DIN, DM, 4384, DIN, (bf16*)(ws + W_A), DM, 0, 1, 0, 1.0f)
    CVD((const float*)a.in(10) + (size_t)l * DM * DIN + 4384, DM, 3072, DIN, (bf16*)(ws + W_M), DM, 0, 0, 0, 1.0f)
    CVD((const float*)a.in(13) + (size_t)l * 2048 * 256, 1024, 256, 256, (bf16*)(ws + W_C1K), 1024, 0, 0, 0, 1.0f)
    CVD((const float*)a.in(13) + (size_t)l * 2048 * 256 + 1024 * 256, 1024, 256, 256, (bf16*)(ws + W_C1K), 1024, 0, 0, 256, 1.0f)
    CVD((const float*)a.in(17) + (size_t)l * 2048 * 256, 1024, 256, 256, (bf16*)(ws + W_C1V), 1024, 0, 0, 0, 1.0f)
    CVD((const float*)a.in(17) + (size_t)l * 2048 * 256 + 1024 * 256, 1024, 256, 256, (bf16*)(ws + W_C1V), 1024, 0, 0, 256, 1.0f)
    CVD((const float*)a.in(20) + (size_t)l * 512 * DM, 512, DM, DM, (bf16*)(ws + W_UP), 512, 0, 0, 0, 1.0f)
    CVD((const float*)a.in(21) + (size_t)l * 512 * DM, 512, DM, DM, (bf16*)(ws + W_UP), 512, 0, 0, 1024, 1.0f)
    CVD((const float*)a.in(22) + (size_t)l * 512 * DM, 512, DM, DM, (bf16*)(ws + W_UP), 512, 0, 0, 2048, 1.0f)
    CVD((const float*)a.in(23) + (size_t)l * DM * DM, DM, DM, DM, (bf16*)(ws + W_OUT3), DM, 0, 0, 0, 1.0f)
    CVD((const float*)a.in(24) + (size_t)l * DM * 256, DM, 256, 256, (bf16*)(ws + W_MQ), DM, 0, 0, 0, 0.125f)
    CVD((const float*)a.in(25) + (size_t)l * DM * 256, DM, 256, 256, (bf16*)(ws + W_MKV), DM, 0, 0, 0, 1.0f)
    CVD((const float*)a.in(26) + (size_t)l * DM * 256, DM, 256, 256, (bf16*)(ws + W_MKV), DM, 0, 0, 256, 1.0f)
    CVD((const float*)a.in(27) + (size_t)l * 256 * DM, 256, DM, DM, (bf16*)(ws + W_MO), 256, 0, 0, 0, 1.0f)
    CVD((const float*)a.in(28) + (size_t)l * DM * DFF, DM, DFF, DFF, (bf16*)(ws + W_GU), DM, 0, 2, 0, 1.0f)
    CVD((const float*)a.in(29) + (size_t)l * DM * DFF, DM, DFF, DFF, (bf16*)(ws + W_GU), DM, 0, 2, 1, 1.0f)
    CVD((const float*)a.in(30) + (size_t)l * DFF * DM, DFF, DM, DM, (bf16*)(ws + W_DN), DFF, 0, 0, 0, 1.0f)
}
#undef CVD
__device__ __forceinline__ const float* conv_gain(const bf16* dst, const KA& a, unsigned char* ws, int l, bool fold) {
    if (!fold) return nullptr;
    const unsigned char* p = (const unsigned char*)dst;
    if (p == ws + W_A || p == ws + W_M) return (const float*)a.in(3) + l * DM;
    if (p == ws + W_MQ) return (const float*)a.in(5) + l * DM;
    if (p == ws + W_GU) return (const float*)a.in(8) + l * DM;
    return nullptr;
}
__device__ __forceinline__ void conv_gain8(const float* gk, int k0, float (&gv)[8]) {
    if (gk) { const f32x4 g0 = *(const f32x4*)(gk + k0), g1 = *(const f32x4*)(gk + k0 + 4); gv[0] = g0.x; gv[1] = g0.y; gv[2] = g0.z; gv[3] = g0.w; gv[4] = g1.x; gv[5] = g1.y; gv[6] = g1.z; gv[7] = g1.w; }
    else {
#pragma unroll
        for (int i = 0; i < 8; ++i) gv[i] = 1.0f; }
}
__device__ __forceinline__ void conv_load(const ConvDesc& d, f32x4 (&v)[8]) {
#pragma unroll
    for (int i = 0; i < 8; ++i) v[i] = __builtin_nontemporal_load((const f32x4*)(d.src + (size_t)(8 * i) * d.ldw));
}
__device__ __forceinline__ void conv_finish(const ConvDesc& d, const f32x4 (&v)[8], LAS float* scr, int lane) {
#pragma unroll
    for (int i = 0; i < 8; ++i) { LAS float* p = scr + (8 * i + (lane >> 3)) * 33 + 4 * (lane & 7); p[0] = v[i].x; p[1] = v[i].y; p[2] = v[i].z; p[3] = v[i].w; }
    asm volatile("s_waitcnt lgkmcnt(0)" ::: "memory");
    const int c = lane & 7;
    float gv[8]; conv_gain8(d.gk, d.kd + 8 * c, gv);
#pragma unroll
    for (int j = 0; j < 4; ++j) { const int n = (lane >> 3) + 8 * j, gn = d.n0 + n; const LAS float* s = scr + (8 * c) * 33 + n;
        const int row = d.kind == 0 ? gn + d.par : (d.kind == 1 ? MapA{}.row(gn) : MapGU{d.par}.row(gn));
        const float sc = d.kind == 1 ? MapA{}.sc(gn) : d.sc;
        u32x4 o; o.x = pk2(s[0 * 33] * sc * gv[0], s[1 * 33] * sc * gv[1]); o.y = pk2(s[2 * 33] * sc * gv[2], s[3 * 33] * sc * gv[3]); o.z = pk2(s[4 * 33] * sc * gv[4], s[5 * 33] * sc * gv[5]); o.w = pk2(s[6 * 33] * sc * gv[6], s[7 * 33] * sc * gv[7]);
        *(u32x4*)(d.dst + (size_t)row * d.ldt + d.kd + 8 * c) = o; }
    asm volatile("s_waitcnt lgkmcnt(0)" ::: "memory");
}
__device__ __forceinline__ void xcopy_rows4(const float* x0, bf16* c0, float* rs, int lane) {
    f32x4 v[4][4]; float s[4] = {0.f, 0.f, 0.f, 0.f};
#pragma unroll
    for (int q = 0; q < 4; ++q)
#pragma unroll
        for (int j = 0; j < 4; ++j) v[q][j] = __builtin_nontemporal_load((const f32x4*)(x0 + (size_t)q * DM) + lane + 64 * j);
#pragma unroll
    for (int q = 0; q < 4; ++q)
#pragma unroll
        for (int j = 0; j < 4; ++j) s[q] += (v[q][j].x * v[q][j].x + v[q][j].y * v[q][j].y) + (v[q][j].z * v[q][j].z + v[q][j].w * v[q][j].w);
#pragma unroll
    for (int o = 1; o < 64; o <<= 1) { s[0] += __shfl_xor(s[0], o); s[1] += __shfl_xor(s[1], o); s[2] += __shfl_xor(s[2], o); s[3] += __shfl_xor(s[3], o); }
    const bool odd = (lane & 1) != 0;
#pragma unroll
    for (int q = 0; q < 4; ++q) {
        if (lane == 0) rs[q] = __builtin_amdgcn_rsqf(s[q] * (1.f / DM) + RMS_EPS);
        const __amdgpu_buffer_rsrc_t cr_ = pg8::wt_rsrc(c0 + (size_t)q * DM);
#pragma unroll
        for (int jp = 0; jp < 4; jp += 2) {
            u32x2 w0, w1; w0.x = pk2(v[q][jp].x, v[q][jp].y); w0.y = pk2(v[q][jp].z, v[q][jp].w); w1.x = pk2(v[q][jp + 1].x, v[q][jp + 1].y); w1.y = pk2(v[q][jp + 1].z, v[q][jp + 1].w);
            const unsigned sx = odd ? w0.x : w1.x, sy = odd ? w0.y : w1.y;
            const unsigned rx = __shfl_xor(sx, 1), ry = __shfl_xor(sy, 1);
            pg8::u32x4e w; int off;
            if (!odd) { w.x = w0.x; w.y = w0.y; w.z = rx; w.w = ry; off = (lane + 64 * jp) * 8; }
            else      { w.x = rx; w.y = ry; w.z = w1.x; w.w = w1.y; off = (lane - 1 + 64 * (jp + 1)) * 8; }
            __builtin_amdgcn_raw_buffer_store_b128(w, cr_, off, 0, 16); }
    }
}
__device__ __forceinline__ void norm_rows4_to_bf16(const float* x0, const float* g, bf16* h0, int lane) {
    f32x4 v[4][4], gg[4]; float s[4] = {0.f, 0.f, 0.f, 0.f};
#pragma unroll
    for (int q = 0; q < 4; ++q)
#pragma unroll
        for (int j = 0; j < 4; ++j) v[q][j] = __builtin_nontemporal_load((const f32x4*)(x0 + (size_t)q * DM) + lane + 64 * j);
#pragma unroll
    for (int j = 0; j < 4; ++j) gg[j] = ((const f32x4*)g + lane)[64 * j];
#pragma unroll
    for (int q = 0; q < 4; ++q)
#pragma unroll
        for (int j = 0; j < 4; ++j) s[q] += (v[q][j].x * v[q][j].x + v[q][j].y * v[q][j].y) + (v[q][j].z * v[q][j].z + v[q][j].w * v[q][j].w);
#pragma unroll
    for (int o = 1; o < 64; o <<= 1) { s[0] += __shfl_xor(s[0], o); s[1] += __shfl_xor(s[1], o); s[2] += __shfl_xor(s[2], o); s[3] += __shfl_xor(s[3], o); }
#pragma unroll
    for (int q = 0; q < 4; ++q) { const float rstd = __builtin_amdgcn_rsqf(s[q] * (1.f / DM) + RMS_EPS); u32x2* o8 = (u32x2*)(h0 + (size_t)q * DM) + lane;
#pragma unroll
        for (int j = 0; j < 4; ++j) { u32x2 w; w.x = pk2(v[q][j].x * rstd * gg[j].x, v[q][j].y * rstd * gg[j].y); w.y = pk2(v[q][j].z * rstd * gg[j].z, v[q][j].w * rstd * gg[j].w); o8[64 * j] = w; } }
}
struct ConvB { const float* src; int ldw; bf16* dst; int ldt; int kd; int n0; int kind; int par; float sc; const float* gk; };
#define CVB(Wp, K_, N_, LDW_, DST_, LDT_, DK0_, KIND_, PAR_, SC_) { constexpr int nb_ = (N_) / 256, n_ = nb_ * ((K_) / 64); if (it < n_) { const int kb = it / nb_, nb = it % nb_; \
    d.src = (Wp) + (size_t)(64 * kb) * (LDW_) + 256 * nb; d.ldw = (LDW_); d.dst = (DST_); d.ldt = (LDT_); d.kd = (DK0_) + 64 * kb; d.n0 = 256 * nb; d.kind = (KIND_); d.par = (PAR_); d.sc = (SC_); return; } it -= n_; }
constexpr int N_CONVB = 16 * 17 + 16 * 12 + 4 * 16 + 3 * 32 + 64 + 16 + 2 * 16 + 16 + 2 * 176 + 176;
constexpr int N_CONVA = N_CONVB - (2 * 176 + 176);
__device__ __forceinline__ void convb_decode(ConvB& d, const KA& a, unsigned char* ws, int l, int it) {
    CVB((const float*)a.in(10) + (size_t)l * DM * DIN, DM, 4352, DIN, (bf16*)(ws + W_A), DM, 0, 1, 0, 1.0f)
    CVB((const float*)a.in(10) + (size_t)l * DM * DIN + 4384, DM, 3072, DIN, (bf16*)(ws + W_M), DM, 0, 0, 0, 1.0f)
    CVB((const float*)a.in(13) + (size_t)l * 2048 * 256, 1024, 256, 256, (bf16*)(ws + W_C1K), 1024, 0, 0, 0, 1.0f)
    CVB((const float*)a.in(13) + (size_t)l * 2048 * 256 + 1024 * 256, 1024, 256, 256, (bf16*)(ws + W_C1K), 1024, 0, 0, 256, 1.0f)
    CVB((const float*)a.in(17) + (size_t)l * 2048 * 256, 1024, 256, 256, (bf16*)(ws + W_C1V), 1024, 0, 0, 0, 1.0f)
    CVB((const float*)a.in(17) + (size_t)l * 2048 * 256 + 1024 * 256, 1024, 256, 256, (bf16*)(ws + W_C1V), 1024, 0, 0, 256, 1.0f)
    CVB((const float*)a.in(20) + (size_t)l * 512 * DM, 512, DM, DM, (bf16*)(ws + W_UP), 512, 0, 0, 0, 1.0f)
    CVB((const float*)a.in(21) + (size_t)l * 512 * DM, 512, DM, DM, (bf16*)(ws + W_UP), 512, 0, 0, 1024, 1.0f)
    CVB((const float*)a.in(22) + (size_t)l * 512 * DM, 512, DM, DM, (bf16*)(ws + W_UP), 512, 0, 0, 2048, 1.0f)
    CVB((const float*)a.in(23) + (size_t)l * DM * DM, DM, DM, DM, (bf16*)(ws + W_OUT3), DM, 0, 0, 0, 1.0f)
    CVB((const float*)a.in(24) + (size_t)l * DM * 256, DM, 256, 256, (bf16*)(ws + W_MQ), DM, 0, 0, 0, 0.125f)
    CVB((const float*)a.in(25) + (size_t)l * DM * 256, DM, 256, 256, (bf16*)(ws + W_MKV), DM, 0, 0, 0, 1.0f)
    CVB((const float*)a.in(26) + (size_t)l * DM * 256, DM, 256, 256, (bf16*)(ws + W_MKV), DM, 0, 0, 256, 1.0f)
    CVB((const float*)a.in(27) + (size_t)l * 256 * DM, 256, DM, DM, (bf16*)(ws + W_MO), 256, 0, 0, 0, 1.0f)
    CVB((const float*)a.in(28) + (size_t)l * DM * DFF, DM, DFF, DFF, (bf16*)(ws + W_GU), DM, 0, 2, 0, 1.0f)
    CVB((const float*)a.in(29) + (size_t)l * DM * DFF, DM, DFF, DFF, (bf16*)(ws + W_GU), DM, 0, 2, 1, 1.0f)
    CVB((const float*)a.in(30) + (size_t)l * DFF * DM, DFF, DM, DM, (bf16*)(ws + W_DN), DFF, 0, 0, 0, 1.0f)
}
#undef CVB
__device__ __forceinline__ void convb_load(const ConvB& d, f32x4 (&v)[8], int wave, int lane) {
#pragma unroll
    for (int i = 0; i < 8; ++i) v[i] = __builtin_nontemporal_load((const f32x4*)(d.src + (size_t)(8 * wave + i) * d.ldw + 4 * lane));
}
__device__ __forceinline__ void convb_finish(const ConvB& d, const f32x4 (&v)[8], LAS float* scr, int tid, int wave, int lane) {
#pragma unroll
    for (int i = 0; i < 8; ++i) { LAS float* p = scr + (8 * wave + i) * 257 + 4 * lane; p[0] = v[i].x; p[1] = v[i].y; p[2] = v[i].z; p[3] = v[i].w; }
    __syncthreads();
    float gv[8]; conv_gain8(d.gk, d.kd + 8 * (tid & 7), gv);
#pragma unroll
    for (int j = 0; j < 4; ++j) { const int pc = tid + 512 * j, n = pc >> 3, c = pc & 7, gn = d.n0 + n; const LAS float* s = scr + (8 * c) * 257 + n;
        const int row = d.kind == 0 ? gn + d.par : (d.kind == 1 ? MapA{}.row(gn) : MapGU{d.par}.row(gn));
        const float sc = d.kind == 1 ? MapA{}.sc(gn) : d.sc;
        u32x4 o; o.x = pk2(s[0 * 257] * sc * gv[0], s[1 * 257] * sc * gv[1]); o.y = pk2(s[2 * 257] * sc * gv[2], s[3 * 257] * sc * gv[3]); o.z = pk2(s[4 * 257] * sc * gv[4], s[5 * 257] * sc * gv[5]); o.w = pk2(s[6 * 257] * sc * gv[6], s[7 * 257] * sc * gv[7]);
        *(u32x4*)(d.dst + (size_t)row * d.ldt + d.kd + 8 * c) = o; }
    __syncthreads();
}
__device__ __forceinline__ void b1_item(const KA& a, unsigned char* ws, int l, int it, int lane) {
            const int m = it >> 5, s = it & 31;
            const float* pe = (m ? (const float*)a.in(16) : (const float*)a.in(12)) + (size_t)l * 2048 + s * 64;
            const float* w1 = (m ? (const float*)a.in(17) : (const float*)a.in(13)) + (size_t)l * 2048 * 256 + (size_t)(s * 64) * 256;
            const unsigned pev = __float_as_uint(pe[lane]);
            f32x4 acc = (f32x4){0.f, 0.f, 0.f, 0.f}, acc2 = (f32x4){0.f, 0.f, 0.f, 0.f};
#pragma unroll 1
            for (int kb = 0; kb < 64; kb += 16) {
                f32x4 w[16];
#pragma unroll
                for (int i = 0; i < 16; ++i) w[i] = __builtin_nontemporal_load((const f32x4*)(w1 + (size_t)(kb + i) * 256) + lane);
#pragma unroll
                for (int i = 0; i < 16; i += 2) { const float p = __uint_as_float(__builtin_amdgcn_readlane(pev, kb + i)), p2 = __uint_as_float(__builtin_amdgcn_readlane(pev, kb + i + 1));
                    acc.x += p * w[i].x; acc.y += p * w[i].y; acc.z += p * w[i].z; acc.w += p * w[i].w; acc2.x += p2 * w[i + 1].x; acc2.y += p2 * w[i + 1].y; acc2.z += p2 * w[i + 1].z; acc2.w += p2 * w[i + 1].w; }
            }
            acc.x += acc2.x; acc.y += acc2.y; acc.z += acc2.z; acc.w += acc2.w;
            ((f32x4*)((float*)(ws + W_B1PART) + (size_t)(m * 32 + s) * 256))[lane] = acc;
}
__device__ __forceinline__ void phase_conv(const Frame& F, const KA& a, int l, int i_lo = 0, int i_hi = N_CONVA, bool rest = true, int foldG = -1) {
    unsigned char* ws = a.ws();
    const bool fold = MK_ONE_LAUNCH && (foldG < 0 ? F.G : foldG) == 256;
    const int gw = F.gw, ngw = F.ngw, lane = F.lane;
    {
        LAS float* scr = (LAS float*)F.lds;
        ConvB da, db; f32x4 va[8], vb[8];
        int i0 = i_lo + F.bid;
        if (i0 < i_hi) { convb_decode(da, a, ws, l, i0); da.gk = conv_gain(da.dst, a, ws, l, fold); convb_load(da, va, F.wave, lane); }
        for (; i0 < i_hi; i0 += 2 * F.G) {
            const int i1 = i0 + F.G, i2 = i1 + F.G; const bool h1 = i1 < i_hi, h2 = i2 < i_hi;
            if (h1) { convb_decode(db, a, ws, l, i1); db.gk = conv_gain(db.dst, a, ws, l, fold); convb_load(db, vb, F.wave, lane); }
            convb_finish(da, va, scr, F.tid, F.wave, lane);
            if (h2) { convb_decode(da, a, ws, l, i2); da.gk = conv_gain(da.dst, a, ws, l, fold); convb_load(da, va, F.wave, lane); }
            if (h1) convb_finish(db, vb, scr, F.tid, F.wave, lane);
        }
    }
    if (!rest) return;
    {
        LAS float* scr = (LAS float*)(F.lds + F.wave * 16384);
        for (int it = ngw - 1 - gw; it < 16; it += ngw) { ConvDesc d; f32x4 v[8];
            d.src = (const float*)a.in(10) + (size_t)l * DM * DIN + (size_t)(64 * it + (lane >> 3)) * DIN + 4352 + 4 * (lane & 7); d.ldw = DIN; d.dst = (bf16*)(ws + W_A); d.ldt = DM; d.kd = 64 * it; d.n0 = 4352; d.kind = 1; d.par = 0; d.sc = 1.0f; d.gk = conv_gain(d.dst, a, ws, l, fold);
            conv_load(d, v); conv_finish(d, v, scr, lane); }
    }
    __syncthreads();
    const int n_other = 14 + 64 + 512 + (l == 0 ? 4096 : 0);
    for (int it0 = ngw - 1 - gw; it0 < n_other; it0 += ngw) {
        int it = it0;
        if (it < 14) {
            u32x4* z = (u32x4*)(ws + W_A + (4384ull + 16 * it) * DM * 2) + lane; unsigned zz = 0u; asm volatile("" : "+v"(zz));
#pragma unroll 8
            for (int i = 0; i < 32; ++i) z[64 * i] = (u32x4){zz, zz, zz, zz};
            continue; }
        it -= 14;
        if (it < 64) {
            if (!fold) b1_item(a, ws, l, it, lane);
            continue; }
        it -= 64;
        if (it < 512) { norm_rows4_to_bf16((const float*)a.in(1) + (size_t)(4 * it) * DM, (const float*)a.in(6) + (size_t)l * DM, (bf16*)(ws + WS_MEMN) + (size_t)(4 * it) * DM, lane); continue; }
        it -= 512;
        if (fold) xcopy_rows4((const float*)a.in(0) + (size_t)(4 * it) * DM, (bf16*)(ws + WS_H) + (size_t)(4 * it) * DM, (float*)(ws + WS_XSTAT) + 4 * it, lane);
        else norm_rows4_to_bf16((const float*)a.in(0) + (size_t)(4 * it) * DM, (const float*)a.in(3), (bf16*)(ws + WS_H) + (size_t)(4 * it) * DM, lane);
    }
}

__device__ __forceinline__ void phase_conv_b(const Frame& F, const KA& a, int l) {
    unsigned char* ws = a.ws();
    LAS float* scr = (LAS float*)F.lds;
    LAS unsigned* qslot = (LAS unsigned*)(F.lds + 66048);
    unsigned* ctr = (unsigned*)(ws + WS_CTL) + CW_CVB + 64 * (unsigned)l;
    for (;;) {
        if (F.tid == 0) *qslot = __hip_atomic_fetch_add(ctr, 1u, __ATOMIC_RELAXED, __HIP_MEMORY_SCOPE_AGENT);
        __syncthreads();
        const unsigned k_ = *qslot;
        __syncthreads();
        if (k_ >= (unsigned)(N_CONVB - N_CONVA)) break;
        ConvB d; f32x4 v[8];
        convb_decode(d, a, ws, l, N_CONVA + (int)k_); d.gk = conv_gain(d.dst, a, ws, l, (MK_ONE_LAUNCH && F.G == 256)); convb_load(d, v, F.wave, F.lane);
        convb_finish(d, v, scr, F.tid, F.wave, F.lane);
    }
}

__device__ __forceinline__ void phase_post(const Frame& F, const KA& a, int l, bool dry) {
    unsigned char* ws = a.ws();
    bf16* nsakv = (bf16*)(ws + WS_KV + 64 * MiB);
    const bf16* small = (const bf16*)(ws + WS_KV + 88 * MiB);
    const int* pos = (const int*)a.in(2);
    for (int it = F.gt; it < M * 32; it += F.ngt) {
        const int tok = it >> 5, r = it & 31, which = r >> 4, g = (r >> 3) & 1, i = r & 7;
        bf16* p = nsakv + (size_t)tok * 768 + 256 + which * 256 + g * 64 + i;
        float c, s; rope_cs(pos[tok], i, c, s);
        const float x1 = bf2f(p[0]), x2 = bf2f(p[8]);
        if (!dry) { p[0] = f2bf(x1 * c - x2 * s); p[8] = f2bf(x2 * c + x1 * s); }
    }
    if (F.bid >= 64 && F.bid < 128) {
        const int it = F.bid - 64, b = it >> 3, h = it & 7; const float bias = ((const float*)a.in(11))[l * 8 + h];
        const bf16* fp = small + ((size_t)b * SEQ + 4 * F.tid) * 256 + 24 + h;
        float v0 = logsig(bf2f(fp[0]) + bias), v1 = logsig(bf2f(fp[256]) + bias), v2 = logsig(bf2f(fp[512]) + bias), v3 = logsig(bf2f(fp[768]) + bias);
        v1 += v0; v2 += v1; v3 += v2;
        float inc = v3;
#pragma unroll
        for (int o = 1; o < 64; o <<= 1) { const float t = __shfl_up(inc, o); if (F.lane >= o) inc += t; }
        LAS float* wtot = (LAS float*)F.lds;
        if (F.lane == 63) wtot[F.wave] = inc;
        __syncthreads();
        float base = inc - v3;
        for (int w = 0; w < F.wave; ++w) base += wtot[w];
        *(f32x4*)((float*)(ws + WS_CF) + ((size_t)b * 8 + h) * SEQ + 4 * F.tid) = (f32x4){base + v0, base + v1, base + v2, base + v3};
        __syncthreads();
    }
}

__device__ __forceinline__ void phase_cmp2(const Frame& F, const KA& a, int l) {
    unsigned char* ws = a.ws();
    LAS float* b1p = (LAS float*)F.lds;
    LAS float* hid = (LAS float*)(F.lds + 4096) + F.wave * 512;
    {
        const int m = F.tid >> 8, j = F.tid & 255;
        const float* part = (const float*)(ws + W_B1PART) + (size_t)m * 32 * 256 + j;
        float pv[32];
#pragma unroll
        for (int i = 0; i < 32; ++i) pv[i] = part[i * 256];
        float s = (m ? (const float*)a.in(18) : (const float*)a.in(14))[l * 256 + j];
#pragma unroll
        for (int i = 0; i < 32; ++i) s += pv[i];
        b1p[m * 256 + j] = s;
    }
    __syncthreads();
    for (int it = 2 * F.gw; it < 4096; it += 2 * F.ngw) {
        const int m = it >> 11, r = it & 2047, b = r >> 8, c = (r >> 1) & 127;
        bf16* out = (bf16*)(ws + (m ? WS_VCMP : WS_KCMP)) + (((size_t)b * 2 + 0) * 128 + c) * 64;
        if (c == 127) { out[F.lane] = 0; out[128 * 64 + F.lane] = 0; continue; }
#pragma unroll
        for (int g = 0; g < 2; ++g) {
            const bf16* P = (const bf16*)(ws + (m ? WS_PV : WS_PK)) + ((size_t)g * 1024 + b * 128 + c) * 512;
            const u32x2 p1 = *(const u32x2*)(P + 4 * F.lane), p2 = *(const u32x2*)(P + 512 + 256 + 4 * F.lane);
            float hv[4];
            hv[0] = __uint_as_float(p1.x << 16) + __uint_as_float(p2.x << 16); hv[1] = __uint_as_float(p1.x & 0xffff0000u) + __uint_as_float(p2.x & 0xffff0000u);
            hv[2] = __uint_as_float(p1.y << 16) + __uint_as_float(p2.y << 16); hv[3] = __uint_as_float(p1.y & 0xffff0000u) + __uint_as_float(p2.y & 0xffff0000u);
            f32x4 hx;
#pragma unroll
            for (int e = 0; e < 4; ++e) { const float x = hv[e] + b1p[m * 256 + 4 * F.lane + e]; hx[e] = x * sigm(x); }
            *(LAS f32x4*)(hid + g * 256 + 4 * F.lane) = hx;
        }
        asm volatile("s_waitcnt lgkmcnt(0)" ::: "memory");
        const float* w2 = (m ? (const float*)a.in(19) : (const float*)a.in(15)) + (size_t)l * 256 * 64 + F.lane;
        float acc0 = 0.f, acc1 = 0.f;
#pragma unroll 1
        for (int jb = 0; jb < 256; jb += 64) {
            float w[64];
#pragma unroll
            for (int i = 0; i < 64; ++i) w[i] = w2[(jb + i) * 64];
#pragma unroll
            for (int i = 0; i < 64; i += 4) { const f32x4 h0 = *(const LAS f32x4*)(hid + jb + i), h1 = *(const LAS f32x4*)(hid + 256 + jb + i);
                acc0 += h0.x * w[i] + h0.y * w[i + 1] + h0.z * w[i + 2] + h0.w * w[i + 3]; acc1 += h1.x * w[i] + h1.y * w[i + 1] + h1.z * w[i + 2] + h1.w * w[i + 3]; }
        }
        out[F.lane] = f2bf(acc0); out[128 * 64 + F.lane] = f2bf(acc1);
        asm volatile("s_waitcnt lgkmcnt(0)" ::: "memory");
    }
    __syncthreads();
}


namespace fa {
typedef short bf16x8 __attribute__((ext_vector_type(8)));
typedef short s16x4 __attribute__((ext_vector_type(4)));
typedef float f32x16 __attribute__((ext_vector_type(16)));
constexpr int KROW = 144;
constexpr int VROW = 192;
constexpr int TILE_B = 64 * KROW;
constexpr int VTILE_B = 64 * VROW;
constexpr int BIAS_OFF = TILE_B + VTILE_B;
constexpr int BUF_B = BIAS_OFF + 256;
constexpr float LOG2E = 1.4426950408889634f;
enum { MODE_NONE = 0, MODE_CAUSAL = 1, MODE_WINDOW = 2, MODE_SELECT = 3 };

__device__ __forceinline__ int crow(int r, int hi) { return (r & 3) + 8 * (r >> 2) + 4 * hi; }
__device__ __forceinline__ float xmax(float v) {
    auto rr = __builtin_amdgcn_permlane32_swap(__float_as_uint(v), __float_as_uint(v), false, false);
    return fmaxf(__uint_as_float(rr[0]), __uint_as_float(rr[1]));
}
typedef float f32x2 __attribute__((ext_vector_type(2)));
__device__ __forceinline__ float max3f(float a, float b, float c) { float r; asm("v_max3_f32 %0, %1, %2, %3" : "=v"(r) : "v"(a), "v"(b), "v"(c)); return r; }
__device__ __forceinline__ float xsum(float v) {
    auto rr = __builtin_amdgcn_permlane32_swap(__float_as_uint(v), __float_as_uint(v), false, false);
    return __uint_as_float(rr[0]) + __uint_as_float(rr[1]);
}
__device__ __forceinline__ s16x4 vtr(const LAS unsigned char* p) {
    typedef short v4i16_t __attribute__((ext_vector_type(4)));
    return __builtin_bit_cast(s16x4, __builtin_amdgcn_ds_read_tr16_b64_v4i16((LAS v4i16_t*)p));
}
__device__ __forceinline__ bf16x8 pack8(const f32x16& p, int b) {
    u32x4 w; w.x = pk2(p[b], p[b + 1]); w.y = pk2(p[b + 2], p[b + 3]); w.z = pk2(p[b + 4], p[b + 5]); w.w = pk2(p[b + 6], p[b + 7]);
    return __builtin_bit_cast(bf16x8, w);
}
__device__ __forceinline__ void load_q(bf16x8 (&qf)[4], const bf16* qrow, int hi) {
#pragma unroll
    for (int d0 = 0; d0 < 4; ++d0) qf[d0] = __builtin_bit_cast(bf16x8, *(const u32x4*)(qrow + 16 * d0 + 8 * hi));
}
__device__ __forceinline__ void rope_q(bf16x8& q0, int pos, int hi) {
    const u32x4 own = __builtin_bit_cast(u32x4, q0); u32x4 oth;
    oth.x = __shfl_xor(own.x, 32); oth.y = __shfl_xor(own.y, 32); oth.z = __shfl_xor(own.z, 32); oth.w = __shfl_xor(own.w, 32);
    float a[8], b[8];
    a[0] = __uint_as_float(own.x << 16); a[1] = __uint_as_float(own.x & 0xffff0000u); a[2] = __uint_as_float(own.y << 16); a[3] = __uint_as_float(own.y & 0xffff0000u);
    a[4] = __uint_as_float(own.z << 16); a[5] = __uint_as_float(own.z & 0xffff0000u); a[6] = __uint_as_float(own.w << 16); a[7] = __uint_as_float(own.w & 0xffff0000u);
    b[0] = __uint_as_float(oth.x << 16); b[1] = __uint_as_float(oth.x & 0xffff0000u); b[2] = __uint_as_float(oth.y << 16); b[3] = __uint_as_float(oth.y & 0xffff0000u);
    b[4] = __uint_as_float(oth.z << 16); b[5] = __uint_as_float(oth.z & 0xffff0000u); b[6] = __uint_as_float(oth.w << 16); b[7] = __uint_as_float(oth.w & 0xffff0000u);
    const float sg = hi ? 1.0f : -1.0f;
#pragma unroll
    for (int i = 0; i < 8; ++i) { float c, s; rope_cs(pos, i, c, s); a[i] = a[i] * c + sg * b[i] * s; }
    u32x4 w; w.x = pk2(a[0], a[1]); w.y = pk2(a[2], a[3]); w.z = pk2(a[4], a[5]); w.w = pk2(a[6], a[7]);
    q0 = __builtin_bit_cast(bf16x8, w);
}

struct KV { const bf16* K; const bf16* V; int ldk, ldv; const float* cb; };

struct Stage { u32x4 k, v; float b; };
template <bool BIAS> __device__ __forceinline__ void stage_load(Stage& s, const KV& P, int t, int tid) {
    const int row = 64 * t + (tid >> 3), ch = tid & 7;
    s.k = *(const u32x4*)(P.K + (size_t)row * P.ldk + ch * 8); s.v = *(const u32x4*)(P.V + (size_t)row * P.ldv + ch * 8);
    if (BIAS) { if (tid < 64) s.b = P.cb[64 * t + tid]; }
}
template <bool BIAS> __device__ __forceinline__ void stage_store(const Stage& s, LAS unsigned char* buf, int tid) {
    const int off = (tid >> 3) * KROW + (tid & 7) * 16, offv = (tid >> 3) * VROW + (tid & 7) * 16;
    *(LAS u32x4*)(buf + off) = s.k; *(LAS u32x4*)(buf + TILE_B + offv) = s.v;
    if (BIAS) { if (tid < 64) *(LAS float*)(buf + BIAS_OFF + tid * 4) = -s.b; }
}

template <int MODE> __device__ __forceinline__ bool tile_work(int t, int tq0, unsigned sel) {
    bool w = true;
    if (MODE == MODE_CAUSAL || MODE == MODE_WINDOW || MODE == MODE_SELECT) w = (64 * t <= tq0 + 31);
    if (MODE == MODE_WINDOW) w = w && (64 * t + 63 >= tq0 - 511);
    if (MODE == MODE_SELECT) w = w && (__ballot((sel >> t) & 1u) != 0ull);
    return w;
}
template <int MODE> __device__ __forceinline__ bool tile_full(int t, int tq0, unsigned sel) {
    bool f = true;
    if (MODE == MODE_CAUSAL || MODE == MODE_WINDOW || MODE == MODE_SELECT) f = (64 * t + 63 <= tq0);
    if (MODE == MODE_WINDOW) f = f && (tq0 + 31 - 64 * t < 512);
    if (MODE == MODE_SELECT) f = f && (__ballot((sel >> t) & 1u) == ~0ull);
    return f;
}

template <int MODE, bool BIAS, int XP = 0>
__device__ __forceinline__ void flash_tile(const LAS unsigned char* buf, int t, const bf16x8 (&qf)[4], int tq, int tq0, unsigned sel, int koff, int voff, int hi, f32x16 (&o)[2], float& m, float& l) {
    if (tile_work<MODE>(t, tq0, sel)) {
        bf16x8 kf[8];
#pragma unroll
        for (int d0 = 0; d0 < 4; ++d0) { kf[2 * d0] = *(const LAS bf16x8*)(buf + koff + d0 * 32); kf[2 * d0 + 1] = *(const LAS bf16x8*)(buf + koff + 32 * KROW + d0 * 32); }
        f32x16 s0, s1;
        if (BIAS) {
#pragma unroll
            for (int u = 0; u < 4; ++u) { const f32x4 b0 = *(const LAS f32x4*)(buf + BIAS_OFF + (8 * u + 4 * hi) * 4), b1 = *(const LAS f32x4*)(buf + BIAS_OFF + (32 + 8 * u + 4 * hi) * 4);
                s0[4 * u] = b0.x; s0[4 * u + 1] = b0.y; s0[4 * u + 2] = b0.z; s0[4 * u + 3] = b0.w; s1[4 * u] = b1.x; s1[4 * u + 1] = b1.y; s1[4 * u + 2] = b1.z; s1[4 * u + 3] = b1.w; }
        } else { s0 = f32x16{}; s1 = f32x16{}; }
        asm volatile("s_waitcnt lgkmcnt(0)" ::: "memory");
#pragma unroll
        for (int d0 = 0; d0 < 4; ++d0) { if (XP == 2) { asm volatile("" :: "v"(kf[2 * d0]), "v"(kf[2 * d0 + 1])); } else { s0 = __builtin_amdgcn_mfma_f32_32x32x16_bf16(kf[2 * d0], qf[d0], s0, 0, 0, 0); s1 = __builtin_amdgcn_mfma_f32_32x32x16_bf16(kf[2 * d0 + 1], qf[d0], s1, 0, 0, 0); } }
        s16x4 vlo[8], vhh[8];
#pragma unroll
        for (int j = 0; j < 2; ++j)
#pragma unroll
            for (int s = 0; s < 2; ++s)
#pragma unroll
                for (int d0 = 0; d0 < 2; ++d0) { const LAS unsigned char* vp = buf + voff + (32 * j + 16 * s) * VROW + d0 * 64; vlo[4 * j + 2 * s + d0] = vtr(vp); vhh[4 * j + 2 * s + d0] = vtr(vp + 8 * VROW); }
        asm volatile("" ::: "memory");
        asm volatile("s_nop 15\n\ts_nop 7" : "+v"(s0), "+v"(s1));
        if (MODE != MODE_NONE) {
            if (!tile_full<MODE>(t, tq0, sel)) {
                const int d = tq - (64 * t + 4 * hi);
                const bool selt = (MODE == MODE_SELECT) ? (((sel >> t) & 1u) != 0u) : true;
#pragma unroll
                for (int r = 0; r < 16; ++r) {
                    const int ca = (r & 3) + 8 * (r >> 2), cb = ca + 32;
                    bool va = selt && (ca <= d), vb = selt && (cb <= d);
                    if (MODE == MODE_WINDOW) { va = va && (ca > d - 512); vb = vb && (cb > d - 512); }
                    s0[r] = va ? s0[r] : -INFINITY; s1[r] = vb ? s1[r] : -INFINITY;
                }
            }
        }
        float mx0 = max3f(s0[0], s1[0], s0[1]), mx1 = max3f(s1[1], s0[2], s1[2]);
#pragma unroll
        for (int r = 3; r < 15; r += 2) { mx0 = max3f(mx0, s0[r], s1[r]); mx1 = max3f(mx1, s0[r + 1], s1[r + 1]); }
        const float mx = xmax(max3f(mx0, mx1, max3f(s0[15], s1[15], mx0)));
        const float mn = fmaxf(m, mx * LOG2E), ms = (mn == -INFINITY) ? 0.f : mn;
        const float alpha = __builtin_amdgcn_exp2f(m - ms);
        const bool resc = (mn != m);
        m = mn;
        f32x2 ps = (f32x2){0.f, 0.f};
#pragma unroll
        for (int r = 0; r < 16; r += 2) {
            const f32x2 ta = (f32x2){s0[r], s0[r + 1]} * LOG2E - ms, tb = (f32x2){s1[r], s1[r + 1]} * LOG2E - ms;
            if (XP == 1) { s0[r] = ta.x; s0[r + 1] = ta.y; s1[r] = tb.x; s1[r + 1] = tb.y; } else { s0[r] = __builtin_amdgcn_exp2f(ta.x); s0[r + 1] = __builtin_amdgcn_exp2f(ta.y); s1[r] = __builtin_amdgcn_exp2f(tb.x); s1[r + 1] = __builtin_amdgcn_exp2f(tb.y); }
            ps += (f32x2){s0[r], s0[r + 1]}; ps += (f32x2){s1[r], s1[r + 1]};
        }
        l = l * alpha + (ps.x + ps.y);
        if (__any(resc)) {
#pragma unroll
            for (int r = 0; r < 16; ++r) { o[0][r] *= alpha; o[1][r] *= alpha; }
        }
#pragma unroll
        for (int j = 0; j < 2; ++j)
#pragma unroll
            for (int s = 0; s < 2; ++s) {
                const bf16x8 pb = pack8(j ? s1 : s0, 8 * s);
#pragma unroll
                for (int d0 = 0; d0 < 2; ++d0) { const s16x4 lo = vlo[4 * j + 2 * s + d0], hh = vhh[4 * j + 2 * s + d0];
                    const bf16x8 vf = (bf16x8){lo[0], lo[1], lo[2], lo[3], hh[0], hh[1], hh[2], hh[3]};
                    if (XP == 2) { asm volatile("" :: "v"(vf), "v"(pb)); } else o[d0] = __builtin_amdgcn_mfma_f32_32x32x16_bf16(vf, pb, o[d0], 0, 0, 0); }
            }
    }
}
template <int MODE, bool BIAS, int XP = 0>
__device__ __forceinline__ void flash_core_v4(LAS unsigned char* lds, const KV& P, int t_lo, int t_hi, const bf16x8 (&qf)[4], int tq, int tq0, unsigned sel, f32x16 (&o)[2], float& l_out) {
    int tid_ = threadIdx.x; asm volatile("" : "+v"(tid_));
    const int tid = tid_, lane = tid & 63, r32 = lane & 31, hi = lane >> 5;
    o[0] = f32x16{}; o[1] = f32x16{};
    float m = -INFINITY, l = 0.f;
    const int koff = r32 * KROW + hi * 16;
    const int voff = TILE_B + (4 * hi + ((lane & 15) >> 2)) * VROW + (((lane >> 4) & 1) * 16 + (lane & 3) * 4) * 2;
    Stage sa, sb;
    stage_load<BIAS>(sa, P, t_lo, tid); stage_store<BIAS>(sa, lds, tid);
    if (t_lo + 1 < t_hi) stage_load<BIAS>(sa, P, t_lo + 1, tid);
    __syncthreads();
    for (int t = t_lo; t < t_hi; t += 2) {
        if (XP < 3 && t + 2 < t_hi) stage_load<BIAS>(sb, P, t + 2, tid);
        flash_tile<MODE, BIAS, XP>(lds, t, qf, tq, tq0, sel, koff, voff, hi, o, m, l);
        if (XP < 3 && t + 1 < t_hi) stage_store<BIAS>(sa, lds + BUF_B, tid);
        if (XP < 4) __syncthreads();
        if (t + 1 >= t_hi) break;
        if (XP < 3 && t + 3 < t_hi) stage_load<BIAS>(sa, P, t + 3, tid);
        flash_tile<MODE, BIAS, XP>(lds + BUF_B, t + 1, qf, tq, tq0, sel, koff, voff, hi, o, m, l);
        if (XP < 3 && t + 2 < t_hi) stage_store<BIAS>(sb, lds, tid);
        if (XP < 4) __syncthreads();
    }
    l_out = xsum(l);
}
__device__ __forceinline__ void store_o(bf16* orow, const f32x16 (&o)[2], float a, int hi) {
#pragma unroll
    for (int d0 = 0; d0 < 2; ++d0)
#pragma unroll
        for (int u = 0; u < 4; u += 2) {
            u32x2 wa, wb;
            wa.x = pk2(o[d0][4 * u] * a, o[d0][4 * u + 1] * a); wa.y = pk2(o[d0][4 * u + 2] * a, o[d0][4 * u + 3] * a);
            wb.x = pk2(o[d0][4 * u + 4] * a, o[d0][4 * u + 5] * a); wb.y = pk2(o[d0][4 * u + 6] * a, o[d0][4 * u + 7] * a);
            const auto rx = __builtin_amdgcn_permlane32_swap(wa.x, wb.x, false, false), ry = __builtin_amdgcn_permlane32_swap(wa.y, wb.y, false, false);
            u32x4 w; w.x = rx[0]; w.y = ry[0]; w.z = rx[1]; w.w = ry[1];
            *(u32x4*)(orow + 32 * d0 + 8 * u + 8 * hi) = w; }
}
}

__device__ __forceinline__ void phase_mem_mfma(const Frame& F, const KA& a, const float* rs) {
    using namespace fa;
    unsigned char* ws = a.ws();
    const int vcu = (F.G % 8 == 0) ? (F.bid % 8) * (F.G / 8) + F.bid / 8 : F.bid;
    for (int u = vcu; u < 256; u += F.G) {
        const int b = u >> 5, h = (u >> 3) & 3, qb = u & 7;
        int tid_ = threadIdx.x; asm volatile("" : "+v"(tid_));
        const int tid = tid_, lane = tid & 63, hi = lane >> 5, r32 = lane & 31, tq0 = 256 * qb + 32 * F.wave;
        const size_t tok = (size_t)b * SEQ + tq0 + r32;
        KV P{(const bf16*)(ws + WS_MEMKV) + (size_t)b * NMEM * 512 + h * 64, (const bf16*)(ws + WS_MEMKV) + (size_t)b * NMEM * 512 + 256 + h * 64, 512, 512, nullptr};
        Stage st[4];
#pragma unroll
        for (int t = 0; t < 4; ++t) stage_load<false>(st[t], P, t, tid);
        bf16x8 qf[4];
        const float rsq = rs ? rs[tok] : 1.0f;
#pragma unroll
        for (int d0 = 0; d0 < 4; ++d0) {
            float qa[8];
#pragma unroll
            for (int e = 0; e < 8; ++e) qa[e] = 0.f;
#pragma unroll
            for (int kq = 0; kq < 4; ++kq) { const u32x4 v = *(const u32x4*)((const bf16*)(ws + WS_MQ) + ((size_t)kq * M + tok) * 256 + h * 64 + 16 * d0 + 8 * hi);
                qa[0] += __uint_as_float(v.x << 16); qa[1] += __uint_as_float(v.x & 0xffff0000u); qa[2] += __uint_as_float(v.y << 16); qa[3] += __uint_as_float(v.y & 0xffff0000u);
                qa[4] += __uint_as_float(v.z << 16); qa[5] += __uint_as_float(v.z & 0xffff0000u); qa[6] += __uint_as_float(v.w << 16); qa[7] += __uint_as_float(v.w & 0xffff0000u); }
            u32x4 w; w.x = pk2(qa[0] * rsq, qa[1] * rsq); w.y = pk2(qa[2] * rsq, qa[3] * rsq); w.z = pk2(qa[4] * rsq, qa[5] * rsq); w.w = pk2(qa[6] * rsq, qa[7] * rsq);
            qf[d0] = __builtin_bit_cast(bf16x8, w);
        }
#pragma unroll
        for (int t = 0; t < 4; ++t) stage_store<false>(st[t], F.lds + t * BUF_B, tid);
        __syncthreads();
        f32x16 o[2]; o[0] = f32x16{}; o[1] = f32x16{};
        float m = -INFINITY, l = 0.f;
        const int koff = r32 * KROW + hi * 16;
        const int voff = TILE_B + (4 * hi + ((lane & 15) >> 2)) * VROW + (((lane >> 4) & 1) * 16 + (lane & 3) * 4) * 2;
        int nt_ = 4; asm volatile("" : "+s"(nt_));
        for (int t = 0; t < nt_; ++t) flash_tile<MODE_NONE, false>(F.lds + t * BUF_B, t, qf, tq0 + r32, tq0, 0u, koff, voff, hi, o, m, l);
        l = xsum(l);
        store_o((bf16*)(ws + WS_MO) + tok * 256 + h * 64, o, 1.0f / l, hi);
        __syncthreads();
    }
}
__device__ __forceinline__ void phase_fox_mfma(const Frame& F, const KA& a, bool dry) {
    unsigned char* ws = a.ws();
    const int vcu = (F.G % 8 == 0) ? (F.bid % 8) * (F.G / 8) + F.bid / 8 : F.bid;
    for (int u = vcu; u < 256; u += F.G) {
        const int bh = u >> 2, b = bh >> 3, h = bh & 7, s4 = u & 3;
        for (int half = 0; half < 2; ++half) {
            const int qb = half ? 7 - s4 : s4;
            const int hi = F.lane >> 5, r32 = F.lane & 31, tq0 = 256 * qb + 32 * F.wave;
            const size_t row0 = (size_t)b * SEQ, tok = row0 + tq0 + r32;
            bf16* Q = (bf16*)(ws + WS_OQ + 32 * MiB);
            fa::bf16x8 qf[4]; fa::load_q(qf, Q + tok * 512 + h * 64, hi);
            fa::KV P{(const bf16*)(ws + WS_KV + 32 * MiB) + row0 * 512 + h * 64, (const bf16*)(ws + WS_KV + 48 * MiB) + row0 * 512 + h * 64, 512, 512, (const float*)(ws + WS_CF) + (size_t)bh * SEQ};
            fa::f32x16 o[2]; float l;
            if (dry && PROBE_XP) fa::flash_core_v4<fa::MODE_CAUSAL, true, PROBE_XP>(F.lds, P, 0, 4 * (qb + 1), qf, tq0 + r32, tq0, 0u, o, l);
            else FA_CORE_FOX<fa::MODE_CAUSAL, true>(F.lds, P, 0, 4 * (qb + 1), qf, tq0 + r32, tq0, 0u, o, l);
            if (!dry) fa::store_o(Q + tok * 512 + h * 64, o, 1.0f / l, hi);
        }
    }
}

__device__ __forceinline__ void phase_nsa_fused(const Frame& F, const KA& a, bool dry) {
    using namespace fa;
    unsigned char* ws = a.ws();
    const int vcu = (F.G % 8 == 0) ? (F.bid % 8) * (F.G / 8) + F.bid / 8 : F.bid;
    const int* pos = (const int*)a.in(2);
    const int lane = F.lane, r32 = lane & 31, hi = lane >> 5, tid = F.tid, wave = F.wave;
    LAS unsigned char* lds = F.lds;
    constexpr int CT = 128 * KROW, SC_OFF = 45056, MK_OFF = SC_OFF + 8 * 32 * 32 * 4;
    for (int u = vcu; u < 256; u += F.G) {
        const int bg = u >> 4, b = bg >> 1, g = bg & 1, s16 = u & 15;
        for (int half = 0; half < 2; ++half) {
            const int qb = half ? 31 - s16 : s16;
            const int h = 4 * g + (wave >> 1), tq0 = 64 * qb + 32 * (wave & 1), tq = tq0 + r32;
            const size_t row0 = (size_t)b * SEQ, tok = row0 + tq;
            bf16* Q = (bf16*)(ws + WS_OQ + 16 * MiB);
            const bf16* kv = (const bf16*)(ws + WS_KV + 64 * MiB) + row0 * 768 + g * 64;
            const bf16* small = (const bf16*)(ws + WS_KV + 88 * MiB) + tok * 256 + h * 3;
            const float g0 = sigm(bf2f(small[0])), g1 = sigm(bf2f(small[1])), g2 = sigm(bf2f(small[2]));
            bf16x8 qf[4]; load_q(qf, Q + tok * 512 + h * 64, hi);
            {   const bf16* Kc = (const bf16*)(ws + WS_KCMP) + (size_t)bg * 128 * 64; const bf16* Vc = (const bf16*)(ws + WS_VCMP) + (size_t)bg * 128 * 64;
#pragma unroll
                for (int i = 0; i < 2; ++i) { const int pc = tid + 512 * i, row = pc >> 3, ch = pc & 7;
                    *(LAS u32x4*)(lds + row * KROW + ch * 16) = *(const u32x4*)(Kc + row * 64 + ch * 8);
                    *(LAS u32x4*)(lds + CT + row * VROW + ch * 16) = *(const u32x4*)(Vc + row * 64 + ch * 8); } }
            __syncthreads();
            {
                f32x16 acc[2];
                const int koff = r32 * KROW + hi * 16;
                const int voff = CT + (4 * hi + ((lane & 15) >> 2)) * VROW + (((lane >> 4) & 1) * 16 + (lane & 3) * 4) * 2;
                const int ncmax = tq0 >= 0 ? min(127, (tq0 + 31 - 31) / 16 + 1) : 0, nsub = (ncmax + 31) >> 5;
                f32x16 s[4];
#pragma unroll
                for (int j = 0; j < 4; ++j) s[j] = f32x16{};
#pragma unroll
                for (int j = 0; j < 4; ++j) if (j < nsub) {
#pragma unroll
                    for (int d0 = 0; d0 < 4; ++d0) { const bf16x8 kf = *(const LAS bf16x8*)(lds + koff + 32 * j * KROW + d0 * 32); s[j] = __builtin_amdgcn_mfma_f32_32x32x16_bf16(kf, qf[d0], s[j], 0, 0, 0); } }
                float mx = -INFINITY;
#pragma unroll
                for (int j = 0; j < 4; ++j)
#pragma unroll
                    for (int rr = 0; rr < 16; ++rr) { const int c = 32 * j + crow(rr, hi); const bool v = (16 * c + 31 <= tq) && (c < 127) && (j < nsub); s[j][rr] = v ? s[j][rr] : -INFINITY; mx = fmaxf(mx, s[j][rr]); }
                mx = xmax(mx);
                const float ms = (mx == -INFINITY) ? 0.f : mx * LOG2E;
                float ps = 0.f;
#pragma unroll
                for (int j = 0; j < 4; ++j)
#pragma unroll
                    for (int rr = 0; rr < 16; ++rr) { s[j][rr] = __builtin_amdgcn_exp2f(s[j][rr] * LOG2E - ms); ps += s[j][rr]; }
                ps = xsum(ps);
                const float inv = ps > 0.f ? 1.0f / ps : 0.f;
#pragma unroll
                for (int j = 0; j < 4; ++j)
#pragma unroll
                    for (int rr = 0; rr < 16; ++rr) s[j][rr] *= inv;
                LAS float* sc_out = (LAS float*)(lds + SC_OFF) + (wave * 32 + r32) * 32;
                float prev = 0.f;
#pragma unroll
                for (int idx = 0; idx < 16; ++idx) { const int j = idx >> 2, uu = idx & 3;
                    const float G = (s[j][4 * uu] + s[j][4 * uu + 1]) + (s[j][4 * uu + 2] + s[j][4 * uu + 3]), L = s[j][4 * uu + 3];
                    const float recv = __shfl_xor(L, 32);
                    sc_out[2 * idx + hi] = G + (hi ? recv : prev);
                    prev = recv; }
                acc[0] = f32x16{}; acc[1] = f32x16{};
#pragma unroll
                for (int j = 0; j < 4; ++j) if (j < nsub) {
#pragma unroll
                    for (int ss = 0; ss < 2; ++ss) {
                        const bf16x8 pb = pack8(s[j], 8 * ss);
#pragma unroll
                        for (int d0 = 0; d0 < 2; ++d0) {
                            const LAS unsigned char* vp = lds + voff + (32 * j + 16 * ss) * VROW + d0 * 64;
                            const s16x4 lo = vtr(vp), hh = vtr(vp + 8 * VROW);
                            const bf16x8 vf = (bf16x8){lo[0], lo[1], lo[2], lo[3], hh[0], hh[1], hh[2], hh[3]};
                            acc[d0] = __builtin_amdgcn_mfma_f32_32x32x16_bf16(vf, pb, acc[d0], 0, 0, 0);
                        }
                    } }
                store_o((bf16*)(ws + WS_OCMP) + tok * 512 + h * 64, acc, g0, hi);
            }
            __syncthreads();
            {
                const int row = tid >> 3, part = tid & 7, t = 64 * qb + row, sub = row >> 5, rr = row & 31;
                float sc[4] = {0.f, 0.f, 0.f, 0.f};
#pragma unroll
                for (int r = 0; r < 4; ++r) { const f32x4 v = ((const LAS f32x4*)(lds + SC_OFF))[((2 * r + sub) * 32 + rr) * 8 + part]; sc[0] += v.x; sc[1] += v.y; sc[2] += v.z; sc[3] += v.w; }
                const int cur = t >> 6;
#pragma unroll
                for (int e = 0; e < 4; ++e) { const int n = 4 * part + e; sc[e] = (n == 0 || n == cur) ? 1e4f : ((64 * n <= t) ? sc[e] : -1.0f); }
                unsigned mask = 0u;
#pragma unroll 1
                for (int k = 0; k < 8; ++k) {
                    float best = sc[0]; int bi = 4 * part;
#pragma unroll
                    for (int e = 1; e < 4; ++e) { const bool take = sc[e] > best; best = take ? sc[e] : best; bi = take ? 4 * part + e : bi; }
#pragma unroll
                    for (int o = 1; o < 8; o <<= 1) { const float ob = __shfl_xor(best, o); const int oi = __shfl_xor(bi, o); const bool take = (ob > best) || (ob == best && oi < bi); best = take ? ob : best; bi = take ? oi : bi; }
                    mask |= 1u << bi;
#pragma unroll
                    for (int e = 0; e < 4; ++e) sc[e] = (4 * part + e == bi) ? -INFINITY : sc[e];
                }
                if (part == 0) ((LAS unsigned*)(lds + MK_OFF))[row] = mask;
            }
            __syncthreads();
            const unsigned sel = ((const LAS unsigned*)(lds + MK_OFF))[32 * (wave & 1) + r32];
            rope_q(qf[0], pos[tok], hi);
            f32x16 o[2]; float l;
            { KV P{kv + 256, kv + 384, 768, 768, nullptr};
              FA_CORE_SEL<MODE_SELECT, false>(lds, P, 0, qb + 1, qf, tq, tq0, sel, o, l); }
            f32x16 acc[2];
            { const float sc = l > 0.f ? g1 / l : 0.f;
#pragma unroll
              for (int r = 0; r < 16; ++r) { acc[0][r] = o[0][r] * sc; acc[1][r] = o[1][r] * sc; } }
            { KV P{kv + 512, kv + 640, 768, 768, nullptr};
              FA_CORE_SEL<MODE_WINDOW, false>(lds, P, qb > 8 ? qb - 8 : 0, qb + 1, qf, tq, tq0, 0u, o, l); }
            { const float sc = l > 0.f ? g2 / l : 0.f;
              const bf16* oc = (const bf16*)(ws + WS_OCMP) + tok * 512 + h * 64;
#pragma unroll
              for (int d0 = 0; d0 < 2; ++d0)
#pragma unroll
                  for (int uu = 0; uu < 4; ++uu) { const u32x2 w = *(const u32x2*)(oc + 32 * d0 + 8 * uu + 4 * hi);
                      acc[d0][4 * uu] += o[d0][4 * uu] * sc + __uint_as_float(w.x << 16); acc[d0][4 * uu + 1] += o[d0][4 * uu + 1] * sc + __uint_as_float(w.x & 0xffff0000u);
                      acc[d0][4 * uu + 2] += o[d0][4 * uu + 2] * sc + __uint_as_float(w.y << 16); acc[d0][4 * uu + 3] += o[d0][4 * uu + 3] * sc + __uint_as_float(w.y & 0xffff0000u); } }
            if (!dry) store_o(Q + tok * 512 + h * 64, acc, 1.0f, hi);
        }
    }
}


__device__ __forceinline__ void phase_sb_mfma(const Frame& F, const KA& a, int l, bool dry) {
    using namespace fa;
    unsigned char* ws = a.ws();
    const int lane = F.lane, r32 = lane & 31, hi = lane >> 5;
    LAS unsigned char* lds = F.lds + F.wave * (32 * KROW + 32 * VROW);
    constexpr int SUB_B = 32 * KROW;
    const int koff = r32 * KROW + hi * 16;
    const int voff = SUB_B + (4 * hi + ((lane & 15) >> 2)) * VROW + (((lane >> 4) & 1) * 16 + (lane & 3) * 4) * 2;
    const unsigned shard = (unsigned)F.bid & 7u;
    unsigned* ctr = (unsigned*)(ws + WS_CTL) + CW_SB + 64 * (shard + 8 * (unsigned)l);
    for (;;) {
        unsigned k_ = 0u;
        if (lane == 0) k_ = __hip_atomic_fetch_add(ctr, 1u, __ATOMIC_RELAXED, __HIP_MEMORY_SCOPE_AGENT);
        k_ = (unsigned)__builtin_amdgcn_readfirstlane((int)k_);
        if (k_ >= 512u) break;
        const int u = (int)(shard * 512u + (511u - k_));
        const int bh = u >> 6, b = bh >> 3, h = bh & 7, rb = u & 63;
        const int tq0 = 32 * rb, tq = tq0 + r32;
        const size_t row0 = (size_t)b * SEQ, tok = row0 + tq;
        bf16* Q = (bf16*)(ws + WS_OQ);
        const bf16* Kg = (const bf16*)(ws + WS_KV) + row0 * 512 + h * 64; const bf16* Vg = (const bf16*)(ws + WS_KV + 16 * MiB) + row0 * 512 + h * 64;
        bf16x8 qf[4]; load_q(qf, Q + tok * 512 + h * 64, hi);
        f32x16 o[2]; o[0] = f32x16{}; o[1] = f32x16{};
        float carry = 1.0f;
        u32x4 ak[4], av[4], bk[4], bv[4];
#define SB_LOAD(K_, V_, j_) do { _Pragma("unroll") for (int i = 0; i < 4; ++i) { const int pc = lane + 64 * i, row = 32 * (j_) + (pc >> 3), ch = pc & 7; \
            K_[i] = *(const u32x4*)(Kg + (size_t)row * 512 + ch * 8); V_[i] = *(const u32x4*)(Vg + (size_t)row * 512 + ch * 8); } } while (0)
#define SB_STORE(K_, V_) do { _Pragma("unroll") for (int i = 0; i < 4; ++i) { const int pc = lane + 64 * i, off = (pc >> 3) * KROW + (pc & 7) * 16, offv = (pc >> 3) * VROW + (pc & 7) * 16; \
            *(LAS u32x4*)(lds + off) = K_[i]; *(LAS u32x4*)(lds + SUB_B + offv) = V_[i]; } } while (0)
#define SB_COMPUTE(jj_) do { const int jsub_ = (jj_); \
            f32x16 s = f32x16{}; \
_Pragma("unroll") \
            for (int d0 = 0; d0 < 4; ++d0) { const bf16x8 kf = *(const LAS bf16x8*)(lds + koff + d0 * 32); s = __builtin_amdgcn_mfma_f32_32x32x16_bf16(kf, qf[d0], s, 0, 0, 0); } \
            const int dd = tq - (32 * jsub_ + 4 * hi); \
            float keep[16]; \
_Pragma("unroll") \
            for (int r = 0; r < 16; ++r) { \
                const bool v = ((r & 3) + 8 * (r >> 2)) < dd; const float z = s[r]; \
                const float ea = __expf(-fabsf(z)), rr = __builtin_amdgcn_rcpf(1.0f + ea), sm = ea * rr; \
                const float beta = z >= 0.f ? rr : sm, kp = z >= 0.f ? sm : rr; \
                keep[r] = v ? kp : 1.0f; s[r] = v ? beta : 0.f; \
            } \
            float Go[4], Gp[4]; \
_Pragma("unroll") \
            for (int uu = 0; uu < 4; ++uu) { Go[uu] = (keep[4 * uu] * keep[4 * uu + 1]) * (keep[4 * uu + 2] * keep[4 * uu + 3]); Gp[uu] = __shfl_xor(Go[uu], 32); } \
            float above = carry; \
_Pragma("unroll") \
            for (int uu = 3; uu >= 0; --uu) { \
                const float e3 = above * (hi ? 1.0f : Gp[uu]); \
                const float e2 = e3 * keep[4 * uu + 3], e1 = e2 * keep[4 * uu + 2], e0 = e1 * keep[4 * uu + 1]; \
                s[4 * uu + 3] *= e3; s[4 * uu + 2] *= e2; s[4 * uu + 1] *= e1; s[4 * uu] *= e0; \
                above *= Go[uu] * Gp[uu]; \
            } \
            carry = above; \
_Pragma("unroll") \
            for (int ss = 0; ss < 2; ++ss) { \
                const bf16x8 pb = pack8(s, 8 * ss); \
_Pragma("unroll") \
                for (int d0 = 0; d0 < 2; ++d0) { \
                    const LAS unsigned char* vp = lds + voff + (16 * ss) * VROW + d0 * 64; \
                    const s16x4 lo = vtr(vp), hh = vtr(vp + 8 * VROW); \
                    const bf16x8 vf = (bf16x8){lo[0], lo[1], lo[2], lo[3], hh[0], hh[1], hh[2], hh[3]}; \
                    o[d0] = __builtin_amdgcn_mfma_f32_32x32x16_bf16(vf, pb, o[d0], 0, 0, 0); \
                } \
            } \
        } while (0)
        SB_LOAD(ak, av, rb);
        if (rb > 0) SB_LOAD(bk, bv, rb - 1);
        for (int j = rb; j >= 0; j -= 2) {
            SB_STORE(ak, av);
            if (j >= 2) SB_LOAD(ak, av, j - 2);
            SB_COMPUTE(j);
            if (__ballot(carry != 0.f) == 0ull) break;
            if (j == 0) break;
            SB_STORE(bk, bv);
            if (j >= 3) SB_LOAD(bk, bv, j - 3);
            SB_COMPUTE(j - 1);
            if (__ballot(carry != 0.f) == 0ull) break;
        }
#undef SB_LOAD
#undef SB_STORE
#undef SB_COMPUTE
        if (!dry) store_o(Q + tok * 512 + h * 64, o, 1.0f, hi);
    }
    __syncthreads();
}

template <int XIN, int XOUT>
__device__ __forceinline__ void post_norm_rows2x(const bf16* y0, const bf16* y1, const void* xs0, const void* xs1, const u32x4 (&xr)[2][2], void* xd0, void* xd1, const float* gpost, const float* gpre, bf16* h0, bf16* h1, float* rs0, float* rs1, bool write_h, bool dry, int lane) {
    float y[2][2][8], x[2][2][8]; f32x4 gp[2][2]; u32x4 w[2][2], xb[2][2];
#pragma unroll
    for (int jj = 0; jj < 2; ++jj) { w[0][jj] = __builtin_nontemporal_load((const u32x4*)y0 + lane + 64 * jj); w[1][jj] = __builtin_nontemporal_load((const u32x4*)y1 + lane + 64 * jj); }
#pragma unroll
    for (int jj = 0; jj < 2; ++jj) {
        if (XIN == 0) {
#pragma unroll
            for (int q = 0; q < 2; ++q) { const f32x4* xp = (const f32x4*)(q ? xs1 : xs0) + 2 * lane + 128 * jj; const f32x4 a0 = __builtin_nontemporal_load(xp), a1 = __builtin_nontemporal_load(xp + 1);
                x[q][jj][0] = a0.x; x[q][jj][1] = a0.y; x[q][jj][2] = a0.z; x[q][jj][3] = a0.w; x[q][jj][4] = a1.x; x[q][jj][5] = a1.y; x[q][jj][6] = a1.z; x[q][jj][7] = a1.w; }
        } else if (XIN == 1) { xb[0][jj] = __builtin_nontemporal_load((const u32x4*)xs0 + lane + 64 * jj); xb[1][jj] = __builtin_nontemporal_load((const u32x4*)xs1 + lane + 64 * jj); }
        else { xb[0][jj] = xr[0][jj]; xb[1][jj] = xr[1][jj]; }
        gp[jj][0] = ((const f32x4*)gpost)[2 * lane + 128 * jj]; gp[jj][1] = ((const f32x4*)gpost)[2 * lane + 128 * jj + 1]; }
    float s[2] = {0.f, 0.f};
#pragma unroll
    for (int q = 0; q < 2; ++q)
#pragma unroll
        for (int jj = 0; jj < 2; ++jj) {
            const unsigned wv[4] = {w[q][jj].x, w[q][jj].y, w[q][jj].z, w[q][jj].w};
#pragma unroll
            for (int e = 0; e < 4; ++e) { y[q][jj][2 * e] = __uint_as_float(wv[e] << 16); y[q][jj][2 * e + 1] = __uint_as_float(wv[e] & 0xffff0000u); }
            if (XIN != 0) { const unsigned xv[4] = {xb[q][jj].x, xb[q][jj].y, xb[q][jj].z, xb[q][jj].w};
#pragma unroll
                for (int e = 0; e < 4; ++e) { x[q][jj][2 * e] = __uint_as_float(xv[e] << 16); x[q][jj][2 * e + 1] = __uint_as_float(xv[e] & 0xffff0000u); } }
#pragma unroll
            for (int e = 0; e < 8; e += 2) s[q] += y[q][jj][e] * y[q][jj][e] + y[q][jj][e + 1] * y[q][jj][e + 1]; }
#pragma unroll
    for (int o = 1; o < 64; o <<= 1) { s[0] += __shfl_xor(s[0], o); s[1] += __shfl_xor(s[1], o); }
    float s2[2] = {0.f, 0.f};
#pragma unroll
    for (int q = 0; q < 2; ++q) { const float rstd = __builtin_amdgcn_rsqf(s[q] * (1.f / DM) + RMS_EPS); void* xd = q ? xd1 : xd0;
#pragma unroll
        for (int jj = 0; jj < 2; ++jj) {
            const float g8[8] = {gp[jj][0].x, gp[jj][0].y, gp[jj][0].z, gp[jj][0].w, gp[jj][1].x, gp[jj][1].y, gp[jj][1].z, gp[jj][1].w};
#pragma unroll
            for (int e = 0; e < 8; ++e) { x[q][jj][e] += y[q][jj][e] * rstd * g8[e]; s2[q] += x[q][jj][e] * x[q][jj][e]; }
            if (!dry) {
                if (XOUT == 0) { f32x4* xp = (f32x4*)xd + 2 * lane + 128 * jj;
                    __builtin_nontemporal_store((f32x4){x[q][jj][0], x[q][jj][1], x[q][jj][2], x[q][jj][3]}, xp); __builtin_nontemporal_store((f32x4){x[q][jj][4], x[q][jj][5], x[q][jj][6], x[q][jj][7]}, xp + 1); }
                else { u32x4 xo; xo.x = pk2(x[q][jj][0], x[q][jj][1]); xo.y = pk2(x[q][jj][2], x[q][jj][3]); xo.z = pk2(x[q][jj][4], x[q][jj][5]); xo.w = pk2(x[q][jj][6], x[q][jj][7]);
                    __builtin_amdgcn_raw_buffer_store_b128(__builtin_bit_cast(pg8::u32x4e, xo), pg8::wt_rsrc(xd), (lane + 64 * jj) * 16, 0, 16); } } } }
    if (write_h && !dry && rs0) {
#pragma unroll
        for (int o = 1; o < 64; o <<= 1) { s2[0] += __shfl_xor(s2[0], o); s2[1] += __shfl_xor(s2[1], o); }
        if (lane == 0) { *rs0 = __builtin_amdgcn_rsqf(s2[0] * (1.f / DM) + RMS_EPS); *rs1 = __builtin_amdgcn_rsqf(s2[1] * (1.f / DM) + RMS_EPS); }
    } else
    if (write_h && !dry) {
#pragma unroll
        for (int o = 1; o < 64; o <<= 1) { s2[0] += __shfl_xor(s2[0], o); s2[1] += __shfl_xor(s2[1], o); }
#pragma unroll
        for (int jj = 0; jj < 2; ++jj) { gp[jj][0] = ((const f32x4*)gpre)[2 * lane + 128 * jj]; gp[jj][1] = ((const f32x4*)gpre)[2 * lane + 128 * jj + 1]; }
#pragma unroll
        for (int q = 0; q < 2; ++q) { const float r2 = __builtin_amdgcn_rsqf(s2[q] * (1.f / DM) + RMS_EPS); const __amdgpu_buffer_rsrc_t hr_ = pg8::wt_rsrc(q ? h1 : h0);
#pragma unroll
            for (int jj = 0; jj < 2; ++jj) {
                const float g8[8] = {gp[jj][0].x, gp[jj][0].y, gp[jj][0].z, gp[jj][0].w, gp[jj][1].x, gp[jj][1].y, gp[jj][1].z, gp[jj][1].w};
                pg8::u32x4e ww; ww.x = pk2(x[q][jj][0] * r2 * g8[0], x[q][jj][1] * r2 * g8[1]); ww.y = pk2(x[q][jj][2] * r2 * g8[2], x[q][jj][3] * r2 * g8[3]);
                ww.z = pk2(x[q][jj][4] * r2 * g8[4], x[q][jj][5] * r2 * g8[5]); ww.w = pk2(x[q][jj][6] * r2 * g8[6], x[q][jj][7] * r2 * g8[7]);
                __builtin_amdgcn_raw_buffer_store_b128(ww, hr_, (lane + 64 * jj) * 16, 0, 16); } }
    }
}
__device__ __forceinline__ void final_norm_rows2(const bf16* y0, const bf16* y1, const bf16* x0, const bf16* x1, float* o0, float* o1, const float* gpost, bool dry, int lane) {
    u32x2 wy[2][4], wx[2][4]; f32x4 gp[4];
#pragma unroll
    for (int j = 0; j < 4; ++j) { wy[0][j] = __builtin_nontemporal_load((const u32x2*)y0 + lane + 64 * j); wy[1][j] = __builtin_nontemporal_load((const u32x2*)y1 + lane + 64 * j); }
#pragma unroll
    for (int j = 0; j < 4; ++j) { wx[0][j] = __builtin_nontemporal_load((const u32x2*)x0 + lane + 64 * j); wx[1][j] = __builtin_nontemporal_load((const u32x2*)x1 + lane + 64 * j); gp[j] = ((const f32x4*)gpost + lane)[64 * j]; }
    f32x4 y[2][4]; float s[2] = {0.f, 0.f};
#pragma unroll
    for (int q = 0; q < 2; ++q)
#pragma unroll
        for (int j = 0; j < 4; ++j) { y[q][j].x = __uint_as_float(wy[q][j].x << 16); y[q][j].y = __uint_as_float(wy[q][j].x & 0xffff0000u); y[q][j].z = __uint_as_float(wy[q][j].y << 16); y[q][j].w = __uint_as_float(wy[q][j].y & 0xffff0000u);
            s[q] += (y[q][j].x * y[q][j].x + y[q][j].y * y[q][j].y) + (y[q][j].z * y[q][j].z + y[q][j].w * y[q][j].w); }
#pragma unroll
    for (int o = 1; o < 64; o <<= 1) { s[0] += __shfl_xor(s[0], o); s[1] += __shfl_xor(s[1], o); }
#pragma unroll
    for (int q = 0; q < 2; ++q) { const float rstd = __builtin_amdgcn_rsqf(s[q] * (1.f / DM) + RMS_EPS); float* od = q ? o1 : o0;
#pragma unroll
        for (int j = 0; j < 4; ++j) { f32x4 x;
            x.x = __uint_as_float(wx[q][j].x << 16) + y[q][j].x * rstd * gp[j].x; x.y = __uint_as_float(wx[q][j].x & 0xffff0000u) + y[q][j].y * rstd * gp[j].y;
            x.z = __uint_as_float(wx[q][j].y << 16) + y[q][j].z * rstd * gp[j].z; x.w = __uint_as_float(wx[q][j].y & 0xffff0000u) + y[q][j].w * rstd * gp[j].w;
            if (!dry) __builtin_nontemporal_store(x, (f32x4*)od + lane + 64 * j); } }
}
__device__ __forceinline__ void phase_norm_bx(const Frame& F, const KA& a, const XcdBarrier& bar, const bf16* ysrc, const float* xin, const float* gpost, const float* gpre, bool write_h, bool dry, int mode) {
    unsigned char* ws = a.ws();
    bf16* xb = (bf16*)(ws + WS_H);
    bf16* H = (bf16*)(ws + WS_H);
    float* RS = (float*)(ws + WS_XSTAT);
    const u32x4 none[2][2] = {};
    if (mode == 0) {
        for (int r = F.gw; r < M; r += 2 * F.ngw) { const int r1 = r + F.ngw;
            post_norm_rows2x<0, 1>(ysrc + (size_t)r * DM, ysrc + (size_t)r1 * DM, xin + (size_t)r * DM, xin + (size_t)r1 * DM, none, xb + (size_t)r * DM, xb + (size_t)r1 * DM, gpost, gpre, H + (size_t)r * DM, H + (size_t)r1 * DM, RS + r, RS + r1, write_h, dry, F.lane); }
    } else if (mode == 1) {
        for (int r = F.gw; r < M; r += 2 * F.ngw) { const int r1 = r + F.ngw;
            post_norm_rows2x<1, 1>(ysrc + (size_t)r * DM, ysrc + (size_t)r1 * DM, xb + (size_t)r * DM, xb + (size_t)r1 * DM, none, xb + (size_t)r * DM, xb + (size_t)r1 * DM, gpost, gpre, H + (size_t)r * DM, H + (size_t)r1 * DM, RS + r, RS + r1, write_h, dry, F.lane); }
    } else {
        float* out = a.out();
        for (int r = F.gw; r < M; r += 2 * F.ngw) { const int r1 = r + F.ngw;
            final_norm_rows2(ysrc + (size_t)r * DM, ysrc + (size_t)r1 * DM, xb + (size_t)r * DM, xb + (size_t)r1 * DM, out + (size_t)r * DM, out + (size_t)r1 * DM, gpost, dry, F.lane); }
    }
}

__device__ __forceinline__ void phase_norm(const Frame& F, const KA& a, const bf16* ysrc, const float* xs, const float* gpost, const float* gpre, bool write_h, bool dry) {
    unsigned char* ws = a.ws();
    for (int r = F.gw; r < M; r += 2 * F.ngw) {
        const int r1 = (r + F.ngw < M) ? r + F.ngw : r;
        if (r1 != r) post_norm_rows2(ysrc + (size_t)r * DM, ysrc + (size_t)r1 * DM, xs + (size_t)r * DM, xs + (size_t)r1 * DM, a.out() + (size_t)r * DM, a.out() + (size_t)r1 * DM, gpost, gpre,
                                     (bf16*)(ws + WS_H) + (size_t)r * DM, (bf16*)(ws + WS_H) + (size_t)r1 * DM, write_h, dry, F.lane);
        else post_norm_row(ysrc + (size_t)r * DM, xs + (size_t)r * DM, a.out() + (size_t)r * DM, gpost, gpre, (bf16*)(ws + WS_H) + (size_t)r * DM, write_h, dry, F.lane);
    }
}

__device__ __forceinline__ void launder_frame(Frame& F) {
    int z = 0; asm volatile("" : "+s"(z));
    int t = threadIdx.x; asm volatile("" : "+v"(t));
    F.tid = t; F.lane = t & 63; F.wave = __builtin_amdgcn_readfirstlane(t >> 6);
    F.G = (int)gridDim.x + z; F.bid = (int)blockIdx.x + z;
    F.gw = F.bid * NWAVES + F.wave; F.ngw = F.G * NWAVES; F.gt = F.bid * NTHREADS + F.tid; F.ngt = F.G * NTHREADS;
}
constexpr int NPH = 19;
constexpr int LDS_BYTES = 147456;
constexpr int MISC_OFF = 131072 + 320;

template <int PSEL> __global__ void __launch_bounds__(NTHREADS, 2) hybrid_fwd(Args a_unused) {
    extern __shared__ __attribute__((aligned(16))) unsigned char lds_raw[];
    Frame F;
    F.lds = (LAS unsigned char*)lds_raw;
    F.tid = threadIdx.x; F.lane = F.tid & 63; F.wave = __builtin_amdgcn_readfirstlane(F.tid >> 6);
    F.G = gridDim.x; F.bid = blockIdx.x;
    F.gw = F.bid * NWAVES + F.wave; F.ngw = F.G * NWAVES; F.gt = F.bid * NTHREADS + F.tid; F.ngt = F.G * NTHREADS;
    volatile LAS unsigned* MISC = (volatile LAS unsigned*)(F.lds + MISC_OFF);
    if (F.tid < 32) MISC[F.tid] = 0u;
    __syncthreads();
    KA a; a.refresh();
    unsigned char* ws = a.ws();
    constexpr bool one_launch = PSEL < 0;
    XcdBarrier bar; bar.bar = (unsigned*)(ws + WS_CTL) + CW_BAR; bar.x = 0; bar.st = nullptr;
    if (one_launch) bar = xcd_barrier_post((unsigned*)(ws + WS_CTL) + CW_BAR, MISC + 8);
    const bool BX = one_launch && F.G == 256;
#define A_NORM ((const pb*)(ws + WS_H))
#define Y2B (BX ? WS_KV + 64 * MiB : WS_H)
#define RS_NORM (BX ? (const float*)(ws + WS_XSTAT) : (const float*)nullptr)
#define IN(k) (a.refresh(), ws = a.ws(), launder_frame(F), (PSEL < 0 || PSEL == ((k) - p0)))
#define REP(k) for (int rep_ = ((PROBE_MASK >> (k)) & 1) ? a.ph_hi() : 0; rep_ >= 0; --rep_)
#define DRY (rep_ > 0)
#define SEAM(k) do { if (PSEL < 0) { xcd_barrier(bar); if (PROBE_XBAR) xcd_barrier(bar); } } while (0)
    typedef pg8::bf16_t pb;
    const int l_lo = (PSEL < 0 ? 0 : a.ph_lo()), l_hi = (PSEL < 0 ? 2 : l_lo + 1);
    for (int l = l_lo; l < l_hi; ++l) {
        const int p0 = l * NPH;
        if (l == 0) { if (IN(p0 + 0)) REP(0) { phase_conv(F, a, 0); __syncthreads(); } SEAM(p0 + 0); }
        if (IN(p0 + 1)) REP(1) {
            pg8::Gemm g{A_NORM, (const pb*)(ws + W_A), M, NA, DM}; pg8::StaticOrder S; S.init(M, NA, F.G, F.bid);
            pg8::EpiProj E{(pb*)(ws + WS_CK), (pb*)(ws + WS_OQ), (pb*)(ws + WS_KV), M, RS_NORM};
            pg8::gemm_phase<pg8::EpiProj, pg8::StaticOrder, true, true>(F.lds, g, S, E);
            { pg8::Gemm g2{(const pb*)(ws + WS_MEMN), (const pb*)(ws + W_MKV), MMEM, 512, DM}; pg8::StaticOrder S2; S2.init(MMEM, 512, F.G, (F.bid + F.G - 128) % F.G);
              pg8::EpiPlain E2{(pb*)(ws + WS_MEMKV), 512}; pg8::gemm_phase<pg8::EpiPlain, pg8::StaticOrder, true, true>(F.lds, g2, S2, E2); }
            if (MK_ONE_LAUNCH && F.G == 256 && F.bid >= 144 && F.bid < 152) b1_item(a, ws, l, (F.bid - 144) * NWAVES + F.wave, F.lane);
            phase_conv_b(F, a, l);
        }
        SEAM(p0 + 1);
        if (IN(p0 + 3)) REP(3) {
            phase_post(F, a, l, DRY);
            { pg8::Gemm g{(const pb*)(ws + WS_CK), (const pb*)(ws + W_C1K), 2048, 512, 1024}; pg8::StaticOrder S; S.init(2048, 512, F.G, F.bid);
              pg8::EpiPlain E{(pb*)(ws + WS_PK), 512}; pg8::gemm_phase<pg8::EpiPlain, pg8::StaticOrder, true, true>(F.lds, g, S, E); }
            { pg8::Gemm g{(const pb*)(ws + WS_CV), (const pb*)(ws + W_C1V), 2048, 512, 1024}; pg8::StaticOrder S; S.init(2048, 512, F.G, (F.bid + F.G - 16) % F.G);
              pg8::EpiPlain E{(pb*)(ws + WS_PV), 512}; pg8::gemm_phase<pg8::EpiPlain, pg8::StaticOrder, true, true>(F.lds, g, S, E); }
            phase_sb_mfma(F, a, l, DRY);
        }
        SEAM(p0 + 3);
        if (IN(p0 + 4)) REP(4) { phase_cmp2(F, a, l); phase_fox_mfma(F, a, DRY); }
        SEAM(p0 + 4);
        if (IN(p0 + 5)) REP(5) phase_nsa_fused(F, a, DRY);
        SEAM(p0 + 5);
        if (IN(p0 + 8)) REP(8) {
            pb* T = (pb*)(ws + WS_MG) + (size_t)F.bid * 65536;
            for (int tile = F.bid; tile < 256; tile += F.G) {
                pg8::Unit v; v.pm = 8 * (tile & 7) + ((tile >> 3) & 7); v.pn = tile >> 6;
                { pg8::Gemm2 g{(const pb*)(ws + WS_OQ), (const pb*)(ws + W_UP), A_NORM, (const pb*)(ws + W_M)}; pg8::SixOrder S{v.pm, v.pn};
                  pg8::EpiUpGate E{T, (pb*)(ws + WS_Y), DRY, RS_NORM}; pg8::gemm_phase_mg<pg8::EpiUpGate, pg8::SixOrder>(F.lds, g, S, E); }
            }
        }
        SEAM(p0 + 9);
        if (IN(p0 + 10)) REP(10) {
            pg8::Gemm g{(const pb*)(ws + WS_Y), (const pb*)(ws + W_OUT3), M, DM, DM}; pg8::StaticOrder S; S.init(M, DM, F.G, F.bid);
            pg8::EpiPlain E{(pb*)(ws + WS_MG), DM};
            pg8::gemm_phase<pg8::EpiPlain, pg8::StaticOrder, true, true>(F.lds, g, S, E);
        }
        SEAM(p0 + 10);
        if (IN(p0 + 11)) REP(11) { if (BX) phase_norm_bx(F, a, bar, (const bf16*)(ws + WS_MG), (const float*)a.in(0), (const float*)a.in(4) + l * DM, (const float*)a.in(5) + l * DM, true, DRY, 1);
            else phase_norm(F, a, (const bf16*)(ws + WS_MG), l == 0 ? (const float*)a.in(0) : (const float*)a.out(), (const float*)a.in(4) + l * DM, (const float*)a.in(5) + l * DM, true, DRY); }
        SEAM(p0 + 11);
        if (IN(p0 + 12)) REP(12) {
            for (int kq = 0; kq < 4; ++kq) {
                pg8::Gemm g{A_NORM + kq * 256, (const pb*)(ws + W_MQ) + kq * 256, M, 256, 256, DM, DM}; pg8::StaticOrder S; S.init(M, 256, F.G, (F.bid + F.G - 64 * kq) % F.G);
                pg8::EpiPlain E{(pb*)(ws + WS_MQ) + (size_t)kq * M * 256, 256}; pg8::gemm_phase<pg8::EpiPlain, pg8::StaticOrder, true, true>(F.lds, g, S, E);
            }
        }
        SEAM(p0 + 12);
        if (IN(p0 + 13)) REP(13) phase_mem_mfma(F, a, RS_NORM);
        SEAM(p0 + 13);
        if (IN(p0 + 14)) REP(14) {
            pg8::Gemm g{(const pb*)(ws + WS_MO), (const pb*)(ws + W_MO), M, DM, 256}; pg8::StaticOrder S; S.init(M, DM, F.G, F.bid);
            pg8::EpiPlain E{(pb*)(ws + Y2B), DM};
            pg8::gemm_phase<pg8::EpiPlain, pg8::StaticOrder, true, true>(F.lds, g, S, E);
        }
        SEAM(p0 + 14);
        if (IN(p0 + 15)) REP(15) { if (BX) phase_norm_bx(F, a, bar, (const bf16*)(ws + Y2B), nullptr, (const float*)a.in(7) + l * DM, (const float*)a.in(8) + l * DM, true, DRY, 1);
            else phase_norm(F, a, (const bf16*)(ws + WS_H), (const float*)a.out(), (const float*)a.in(7) + l * DM, (const float*)a.in(8) + l * DM, true, DRY); }
        SEAM(p0 + 15);
        if (IN(p0 + 16)) REP(16) {
            pg8::Gemm g{A_NORM, (const pb*)(ws + W_GU), M, 2 * DFF, DM}; pg8::StaticOrder S; S.init(M, 2 * DFF, F.G, F.bid);
            pg8::EpiSwiglu E{(pb*)(ws + WS_ACT), DFF, RS_NORM};
            pg8::gemm_phase<pg8::EpiSwiglu, pg8::StaticOrder, true, true>(F.lds, g, S, E);
            if (l == 0 && F.G == 256 && F.bid >= 128 && !DRY) { Frame F2 = F; F2.bid = F.bid - 128; F2.G = 128; F2.gw = F2.bid * NWAVES + F.wave; F2.ngw = 128 * NWAVES; F2.gt = F2.bid * NTHREADS + F.tid; F2.ngt = 128 * NTHREADS;
                __syncthreads(); phase_conv(F2, a, 1, 0, CONV1_EARLY, false, 256); __syncthreads(); }
        }
        SEAM(p0 + 16);
        if (IN(p0 + 17)) REP(17) {
            pg8::Gemm g{(const pb*)(ws + WS_ACT), (const pb*)(ws + W_DN), M, DM, DFF}; pg8::StaticOrder S; S.init(M, DM, F.G, F.bid);
            pg8::EpiPlain E{(pb*)(ws + Y2B), DM};
            pg8::gemm_phase<pg8::EpiPlain, pg8::StaticOrder, true, true>(F.lds, g, S, E);
        }
        SEAM(p0 + 17);
        if (IN(p0 + 18)) REP(18) { if (BX) phase_norm_bx(F, a, bar, (const bf16*)(ws + Y2B), nullptr, (const float*)a.in(9) + l * DM, (const float*)a.in(3) + (l + 1 < 2 ? l + 1 : l) * DM, l == 0, DRY, l == 0 ? 1 : 2);
            else phase_norm(F, a, (const bf16*)(ws + WS_H), (const float*)a.out(), (const float*)a.in(9) + l * DM, (const float*)a.in(3) + (l + 1 < 2 ? l + 1 : l) * DM, l == 0, DRY);
            if (l == 0) { phase_conv(F, a, 1, F.G == 256 ? CONV1_EARLY : 0); __syncthreads(); } }
        if (l == 0) SEAM(p0 + 18);
    }
#undef IN
#undef SEAM
}

template <int P> static hipError_t set_attr1() { return hipFuncSetAttribute((const void*)hybrid_fwd<P>, hipFuncAttributeMaxDynamicSharedMemorySize, LDS_BYTES); }
template <int... P> static hipError_t set_attrs_seq(std::integer_sequence<int, P...>) { hipError_t e = hipSuccess; hipError_t r[] = {set_attr1<P>()...}; for (hipError_t x : r) if (x != hipSuccess) e = x; return e; }
static hipError_t set_attrs() {
#if MK_ONE_LAUNCH
    return set_attr1<-1>();
#else
    return set_attrs_seq(std::make_integer_sequence<int, NPH>{});
#endif
}
template <int P> static int launch1(const Args& a, int grid, hipStream_t stream) { hybrid_fwd<P><<<dim3(grid), dim3(NTHREADS), LDS_BYTES, stream>>>(a); return 0; }
template <int... P> static void launch_phases(const Args& a, int grid, hipStream_t stream, std::integer_sequence<int, P...>) {
    (void)std::initializer_list<int>{launch1<P>(a, grid, stream)...};
}

extern "C" void kernel_launch(void* const* d_in, const int* in_sizes, int n_in, void* d_out, int out_size, void* d_ws, size_t ws_size, hipStream_t stream) {
    static int grid = 0;
    if (grid == 0) {
        if (n_in != 31 || out_size != M * DM || ws_size < WS_XSTAT + 64 * 1024) { fprintf(stderr, "kernel_launch: unexpected problem (n_in %d, out %d, ws %zu)\n", n_in, out_size, ws_size); grid = -1; return; }
        if (set_attrs() != hipSuccess) { fprintf(stderr, "kernel_launch: hipFuncSetAttribute failed\n"); grid = -1; return; }
        int dev = 0, cus = 0;
        if (hipGetDevice(&dev) != hipSuccess || hipDeviceGetAttribute(&cus, hipDeviceAttributeMultiprocessorCount, dev) != hipSuccess) { grid = -1; return; }
        grid = cus;
    }
    if (grid < 0) return;
    (void)hipMemsetAsync((char*)d_ws + WS_CTL, 0, CTL_ZERO_BYTES, stream);
    Args a{};
    for (int i = 0; i < 31; ++i) a.in[i] = d_in[i];
    a.out = (float*)d_out; a.ws = (unsigned char*)d_ws;
#if MK_ONE_LAUNCH
    a.ph_lo = 0; a.ph_hi = PROBE_REPS;
    launch1<-1>(a, grid, stream);
#else
    for (int l = 0; l < 2; ++l) { a.ph_lo = l; a.ph_hi = l + 1; launch_phases(a, grid, stream, std::make_integer_sequence<int, NPH>{}); }
#endif
}
```
